# Optimizing an MI355X kernel written in HIP

```python
import math
import jax, jax.numpy as jnp
from jax import lax
import numpy as np

D_MODEL = 2048
BATCH = 4
SEQ = 2048
DEPTH = 4
DEC_BATCH = 128
DEC_SEQ = 8
PAST_LEN = 16384
PAGE_SIZE = 128

MIX_WIDTH = D_MODEL
S5_WIDTH = MIX_WIDTH // 2
S5_GROUP = 16
S5_GROUPS = S5_WIDTH // S5_GROUP
S5_STATE = 64
HGRN_WIDTH = MIX_WIDTH - S5_WIDTH
HGRN_DK = 128
HGRN_DV = 128
HGRN_HEADS = HGRN_WIDTH // HGRN_DK
HGRN_CHUNK = 64
D_FF = 128 * ((8 * D_MODEL // 3 + 127) // 128)
IN_WIDTH = S5_WIDTH + 4 * HGRN_WIDTH
EPS = 1e-6
S5_DT_MIN = 1e-3
S5_DT_MAX = 1e-1

kernel_name = 'hymba_s5_hgrn2_macaron_decode_step'


def rms_norm(x, gain):
    x32 = x.astype(jnp.float32)
    y = x32 * lax.rsqrt(jnp.mean(x32 * x32, axis=-1, keepdims=True) + EPS)
    return (y * gain.astype(jnp.float32)).astype(x.dtype)


def swiglu(x, w_gate, w_up, w_down):
    return (jax.nn.silu(x @ w_gate) * (x @ w_up)) @ w_down


def s5_discretise(lam_re, lam_im, log_dt, b_re, b_im):
    lam_re = lam_re.astype(jnp.float32)
    lam_im = lam_im.astype(jnp.float32)
    dt = jnp.exp(log_dt.astype(jnp.float32))[:, None]
    mag = jnp.exp(lam_re * dt)
    ang = lam_im * dt
    abar_re = mag * jnp.cos(ang)
    abar_im = mag * jnp.sin(ang)
    p = abar_re - 1.0
    qv = abar_im
    den = lam_re * lam_re + lam_im * lam_im
    z_re = (p * lam_re + qv * lam_im) / den
    z_im = (qv * lam_re - p * lam_im) / den
    b_re = b_re.astype(jnp.float32)
    b_im = b_im.astype(jnp.float32)
    bb_re = z_re[..., None] * b_re - z_im[..., None] * b_im
    bb_im = z_re[..., None] * b_im + z_im[..., None] * b_re
    return abar_re, abar_im, bb_re, bb_im


def _complex_affine_combine(e1, e2):
    a1r, a1i, b1r, b1i = e1
    a2r, a2i, b2r, b2i = e2
    return (a2r * a1r - a2i * a1i,
            a2r * a1i + a2i * a1r,
            a2r * b1r - a2i * b1i + b2r,
            a2r * b1i + a2i * b1r + b2i)


def s5_scan(u, h_re, h_im, abar_re, abar_im, bb_re, bb_im, c_re, c_im):
    bu_re = jnp.einsum('btgc,gnc->btgn', u, bb_re)
    bu_im = jnp.einsum('btgc,gnc->btgn', u, bb_im)
    init_re = abar_re * h_re - abar_im * h_im
    init_im = abar_re * h_im + abar_im * h_re
    bu_re = bu_re.at[:, 0].add(init_re)
    bu_im = bu_im.at[:, 0].add(init_im)
    a_re = jnp.broadcast_to(abar_re, bu_re.shape)
    a_im = jnp.broadcast_to(abar_im, bu_im.shape)
    _, _, x_re, x_im = lax.associative_scan(_complex_affine_combine,
                                            (a_re, a_im, bu_re, bu_im), axis=1)
    y = (jnp.einsum('btgn,gcn->btgc', x_re, c_re.astype(jnp.float32))
         - jnp.einsum('btgn,gcn->btgc', x_im, c_im.astype(jnp.float32)))
    return y, x_re[:, -1], x_im[:, -1]


def hgrn_lower_bounds(lb_param):
    p = jax.nn.softmax(lb_param.astype(jnp.float32), axis=0)
    return jnp.cumsum(p, axis=0) - p[0]


def chunk_gla(q, k, v, log_f, s0):
    B, T, H, dk = q.shape
    dv = v.shape[-1]
    C = math.gcd(T, HGRN_CHUNK)
    n = T // C

    def to_chunks(t):
        return t.reshape(B, n, C, H, t.shape[-1]).transpose(1, 0, 3, 2, 4)

    causal = jnp.tril(jnp.ones((C, C), dtype=bool))[:, :, None]

    def step(S, inp):
        qi, ki, vi, fi = inp
        b = jnp.cumsum(fi, axis=2)
        o_inter = jnp.einsum('bhtk,bhkv->bhtv', qi * jnp.exp(b), S)
        diff = b[:, :, :, None, :] - b[:, :, None, :, :]
        decay = jnp.where(causal, jnp.exp(jnp.where(causal, diff, 0.0)), 0.0)
        att = jnp.einsum('bhtsk,bhsk->bhts', qi[:, :, :, None, :] * decay, ki)
        o = o_inter + jnp.einsum('bhts,bhsv->bhtv', att, vi)
        b_last = b[:, :, -1:, :]
        S = (jnp.exp(b_last[:, :, 0, :])[..., None] * S
             + jnp.einsum('bhsk,bhsv->bhkv', ki * jnp.exp(b_last - b), vi))
        return S, o

    S, o = lax.scan(step, s0, (to_chunks(q), to_chunks(k), to_chunks(v), to_chunks(log_f)))
    o = o.transpose(1, 0, 3, 2, 4).reshape(B, T, H, dv)
    return o, S


def hgrn2(q, f, v, g, lb, s0, gain):
    B, T, _ = q.shape
    shp = (B, T, HGRN_HEADS, HGRN_DK)
    qh = jax.nn.silu(q.astype(jnp.float32)).reshape(shp)
    f_gate = lb + (1.0 - lb) * jax.nn.sigmoid(f.astype(jnp.float32))
    log_f = jnp.log(f_gate).reshape(shp)
    k = (1.0 - f_gate).reshape(shp)
    vh = v.astype(jnp.float32).reshape(B, T, HGRN_HEADS, HGRN_DV)
    o, s_new = chunk_gla(qh, k, vh, log_f, s0)
    o = o * lax.rsqrt(jnp.mean(o * o, axis=-1, keepdims=True) + EPS)
    o = o * gain.astype(jnp.float32).reshape(HGRN_HEADS, HGRN_DV)
    o = o.reshape(B, T, HGRN_WIDTH) * jax.nn.silu(g.astype(jnp.float32))
    return o, s_new


def mixer(a, s_re, s_im, s_h, lb, p, l):
    B, T, _ = a.shape
    z = a @ p['w_in'][l]
    u, q, f, v, g = jnp.split(z, [S5_WIDTH, S5_WIDTH + HGRN_WIDTH,
                                  S5_WIDTH + 2 * HGRN_WIDTH,
                                  S5_WIDTH + 3 * HGRN_WIDTH], axis=-1)
    abar_re, abar_im, bb_re, bb_im = s5_discretise(p['s5_lam_re'][l], p['s5_lam_im'][l],
                                                   p['s5_log_dt'][l], p['s5_b_re'][l],
                                                   p['s5_b_im'][l])
    u32 = u.astype(jnp.float32)
    ys, s_re_new, s_im_new = s5_scan(u32.reshape(B, T, S5_GROUPS, S5_GROUP),
                                     s_re.astype(jnp.float32), s_im.astype(jnp.float32),
                                     abar_re, abar_im, bb_re, bb_im,
                                     p['s5_c_re'][l], p['s5_c_im'][l])
    ys = ys.reshape(B, T, S5_WIDTH) + p['s5_d'][l].astype(jnp.float32) * u32
    ys = jax.nn.gelu(ys).astype(a.dtype)
    ys = ys * jax.nn.sigmoid(ys @ p['s5_w_glu'][l] + p['s5_b_glu'][l])
    yh, s_h_new = hgrn2(q, f, v, g, lb, s_h.astype(jnp.float32), p['hgrn_norm'][l])
    out = jnp.concatenate([ys, yh.astype(a.dtype)], axis=-1) @ p['w_out'][l]
    return out, s_re_new, s_im_new, s_h_new


def trunk(x, s5_re0, s5_im0, hgrn0, p):
    lb_all = hgrn_lower_bounds(p['hgrn_lb'])
    h = x
    new_re, new_im, new_h = [], [], []
    for l in range(DEPTH):
        a = swiglu(rms_norm(h, p['norm_pre'][l, 0]), p['ffn1_w_gate'][l],
                   p['ffn1_w_up'][l], p['ffn1_w_down'][l])
        h = h + 0.5 * rms_norm(a, p['norm_post'][l, 0])
        a, sre, sim, sh = mixer(rms_norm(h, p['norm_pre'][l, 1]), s5_re0[l], s5_im0[l],
                                hgrn0[l], lb_all[l], p, l)
        h = h + rms_norm(a, p['norm_post'][l, 1])
        a = swiglu(rms_norm(h, p['norm_pre'][l, 2]), p['ffn2_w_gate'][l],
                   p['ffn2_w_up'][l], p['ffn2_w_down'][l])
        h = h + 0.5 * rms_norm(a, p['norm_post'][l, 2])
        new_re.append(sre)
        new_im.append(sim)
        new_h.append(sh)
    return h, jnp.stack(new_re), jnp.stack(new_im), jnp.stack(new_h)


def setup_inputs(seed: int = 0) -> dict:
    key = jax.random.key(seed)
    ks = jax.random.split(key, 32)
    f32 = jnp.float32
    nrm = lambda k, shape, s: jax.random.normal(k, shape, f32) * s
    G, N, Cg = S5_GROUPS, S5_STATE, S5_GROUP
    lam_im = (jnp.pi * jnp.arange(N, dtype=f32))[None, None, :] + nrm(ks[20], (DEPTH, G, N), 0.01)
    return {
        'x_prompt': nrm(ks[0], (BATCH, SEQ, D_MODEL), 1.0),
        'x_sample': nrm(ks[1], (DEC_BATCH, DEC_SEQ, D_MODEL), 1.0),
        'state_s5_re': nrm(ks[2], (DEPTH, DEC_BATCH, G, N), 0.3),
        'state_s5_im': nrm(ks[3], (DEPTH, DEC_BATCH, G, N), 0.3),
        'state_hgrn': nrm(ks[4], (DEPTH, DEC_BATCH, HGRN_HEADS, HGRN_DK, HGRN_DV), 0.5),
        'norm_pre': 1.0 + nrm(ks[5], (DEPTH, 3, D_MODEL), 0.02),
        'norm_post': 1.0 + nrm(ks[6], (DEPTH, 3, D_MODEL), 0.02),
        'ffn1_w_gate': nrm(ks[7], (DEPTH, D_MODEL, D_FF), D_MODEL ** -0.5),
        'ffn1_w_up': nrm(ks[8], (DEPTH, D_MODEL, D_FF), D_MODEL ** -0.5),
        'ffn1_w_down': nrm(ks[9], (DEPTH, D_FF, D_MODEL), D_FF ** -0.5),
        'ffn2_w_gate': nrm(ks[10], (DEPTH, D_MODEL, D_FF), D_MODEL ** -0.5),
        'ffn2_w_up': nrm(ks[11], (DEPTH, D_MODEL, D_FF), D_MODEL ** -0.5),
        'ffn2_w_down': nrm(ks[12], (DEPTH, D_FF, D_MODEL), D_FF ** -0.5),
        'w_in': nrm(ks[13], (DEPTH, D_MODEL, IN_WIDTH), D_MODEL ** -0.5),
        'w_out': nrm(ks[14], (DEPTH, MIX_WIDTH, D_MODEL), MIX_WIDTH ** -0.5),
        's5_lam_re': -0.5 + nrm(ks[15], (DEPTH, G, N), 0.01),
        's5_lam_im': lam_im,
        's5_log_dt': jax.random.uniform(ks[16], (DEPTH, G), f32,
                                        math.log(S5_DT_MIN), math.log(S5_DT_MAX)),
        's5_b_re': nrm(ks[17], (DEPTH, G, N, Cg), (2 * Cg) ** -0.5),
        's5_b_im': nrm(ks[18], (DEPTH, G, N, Cg), (2 * Cg) ** -0.5),
        's5_c_re': nrm(ks[19], (DEPTH, G, Cg, N), N ** -0.5),
        's5_c_im': nrm(ks[21], (DEPTH, G, Cg, N), N ** -0.5),
        's5_d': nrm(ks[22], (DEPTH, S5_WIDTH), 1.0),
        's5_w_glu': nrm(ks[23], (DEPTH, S5_WIDTH, S5_WIDTH), S5_WIDTH ** -0.5),
        's5_b_glu': nrm(ks[24], (DEPTH, S5_WIDTH), 0.01),
        'hgrn_lb': nrm(ks[25], (DEPTH, HGRN_WIDTH), 0.1),
        'hgrn_norm': 1.0 + nrm(ks[26], (DEPTH, HGRN_WIDTH), 0.02),
    }


def reference(x_prompt, x_sample, state_s5_re, state_s5_im, state_hgrn,
              norm_pre, norm_post,
              ffn1_w_gate, ffn1_w_up, ffn1_w_down,
              ffn2_w_gate, ffn2_w_up, ffn2_w_down,
              w_in, w_out,
              s5_lam_re, s5_lam_im, s5_log_dt, s5_b_re, s5_b_im, s5_c_re, s5_c_im,
              s5_d, s5_w_glu, s5_b_glu,
              hgrn_lb, hgrn_norm):
    p = dict(norm_pre=norm_pre, norm_post=norm_post,
             ffn1_w_gate=ffn1_w_gate, ffn1_w_up=ffn1_w_up, ffn1_w_down=ffn1_w_down,
             ffn2_w_gate=ffn2_w_gate, ffn2_w_up=ffn2_w_up, ffn2_w_down=ffn2_w_down,
             w_in=w_in, w_out=w_out,
             s5_lam_re=s5_lam_re, s5_lam_im=s5_lam_im, s5_log_dt=s5_log_dt,
             s5_b_re=s5_b_re, s5_b_im=s5_b_im, s5_c_re=s5_c_re, s5_c_im=s5_c_im,
             s5_d=s5_d, s5_w_glu=s5_w_glu, s5_b_glu=s5_b_glu,
             hgrn_lb=hgrn_lb, hgrn_norm=hgrn_norm)
    sdt = state_hgrn.dtype
    z_s5 = jnp.zeros((DEPTH, BATCH, S5_GROUPS, S5_STATE), jnp.float32)
    z_h = jnp.zeros((DEPTH, BATCH, HGRN_HEADS, HGRN_DK, HGRN_DV), jnp.float32)
    y_prompt, re_p, im_p, h_p = trunk(x_prompt, z_s5, z_s5, z_h, p)
    y_sample, re_s, im_s, h_s = trunk(x_sample, state_s5_re, state_s5_im, state_hgrn, p)
    return (y_prompt, y_sample,
            re_p.astype(sdt), im_p.astype(sdt), h_p.astype(sdt),
            re_s.astype(sdt), im_s.astype(sdt), h_s.astype(sdt))
```

```cpp
#include <hip/hip_runtime.h>
#include <cstdio>
#include <cstdint>
namespace pg8 {
#define PG8_LAS __attribute__((address_space(3)))
typedef unsigned short bf16_t;
typedef short bf16x8 __attribute__((ext_vector_type(8)));
typedef float f32x4 __attribute__((ext_vector_type(4)));
typedef unsigned u32x4 __attribute__((ext_vector_type(4)));
constexpr int BM = 256, BK = 64, HALF = 128, HTB = HALF * BK * 2  , STAGE_BYTES = 8 * HTB, NXCD = 8, WGM = 8;

__host__ __device__ __forceinline__ int lds_byte(int r, int c) { const int st = (r >> 4) * 2 + (c >> 5), rr = r & 15, cc = c & 31, ob = rr * 64 + cc * 2; return st * 1024 + (ob ^ (((ob >> 9) & 1) << 5)); }
__host__ __device__ __forceinline__ void stage_rc(int b, int& R, int& C) { const int st = b / 1024, sb = b % 1024, swz = sb ^ (((sb >> 9) & 1) << 5); R = (st >> 1) * 16 + swz / 64; C = (st & 1) * 32 + (swz % 64) / 2; }
__host__ __device__ __forceinline__ int perm32(int rho) { const int n = rho >> 4, i = rho & 15; return 8 * (i >> 2) + 4 * n + (i & 3); }

struct Unit { int pm, pn; };
struct Gemm { const bf16_t* A; const bf16_t* Bt; int M, N, K; };

struct StaticOrder {
    int nM, nN, nwg, G, c;
    __host__ __device__ void init(int M, int N, int G_, int c_) { nM = M / BM; nN = N / BM; nwg = nM * nN; G = G_; c = c_; }
    __host__ __device__ bool next(int i, Unit& u) const {
        const long L = (long)i * G + c; if (L >= nwg) return false;
        int wgid = (int)L; { const int q = nwg / NXCD, r = nwg % NXCD, xcd = wgid % NXCD, off = wgid / NXCD; wgid = (xcd < r ? xcd * (q + 1) : r * (q + 1) + (xcd - r) * q) + off; }
        const int nig = WGM * nN, gid = wgid / nig, fm = gid * WGM, gsz = (nM - fm) < WGM ? (nM - fm) : WGM;
        u.pm = fm + ((wgid % nig) % gsz); u.pn = (wgid % nig) / gsz; return true;
    }
    __device__ __forceinline__ void a_ready(const Unit&) const {}
    __device__ __forceinline__ void done(const Unit&) const {}
};

__device__ __forceinline__ unsigned cvt_pk_bf16(float lo, float hi) { unsigned r; asm volatile("v_cvt_pk_bf16_f32 %0, %1, %2" : "=v"(r) : "v"(lo), "v"(hi)); return r; }
typedef float f32x2 __attribute__((ext_vector_type(2)));
template <class Epi, class Sched, bool ALIGN_EPI = false, bool SP2 = false>
__device__ __forceinline__ void gemm_phase(PG8_LAS unsigned char* lds, const Gemm g, const Sched& S, const Epi& E) {
    int tid_l = threadIdx.x; asm volatile("" : "+v"(tid_l));
    const int tid = tid_l, wid = __builtin_amdgcn_readfirstlane(tid >> 6), lane = tid & 63, wr = wid >> 2, wc = wid & 3, fr = lane & 15, fq = lane >> 4;
    const int K = g.K, nt = K / BK;
    unsigned voffA[2], voffB[2];
#pragma unroll
    for (int i = 0; i < 2; ++i) { int R, C; stage_rc(tid * 16 + i * 8192, R, C); const int Rb = Epi::PERM ? ((R & ~31) + perm32(R & 31)) : R;
        voffA[i] = (unsigned)(R * K + C) * 2u; voffB[i] = (unsigned)(Rb * K + C) * 2u; }
    const size_t kstep = (size_t)(BK * 2);
    const size_t hstep = (size_t)HALF * K * 2;
    const size_t tstep = 2 * hstep;
    const unsigned ldsw = (unsigned)wid * 1024u;
    const int aoff = lds_byte(wr * 64 + fr, fq * 8), boff = lds_byte(wc * 32 + fr, fq * 8);
#define PG8_SA(b, h) (((b) * 2 + (h)) * HTB)
#define PG8_SB(b, h) ((4 + (b) * 2 + (h)) * HTB)
#define PG8_STAGE(bufoff, gbase, voff) do { _Pragma("unroll") for (int _i = 0; _i < 2; ++_i) \
        __builtin_amdgcn_global_load_lds((const unsigned*)((const char*)(gbase) + (voff)[_i]), (PG8_LAS unsigned*)(lds + (bufoff) + ldsw + _i * 8192), 16, 0, 0); } while (0)
#define PG8_LDA(dst, b, h) do { _Pragma("unroll") for (int m = 0; m < 4; ++m) _Pragma("unroll") for (int k = 0; k < 2; ++k) dst[m][k] = *(const PG8_LAS bf16x8*)(lds + PG8_SA(b, h) + aoff + m * 2048 + k * 1024); } while (0)
#define PG8_LDB(dst, b, h) do { _Pragma("unroll") for (int n = 0; n < 2; ++n) _Pragma("unroll") for (int k = 0; k < 2; ++k) dst[n][k] = *(const PG8_LAS bf16x8*)(lds + PG8_SB(b, h) + boff + n * 2048 + k * 1024); } while (0)
#define PG8_MMA(ai, bj, At, Bt) do { __builtin_amdgcn_s_setprio(1); _Pragma("unroll") for (int m = 0; m < 4; ++m) _Pragma("unroll") for (int n = 0; n < 2; ++n) _Pragma("unroll") for (int k = 0; k < 2; ++k) \
        acc[ai][bj][m][n] = __builtin_amdgcn_mfma_f32_16x16x32_bf16(Bt[n][k], At[m][k], acc[ai][bj][m][n], 0, 0, 0); __builtin_amdgcn_s_setprio(0); } while (0)
#define PG8_WAIT_V(n) asm volatile("s_waitcnt vmcnt(" #n ")" ::: "memory")
#define PG8_WAIT_L(n) asm volatile("s_waitcnt lgkmcnt(" #n ")" ::: "memory")
#define PG8_BAR __builtin_amdgcn_s_barrier()
#define PG8_SCHED __builtin_amdgcn_sched_barrier(0)
    Unit cur, nxt; int ui = 0;
    if (!S.next(0, cur)) return;
    f32x4 acc[2][2][4][2];
#pragma unroll
    for (int a = 0; a < 2; ++a)
#pragma unroll
        for (int b = 0; b < 2; ++b)
#pragma unroll
            for (int m = 0; m < 4; ++m)
#pragma unroll
                for (int n = 0; n < 2; ++n) acc[a][b][m][n] = (f32x4){0.f, 0.f, 0.f, 0.f};
    bf16x8 At[4][2], B0[2][2], B1[2][2];
    const char* cA = (const char*)g.A + (size_t)cur.pm * tstep; const char* cB = (const char*)g.Bt + (size_t)cur.pn * tstep;
    S.a_ready(cur);
    if constexpr (SP2) {
        PG8_STAGE(PG8_SB(0, 0), cB, voffB); PG8_STAGE(PG8_SB(0, 1), cB + hstep, voffB); PG8_STAGE(PG8_SA(0, 0), cA, voffA); PG8_STAGE(PG8_SA(0, 1), cA + hstep, voffA);
        if (wr == 1) PG8_BAR;
        PG8_WAIT_V(2); PG8_BAR;
        PG8_STAGE(PG8_SB(1, 0), cB + kstep, voffB); PG8_STAGE(PG8_SA(1, 0), cA + kstep, voffA); PG8_STAGE(PG8_SB(1, 1), cB + hstep + kstep, voffB);
        PG8_WAIT_V(6); PG8_BAR;
    } else {
        PG8_STAGE(PG8_SB(0, 0), cB, voffB); PG8_STAGE(PG8_SA(0, 0), cA, voffA); PG8_STAGE(PG8_SB(0, 1), cB + hstep, voffB); PG8_STAGE(PG8_SA(0, 1), cA + hstep, voffA);
        if (wr == 1) PG8_BAR;
        PG8_WAIT_V(4); PG8_BAR;
        PG8_STAGE(PG8_SB(1, 0), cB + kstep, voffB); PG8_STAGE(PG8_SA(1, 0), cA + kstep, voffA); PG8_STAGE(PG8_SB(1, 1), cB + hstep + kstep, voffB);
        PG8_WAIT_V(6); PG8_BAR;
    }
    for (;;) {
        const bool has_next = S.next(ui + 1, nxt);
        const char* nA = has_next ? (const char*)g.A + (size_t)nxt.pm * tstep : cA; const char* nB = has_next ? (const char*)g.Bt + (size_t)nxt.pn * tstep : cB;
        for (int t = 0; t < nt; t += 2) {
            const bool last = (t == nt - 2);
            const char* a1 = cA + (size_t)(t + 1) * kstep;
            const char* a2 = last ? nA : cA + (size_t)(t + 2) * kstep; const char* b2 = last ? nB : cB + (size_t)(t + 2) * kstep;
            const char* a3 = a2 + kstep; const char* b3 = b2 + kstep;
            if (last && has_next) S.a_ready(nxt);
            if constexpr (SP2) {
            PG8_LDB(B0, 0, 0); PG8_LDB(B1, 0, 1); PG8_SCHED; PG8_LDA(At, 0, 0); PG8_STAGE(PG8_SA(1, 1), a1 + hstep, voffA);
            PG8_WAIT_V(8); PG8_WAIT_L(0); PG8_BAR; PG8_MMA(0, 0, At, B0); PG8_MMA(0, 1, At, B1); PG8_BAR; PG8_SCHED;
            PG8_LDA(At, 0, 1); PG8_STAGE(PG8_SB(0, 0), b2, voffB); PG8_STAGE(PG8_SB(0, 1), b2 + hstep, voffB); PG8_STAGE(PG8_SA(0, 0), a2, voffA);
            PG8_WAIT_V(8); PG8_WAIT_L(0); PG8_BAR; PG8_MMA(1, 0, At, B0); PG8_MMA(1, 1, At, B1); PG8_BAR; PG8_SCHED;
            PG8_LDB(B0, 1, 0); PG8_LDB(B1, 1, 1); PG8_SCHED; PG8_LDA(At, 1, 0); PG8_STAGE(PG8_SA(0, 1), a2 + hstep, voffA);
            PG8_WAIT_V(8); PG8_WAIT_L(0); PG8_BAR; PG8_MMA(0, 0, At, B0); PG8_MMA(0, 1, At, B1); PG8_BAR; PG8_SCHED;
            PG8_LDA(At, 1, 1); PG8_STAGE(PG8_SB(1, 0), b3, voffB); PG8_STAGE(PG8_SB(1, 1), b3 + hstep, voffB); PG8_STAGE(PG8_SA(1, 0), a3, voffA);
            PG8_WAIT_V(8); PG8_WAIT_L(0); PG8_BAR; PG8_MMA(1, 0, At, B0); PG8_MMA(1, 1, At, B1); PG8_BAR; PG8_SCHED;
            } else {
            PG8_LDB(B0, 0, 0); PG8_SCHED; PG8_LDA(At, 0, 0); PG8_STAGE(PG8_SA(1, 1), a1 + hstep, voffA);
            PG8_WAIT_L(8); PG8_BAR; PG8_WAIT_L(0); PG8_MMA(0, 0, At, B0); PG8_BAR; PG8_SCHED;
            PG8_LDB(B1, 0, 1); PG8_STAGE(PG8_SB(0, 0), b2, voffB);
            PG8_BAR; PG8_WAIT_L(0); PG8_MMA(0, 1, At, B1); PG8_BAR;
            PG8_LDA(At, 0, 1); PG8_STAGE(PG8_SA(0, 0), a2, voffA);
            PG8_BAR; PG8_WAIT_L(0); PG8_MMA(1, 0, At, B0); PG8_BAR; PG8_SCHED;
            PG8_STAGE(PG8_SB(0, 1), b2 + hstep, voffB);
            PG8_WAIT_V(6); PG8_BAR; PG8_MMA(1, 1, At, B1); PG8_BAR;
            PG8_LDB(B0, 1, 0); PG8_SCHED; PG8_LDA(At, 1, 0); PG8_STAGE(PG8_SA(0, 1), a2 + hstep, voffA);
            PG8_WAIT_L(8); PG8_BAR; PG8_WAIT_L(0); PG8_MMA(0, 0, At, B0); PG8_BAR; PG8_SCHED;
            PG8_LDB(B1, 1, 1); PG8_STAGE(PG8_SB(1, 0), b3, voffB);
            PG8_BAR; PG8_WAIT_L(0); PG8_MMA(0, 1, At, B1); PG8_BAR;
            PG8_LDA(At, 1, 1); PG8_STAGE(PG8_SA(1, 0), a3, voffA);
            PG8_BAR; PG8_WAIT_L(0); PG8_MMA(1, 0, At, B0); PG8_BAR; PG8_SCHED;
            PG8_STAGE(PG8_SB(1, 1), b3 + hstep, voffB);
            PG8_WAIT_V(6); PG8_BAR; PG8_MMA(1, 1, At, B1); PG8_BAR;
            }
        }
        if constexpr (ALIGN_EPI) { if (wr == 0) PG8_BAR; }
        if constexpr (!Epi::AFTER_DRAIN) { E(acc, cur, wr, wc, fr, fq); S.done(cur); }
        if (!has_next) break;
#pragma unroll
        for (int a = 0; a < 2; ++a)
#pragma unroll
            for (int b = 0; b < 2; ++b)
#pragma unroll
                for (int m = 0; m < 4; ++m)
#pragma unroll
                    for (int n = 0; n < 2; ++n) acc[a][b][m][n] = (f32x4){0.f, 0.f, 0.f, 0.f};
        cur = nxt; cA = nA; cB = nB; ++ui;
        if constexpr (ALIGN_EPI) { if (wr == 1) PG8_BAR; }
    }
    PG8_WAIT_V(0);
    if constexpr (!ALIGN_EPI) { if (wr == 0) PG8_BAR; }
    PG8_BAR;
    if constexpr (Epi::AFTER_DRAIN) { E.fused(acc, cur, wr, wc, fr, fq, lds, wid, lane); S.done(cur); }
#undef PG8_SA
#undef PG8_SB
#undef PG8_STAGE
#undef PG8_LDA
#undef PG8_LDB
#undef PG8_MMA
#undef PG8_WAIT_V
#undef PG8_WAIT_L
#undef PG8_BAR
#undef PG8_SCHED
}
}
#define XB_TMO      128
#define XB_XCNT(j)  (256  + 64 * (j))
#define XB_XSUB(j)  (1280 + 64 * (j))
#define XB_XGEN(j)  (2304 + 64 * (j))
#define XB_TOP      3328
#define XB_TOPGEN   3392
#define XCD_BAR_WORDS 3456
#define XB_SPIN_CAP (1u << 18)
#define LAS __attribute__((address_space(3)))

__device__ __forceinline__ unsigned xb_ld(unsigned* p)              { return __hip_atomic_load(p, __ATOMIC_RELAXED, __HIP_MEMORY_SCOPE_AGENT); }
__device__ __forceinline__ unsigned xb_add(unsigned* p, unsigned v) { return __hip_atomic_fetch_add(p, v, __ATOMIC_RELAXED, __HIP_MEMORY_SCOPE_AGENT); }
__device__ __forceinline__ unsigned xb_xcc_id() { return (unsigned)__builtin_amdgcn_s_getreg((3 << 11) | 20) & 0xFu; }
#define XB_SPIN(cond, bar) do { unsigned _sp = 0; while (cond) { __builtin_amdgcn_s_sleep(1); \
    if ((++_sp & 255u) == 0u) { if (xb_ld(&(bar)[XB_TMO])) break; if (_sp > XB_SPIN_CAP) { atomicAdd(&(bar)[XB_TMO], 1u); break; } } } } while (0)

struct XcdBarrier {
    unsigned* bar; unsigned x;
    volatile LAS unsigned* st;
};

__device__ __forceinline__ XcdBarrier xcd_barrier_post(unsigned* bar, volatile LAS unsigned* st) {
    XcdBarrier b; b.bar = bar; b.x = xb_xcc_id(); b.st = st;
    if (threadIdx.x == 0) (void)xb_add(&bar[XB_XCNT(b.x)], 1u);
    return b;
}
__device__ __forceinline__ void xcd_barrier_complete(unsigned* bar, unsigned x, unsigned& nloc, unsigned& nx) {
    const unsigned G = gridDim.x * gridDim.y * gridDim.z;
    unsigned sum, cnt, mine, sp = 0u;
    for (;;) {
        sum = 0u; cnt = 0u; mine = 0u;
#pragma unroll
        for (unsigned j = 0; j < 16; ++j) { const unsigned c = xb_ld(&bar[XB_XCNT(j)]); sum += c; cnt += (c > 0u) ? 1u : 0u; mine = (j == x) ? c : mine; }
        if (sum == G) break;
        __builtin_amdgcn_s_sleep(1);
        if ((++sp & 255u) == 0u) { if (xb_ld(&bar[XB_TMO])) break; if (sp > XB_SPIN_CAP) { atomicAdd(&bar[XB_TMO], 1u); break; } }
    }
    nloc = mine > 0u ? mine : 1u; nx = cnt > 0u ? cnt : 1u;
}

__device__ __forceinline__ void xcd_barrier(const XcdBarrier& b) {
    asm volatile("s_waitcnt vmcnt(0)" ::: "memory");
    __syncthreads();
    if (threadIdx.x == 0) {
        unsigned* bar = b.bar;
        __builtin_amdgcn_s_waitcnt(0);
        unsigned nloc = b.st[0], nx = b.st[1];
        if (nloc == 0u) { xcd_barrier_complete(bar, b.x, nloc, nx); b.st[0] = nloc; b.st[1] = nx; }
        const unsigned old = xb_add(&bar[XB_XSUB(b.x)], 1u);
        const unsigned gen = old / nloc;
        if (old + 1u == (gen + 1u) * nloc) {
            __builtin_amdgcn_fence(__ATOMIC_RELEASE, "agent");
            asm volatile("s_waitcnt vmcnt(0)" ::: "memory");
            const unsigned og = xb_add(&bar[XB_TOP], 1u);
            const unsigned tg = og / nx;
            if (og + 1u == (tg + 1u) * nx) xb_add(&bar[XB_TOPGEN], 1u);
            else XB_SPIN(xb_ld(&bar[XB_TOPGEN]) == tg, bar);
            __builtin_amdgcn_fence(__ATOMIC_ACQUIRE, "agent");
            xb_add(&bar[XB_XGEN(b.x)], 1u);
            asm volatile("s_waitcnt vmcnt(0)" ::: "memory");
        } else {
            XB_SPIN(xb_ld(&bar[XB_XGEN(b.x)]) == gen, bar);
            __builtin_amdgcn_fence(__ATOMIC_ACQUIRE, "agent");
            asm volatile("s_waitcnt vmcnt(0)" ::: "memory");
        }
    }
    __syncthreads();
}

constexpr int DM = 2048, NB = 4, SEQ = 2048, DEPTH = 4, DB = 128, DSQ = 8;
constexpr int MP = NB * SEQ, MS = DB * DSQ, MT = MP + MS;
constexpr int S5W = 1024, S5G = 64, S5N = 64, S5C = 16;
constexpr int HW = 1024, HH = 8, HK = 128, HV = 128;
constexpr int FF = 5504, INW = 5120;
constexpr float EPS = 1e-6f;
constexpr int S5CH = 16, S5CL = SEQ / S5CH;

constexpr size_t O_Y = 0, O_REP = (size_t)MT * DM, O_IMP = O_REP + (size_t)DEPTH * NB * S5G * S5N, O_HP = O_IMP + (size_t)DEPTH * NB * S5G * S5N,
                 O_RES = O_HP + (size_t)DEPTH * NB * HH * HK * HV, O_IMS = O_RES + (size_t)DEPTH * DB * S5G * S5N, O_HS = O_IMS + (size_t)DEPTH * DB * S5G * S5N,
                 O_END = O_HS + (size_t)DEPTH * DB * HH * HK * HV;
static_assert(O_END == 92405760, "output size");

constexpr size_t MiB = 1u << 20;
constexpr size_t WS_CTL = 0, CTL_ZERO_BYTES = 1 * MiB;
constexpr size_t WS_AB = 1 * MiB;
constexpr size_t WS_BBR = WS_AB + 256 * 1024;
constexpr size_t WS_BBI = WS_BBR + 1 * MiB;
constexpr size_t WS_LB = WS_BBI + 1 * MiB;
constexpr size_t WS_RS = WS_LB + 64 * 1024;
constexpr size_t WS_S5E = WS_RS + 64 * 1024;
constexpr size_t WS_W = 16 * MiB;
constexpr size_t LW_GU1 = 0, LW_D1 = LW_GU1 + (size_t)2 * FF * DM * 2, LW_GU2 = LW_D1 + (size_t)DM * FF * 2, LW_D2 = LW_GU2 + (size_t)2 * FF * DM * 2,
                 LW_IN = LW_D2 + (size_t)DM * FF * 2, LW_GLU = LW_IN + (size_t)INW * DM * 2, LW_OUT = LW_GLU + (size_t)S5W * S5W * 2, LW_END = LW_OUT + (size_t)DM * DM * 2;
static_assert(LW_END == 166723584 && (LW_D1 % 256) == 0 && (LW_GLU % 256) == 0, "weight map");
constexpr size_t WS_HB = 656 * MiB;
constexpr size_t WS_HID = WS_HB + 36 * MiB;
constexpr size_t WS_A = WS_HID + 97 * MiB;
constexpr size_t WS_Z = WS_A + 72 * MiB;
constexpr size_t WS_CAT = WS_Z + 180 * MiB;
constexpr size_t WS_YSG = WS_CAT + 36 * MiB;
constexpr size_t WS_O = WS_YSG + 18 * MiB;
constexpr size_t WS_END = WS_O + 36 * MiB;
static_assert(WS_W + 4 * LW_END <= WS_HB && WS_S5E + 2 * MiB <= WS_W, "ws map");

constexpr int RING_BYTES = 131072, LDSCTL_OFF = RING_BYTES, LDS_BYTES = RING_BYTES + 1024;

#define GAS __attribute__((address_space(1)))
#define LAS __attribute__((address_space(3)))
typedef unsigned short bf16;
typedef float f32x4 __attribute__((ext_vector_type(4)));
typedef float f32x2 __attribute__((ext_vector_type(2)));
typedef unsigned v4u __attribute__((ext_vector_type(4)));
typedef unsigned v2u __attribute__((ext_vector_type(2)));
#define LDS_WAIT() asm volatile("s_waitcnt lgkmcnt(0)" ::: "memory")

__device__ __forceinline__ unsigned f2bf(float f) { unsigned u = __builtin_bit_cast(unsigned, f); return (u + 0x7fffu + ((u >> 16) & 1u)) >> 16; }
__device__ __forceinline__ unsigned pk2(float lo, float hi) { return f2bf(lo) | (f2bf(hi) << 16); }
__device__ __forceinline__ float bflo(unsigned w) { return __builtin_bit_cast(float, w << 16); }
__device__ __forceinline__ float bfhi(unsigned w) { return __builtin_bit_cast(float, w & 0xffff0000u); }
__device__ __forceinline__ float wave_sum(float v) {
#pragma unroll
    for (int o = 1; o < 64; o <<= 1) v += __shfl_xor(v, o);
    return v;
}
__device__ __forceinline__ float sigm(float x) { return 1.f / (1.f + __expf(-x)); }
__device__ __forceinline__ float silu(float x) { return x / (1.f + __expf(-x)); }
__device__ __forceinline__ float gelu_tanh(float v) { const float a = 0.7978845608f * (v + 0.044715f * v * v * v); const float th = 1.f - 2.f / (__expf(2.f * a) + 1.f); return 0.5f * v * (1.f + th); }

struct Args { const float* in[27]; float* out; unsigned char* ws; int ph_lo, ph_hi; };

struct EpiGU {
    static constexpr bool PERM = true, AFTER_DRAIN = false;
    bf16* O; const float* rs;
    __device__ __forceinline__ void operator()(const pg8::f32x4 (&acc)[2][2][4][2], const pg8::Unit& u, int wr, int wc, int fr, int fq) const {
        const int row0 = u.pm * 256 + wr * 64 + fr, col0 = u.pn * 128 + wc * 32 + 8 * fq;
#pragma unroll
        for (int ai = 0; ai < 2; ++ai)
#pragma unroll
            for (int m = 0; m < 4; ++m) {
                const int row = row0 + ai * 128 + m * 16; const float r = rs[row];
                float o[8];
#pragma unroll
                for (int n = 0; n < 2; ++n)
#pragma unroll
                    for (int j = 0; j < 4; ++j) { const float g = acc[ai][0][m][n][j] * r, uu = acc[ai][1][m][n][j] * r; o[4 * n + j] = silu(g) * uu; }
                v4u w; w.x = pk2(o[0], o[1]); w.y = pk2(o[2], o[3]); w.z = pk2(o[4], o[5]); w.w = pk2(o[6], o[7]);
                *(v4u*)(O + (size_t)row * FF + col0) = w;
            }
    }
};
struct EpiF32 {
    static constexpr bool PERM = false, AFTER_DRAIN = false;
    float* C; int ldc;
    __device__ __forceinline__ void operator()(const pg8::f32x4 (&acc)[2][2][4][2], const pg8::Unit& u, int wr, int wc, int fr, int fq) const {
        const int row0 = u.pm * 256 + wr * 64 + fr, col0 = u.pn * 256 + wc * 32 + 4 * fq;
#pragma unroll
        for (int ai = 0; ai < 2; ++ai)
#pragma unroll
            for (int m = 0; m < 4; ++m) { float* rowp = C + (size_t)(row0 + ai * 128 + m * 16) * ldc + col0;
#pragma unroll
                for (int bj = 0; bj < 2; ++bj)
#pragma unroll
                    for (int n = 0; n < 2; ++n) *(f32x4*)(rowp + bj * 128 + n * 16) = acc[ai][bj][m][n]; }
    }
};
struct EpiWin {
    static constexpr bool PERM = false, AFTER_DRAIN = false;
    float* Z; const float* rs; const float* lb;
    __device__ __forceinline__ void operator()(const pg8::f32x4 (&acc)[2][2][4][2], const pg8::Unit& u, int wr, int wc, int fr, int fq) const {
        const int row0 = u.pm * 256 + wr * 64 + fr, col0 = u.pn * 256 + wc * 32 + 4 * fq; const int kind = u.pn >> 2;
#pragma unroll
        for (int ai = 0; ai < 2; ++ai)
#pragma unroll
            for (int m = 0; m < 4; ++m) { const int row = row0 + ai * 128 + m * 16; const float r = rs[row]; float* rowp = Z + (size_t)row * INW + col0;
#pragma unroll
                for (int bj = 0; bj < 2; ++bj)
#pragma unroll
                    for (int n = 0; n < 2; ++n) { f32x4 v = acc[ai][bj][m][n] * r;
                        if (kind == 1) { v[0] = silu(v[0]); v[1] = silu(v[1]); v[2] = silu(v[2]); v[3] = silu(v[3]); }
                        else if (kind == 2) { const f32x4 l4 = *(const f32x4*)(lb + (col0 + bj * 128 + n * 16 - 2048));
#pragma unroll
                            for (int j = 0; j < 4; ++j) v[j] = l4[j] + (1.f - l4[j]) * sigm(v[j]); }
                        *(f32x4*)(rowp + bj * 128 + n * 16) = v; } }
    }
};
struct EpiGlu {
    static constexpr bool PERM = true, AFTER_DRAIN = false;
    bf16* CAT; const bf16* YSG; const float* bias;
    __device__ __forceinline__ void operator()(const pg8::f32x4 (&acc)[2][2][4][2], const pg8::Unit& u, int wr, int wc, int fr, int fq) const {
        const int row0 = u.pm * 256 + wr * 64 + fr, col0 = u.pn * 256 + wc * 32 + 8 * fq;
        f32x4 bv[2][2];
#pragma unroll
        for (int bj = 0; bj < 2; ++bj)
#pragma unroll
            for (int n = 0; n < 2; ++n) bv[bj][n] = *(const f32x4*)(bias + col0 + bj * 128 + 4 * n);
#pragma unroll
        for (int ai = 0; ai < 2; ++ai)
#pragma unroll
            for (int m = 0; m < 4; ++m) { const int row = row0 + ai * 128 + m * 16;
#pragma unroll
                for (int bj = 0; bj < 2; ++bj) { const int col = col0 + bj * 128;
                    const v4u y = *(const v4u*)(YSG + (size_t)row * S5W + col);
                    const f32x4 t0 = acc[ai][bj][m][0] + bv[bj][0], t1 = acc[ai][bj][m][1] + bv[bj][1];
                    v4u w; w.x = pk2(bflo(y.x) * sigm(t0[0]), bfhi(y.x) * sigm(t0[1])); w.y = pk2(bflo(y.y) * sigm(t0[2]), bfhi(y.y) * sigm(t0[3]));
                    w.z = pk2(bflo(y.z) * sigm(t1[0]), bfhi(y.z) * sigm(t1[1])); w.w = pk2(bflo(y.w) * sigm(t1[2]), bfhi(y.w) * sigm(t1[3]));
                    *(v4u*)(CAT + (size_t)row * DM + col) = w; } }
    }
};

__device__ __forceinline__ void tr_item(const float* W, int ldw, int j0, int k0, const float* gain, bf16* WT, int K, int n0d, LAS float* scr, int lane) {
#pragma unroll 8
    for (int i = 0; i < 32; ++i) { const int kk = 2 * i + (lane >> 5); float v = W[(size_t)(k0 + kk) * ldw + j0 + (lane & 31)]; if (gain) v *= gain[k0 + kk]; scr[kk * 33 + (lane & 31)] = v; }
    LDS_WAIT(); asm volatile("" ::: "memory");
    const int c = lane & 7;
#pragma unroll
    for (int j = 0; j < 4; ++j) { const int n = (lane >> 3) + 8 * j; const LAS float* s = scr + (8 * c) * 33 + n;
        v4u o; o.x = pk2(s[0 * 33], s[1 * 33]); o.y = pk2(s[2 * 33], s[3 * 33]); o.z = pk2(s[4 * 33], s[5 * 33]); o.w = pk2(s[6 * 33], s[7 * 33]);
        *(v4u*)(WT + (size_t)(n0d + n) * K + k0 + 8 * c) = o; }
    LDS_WAIT(); asm volatile("" ::: "memory");
}
__device__ __forceinline__ void p0_prologue(const Args& a, LAS unsigned char* lds, int G, int bid, int tid) {
    const int wave = __builtin_amdgcn_readfirstlane(tid >> 6), lane = tid & 63;
    LAS float* scr = (LAS float*)(lds + wave * 16384);
    const int gw = bid * 8 + wave, NGW = G * 8;
    constexpr int I_GU = 32 * 344, I_D = 86 * 64, I_IN = 32 * 160, I_GLU = 16 * 32, I_OUT = 32 * 64, I_L = 2 * I_GU + 2 * I_D + I_IN + I_GLU + I_OUT;
    for (int it = gw; it < DEPTH * I_L; it += NGW) {
        const int l = it / I_L; int r = it - l * I_L;
        unsigned char* wl = a.ws + WS_W + (size_t)l * LW_END;
        if (r < 2 * I_GU) { const int f = r / I_GU; r -= f * I_GU; const int kb = r / 344, nb = r % 344, pn = nb >> 3, rr = nb & 7;
            const float* src = (rr < 4 ? a.in[f ? 10 : 7] : a.in[f ? 11 : 8]) + (size_t)l * DM * FF;
            tr_item(src, FF, 128 * pn + 32 * (rr & 3), 64 * kb, a.in[5] + (size_t)(l * 3 + (f ? 2 : 0)) * DM, (bf16*)(wl + (f ? LW_GU2 : LW_GU1)), DM, 32 * nb, scr, lane); continue; }
        r -= 2 * I_GU;
        if (r < 2 * I_D) { const int f = r / I_D; r -= f * I_D; const int kb = r / 64, nb = r % 64;
            tr_item(a.in[f ? 12 : 9] + (size_t)l * FF * DM, DM, 32 * nb, 64 * kb, nullptr, (bf16*)(wl + (f ? LW_D2 : LW_D1)), FF, 32 * nb, scr, lane); continue; }
        r -= 2 * I_D;
        if (r < I_IN) { const int kb = r / 160, nb = r % 160;
            tr_item(a.in[13] + (size_t)l * DM * INW, INW, 32 * nb, 64 * kb, a.in[5] + (size_t)(l * 3 + 1) * DM, (bf16*)(wl + LW_IN), DM, 32 * nb, scr, lane); continue; }
        r -= I_IN;
        if (r < I_GLU) { const int kb = r / 32, nb = r % 32;
            tr_item(a.in[23] + (size_t)l * S5W * S5W, S5W, 32 * nb, 64 * kb, nullptr, (bf16*)(wl + LW_GLU), S5W, 32 * nb, scr, lane); continue; }
        r -= I_GLU;
        { const int kb = r / 64, nb = r % 64;
            tr_item(a.in[14] + (size_t)l * DM * DM, DM, 32 * nb, 64 * kb, nullptr, (bf16*)(wl + LW_OUT), DM, 32 * nb, scr, lane); }
    }
    for (int idx = bid * 512 + tid; idx < DEPTH * S5G * S5N; idx += G * 512) {
        const int lg = idx / S5N;
        const float lr = a.in[15][idx], li = a.in[16][idx], dt = expf(a.in[17][lg]);
        const float mag = expf(lr * dt), ang = li * dt;
        const float are = mag * cosf(ang), aim = mag * sinf(ang);
        const float p = are - 1.f, q = aim, den = lr * lr + li * li;
        const float zre = (p * lr + q * li) / den, zim = (q * lr - p * li) / den;
        ((f32x2*)(a.ws + WS_AB))[idx] = (f32x2){are, aim};
        const f32x4* br = (const f32x4*)(a.in[18] + (size_t)idx * 16); const f32x4* bi = (const f32x4*)(a.in[19] + (size_t)idx * 16);
        f32x4* obr = (f32x4*)(a.ws + WS_BBR) + (size_t)idx * 4; f32x4* obi = (f32x4*)(a.ws + WS_BBI) + (size_t)idx * 4;
#pragma unroll
        for (int c = 0; c < 4; ++c) { const f32x4 r4 = br[c], i4 = bi[c]; obr[c] = zre * r4 - zim * i4; obi[c] = zre * i4 + zim * r4; }
    }
    for (int idx = bid * 512 + tid; idx < HW; idx += G * 512) {
        const float x0 = a.in[25][idx], x1 = a.in[25][HW + idx], x2 = a.in[25][2 * HW + idx], x3 = a.in[25][3 * HW + idx];
        const float mx = fmaxf(fmaxf(x0, x1), fmaxf(x2, x3));
        const float e0 = expf(x0 - mx), e1 = expf(x1 - mx), e2 = expf(x2 - mx), e3 = expf(x3 - mx), inv = 1.f / (e0 + e1 + e2 + e3);
        float* lb = (float*)(a.ws + WS_LB);
        lb[idx] = 0.f; lb[HW + idx] = e1 * inv; lb[2 * HW + idx] = (e1 + e2) * inv; lb[3 * HW + idx] = (e1 + e2 + e3) * inv;
    }
    for (int row = gw; row < MT; row += NGW) {
        const float* xr = row < MP ? a.in[0] + (size_t)row * DM : a.in[1] + (size_t)(row - MP) * DM;
        float* hr = a.out + O_Y + (size_t)row * DM; bf16* hb = (bf16*)(a.ws + WS_HB) + (size_t)row * DM;
        float ss = 0.f;
#pragma unroll
        for (int j = 0; j < 8; ++j) { const f32x4 v = *(const f32x4*)(xr + 4 * lane + 256 * j); ss += (v[0] * v[0] + v[1] * v[1]) + (v[2] * v[2] + v[3] * v[3]);
            *(f32x4*)(hr + 4 * lane + 256 * j) = v; v2u w; w.x = pk2(v[0], v[1]); w.y = pk2(v[2], v[3]); *(v2u*)(hb + 4 * lane + 256 * j) = w; }
        ss = wave_sum(ss);
        if (lane == 0) ((float*)(a.ws + WS_RS))[row] = 1.f / sqrtf(ss * (1.f / DM) + EPS);
    }
}

__device__ __forceinline__ void norm_res_phase(const Args& a, const float* gain, float coef, int G, int bid, int tid) {
    const int wave = __builtin_amdgcn_readfirstlane(tid >> 6), lane = tid & 63;
    const int gw = bid * 8 + wave, NGW = G * 8;
    f32x4 gv[8];
#pragma unroll
    for (int j = 0; j < 8; ++j) gv[j] = *(const f32x4*)(gain + 4 * lane + 256 * j) * coef;
    for (int row = gw; row < MT; row += NGW) {
        const float* ar = (const float*)(a.ws + WS_A) + (size_t)row * DM; float* hr = a.out + O_Y + (size_t)row * DM; bf16* hb = (bf16*)(a.ws + WS_HB) + (size_t)row * DM;
        f32x4 av[8], hv[8]; float ss = 0.f;
#pragma unroll
        for (int j = 0; j < 8; ++j) { av[j] = *(const f32x4*)(ar + 4 * lane + 256 * j); hv[j] = *(const f32x4*)(hr + 4 * lane + 256 * j);
            ss += (av[j][0] * av[j][0] + av[j][1] * av[j][1]) + (av[j][2] * av[j][2] + av[j][3] * av[j][3]); }
        ss = wave_sum(ss);
        const float ra = 1.f / sqrtf(ss * (1.f / DM) + EPS);
        float s2 = 0.f;
#pragma unroll
        for (int j = 0; j < 8; ++j) { const f32x4 v = hv[j] + av[j] * gv[j] * ra; s2 += (v[0] * v[0] + v[1] * v[1]) + (v[2] * v[2] + v[3] * v[3]);
            *(f32x4*)(hr + 4 * lane + 256 * j) = v; v2u w; w.x = pk2(v[0], v[1]); w.y = pk2(v[2], v[3]); *(v2u*)(hb + 4 * lane + 256 * j) = w; }
        s2 = wave_sum(s2);
        if (lane == 0) ((float*)(a.ws + WS_RS))[row] = 1.f / sqrtf(s2 * (1.f / DM) + EPS);
    }
}

struct S5P { float are, aim; float bbr[16], bbi[16]; };
__device__ __forceinline__ void s5_load(const Args& a, int l, int g, int lane, S5P& p) {
    const int idx = (l * S5G + g) * S5N + lane;
    const f32x2 ab = ((const f32x2*)(a.ws + WS_AB))[idx]; p.are = ab[0]; p.aim = ab[1];
    const f32x4* br = (const f32x4*)(a.ws + WS_BBR) + (size_t)idx * 4; const f32x4* bi = (const f32x4*)(a.ws + WS_BBI) + (size_t)idx * 4;
#pragma unroll
    for (int c = 0; c < 4; ++c) { const f32x4 r4 = br[c], i4 = bi[c];
#pragma unroll
        for (int j = 0; j < 4; ++j) { p.bbr[4 * c + j] = r4[j]; p.bbi[4 * c + j] = i4[j]; } }
}
__device__ __forceinline__ void s5_step(const S5P& p, float um, float& xr, float& xi) {
    float br = 0.f, bi = 0.f;
#pragma unroll
    for (int c = 0; c < 16; ++c) { const float uc = __builtin_bit_cast(float, __builtin_amdgcn_readlane(__builtin_bit_cast(int, um), c)); br += p.bbr[c] * uc; bi += p.bbi[c] * uc; }
    const float nr = p.are * xr - p.aim * xi + br, ni = p.are * xi + p.aim * xr + bi;
    xr = nr; xi = ni;
}
__device__ __forceinline__ void s5_pass1_item(const Args& a, int l, int item, int lane) {
    const int ch = item % S5CH, g = (item / S5CH) % S5G, b = item / (S5CH * S5G);
    S5P p; s5_load(a, l, g, lane, p);
    const float* zp = (const float*)(a.ws + WS_Z) + (size_t)(b * SEQ + ch * S5CL) * INW + 16 * g + (lane & 15);
    float xr = 0.f, xi = 0.f;
    for (int tb = 0; tb < S5CL; tb += 8) {
        float um[8];
#pragma unroll
        for (int j = 0; j < 8; ++j) um[j] = zp[(size_t)(tb + j) * INW];
#pragma unroll
        for (int j = 0; j < 8; ++j) s5_step(p, um[j], xr, xi);
    }
    ((f32x2*)(a.ws + WS_S5E))[((b * S5G + g) * S5CH + ch) * S5N + lane] = (f32x2){xr, xi};
}
__device__ __forceinline__ float reduce16(const float (&p)[16], int lane) {
    float r8[8], r4[4], r2[2];
    { const bool hi = lane & 8;
#pragma unroll
      for (int i = 0; i < 8; ++i) { const float send = hi ? p[i] : p[i + 8], keep = hi ? p[i + 8] : p[i]; r8[i] = keep + __shfl_xor(send, 8); } }
    { const bool hi = lane & 4;
#pragma unroll
      for (int i = 0; i < 4; ++i) { const float send = hi ? r8[i] : r8[i + 4], keep = hi ? r8[i + 4] : r8[i]; r4[i] = keep + __shfl_xor(send, 4); } }
    { const bool hi = lane & 2;
#pragma unroll
      for (int i = 0; i < 2; ++i) { const float send = hi ? r4[i] : r4[i + 2], keep = hi ? r4[i + 2] : r4[i]; r2[i] = keep + __shfl_xor(send, 2); } }
    float r;
    { const bool hi = lane & 1; const float send = hi ? r2[0] : r2[1], keep = hi ? r2[1] : r2[0]; r = keep + __shfl_xor(send, 1); }
    r += __shfl_xor(r, 16); r += __shfl_xor(r, 32);
    return r;
}
__device__ __forceinline__ void s5_pass2_item(const Args& a, int l, int item, int lane) {
    int g, b, ch, row0, nsteps; bool sample = item >= NB * S5G * S5CH;
    if (!sample) { ch = item % S5CH; g = (item / S5CH) % S5G; b = item / (S5CH * S5G); row0 = b * SEQ + ch * S5CL; nsteps = S5CL; }
    else { const int it = item - NB * S5G * S5CH; g = it % S5G; b = it / S5G; ch = 0; row0 = MP + b * DSQ; nsteps = DSQ; }
    S5P p; s5_load(a, l, g, lane, p);
    float cre[16], cim[16];
#pragma unroll
    for (int c = 0; c < 16; ++c) { cre[c] = a.in[20][(size_t)((l * S5G + g) * S5C + c) * S5N + lane]; cim[c] = a.in[21][(size_t)((l * S5G + g) * S5C + c) * S5N + lane]; }
    float xr = 0.f, xi = 0.f;
    if (!sample) {
        float pr = p.are, pi = p.aim;
#pragma unroll
        for (int s = 0; s < 7; ++s) { const float nr = pr * pr - pi * pi, ni = 2.f * pr * pi; pr = nr; pi = ni; }
        const f32x2* E = (const f32x2*)(a.ws + WS_S5E) + (size_t)((b * S5G + g) * S5CH) * S5N + lane;
        for (int j = 0; j < ch; ++j) { const f32x2 e = E[j * S5N]; const float nr = pr * xr - pi * xi + e[0], ni = pr * xi + pi * xr + e[1]; xr = nr; xi = ni; }
    } else {
        const size_t si = (size_t)((l * DB + b) * S5G + g) * S5N + lane; xr = a.in[2][si]; xi = a.in[3][si];
    }
    const float dm = a.in[22][(size_t)l * S5W + 16 * g + (lane & 15)];
    const float* zp = (const float*)(a.ws + WS_Z) + (size_t)row0 * INW + 16 * g + (lane & 15);
    bf16* yp = (bf16*)(a.ws + WS_YSG) + (size_t)row0 * S5W + 16 * g + (lane & 15);
    for (int tb = 0; tb < nsteps; tb += 8) {
        float um[8];
#pragma unroll
        for (int j = 0; j < 8; ++j) um[j] = zp[(size_t)(tb + j) * INW];
#pragma unroll
        for (int j = 0; j < 8; ++j) {
            s5_step(p, um[j], xr, xi);
            float pp[16];
#pragma unroll
            for (int c = 0; c < 16; ++c) pp[c] = xr * cre[c] - xi * cim[c];
            const float y = reduce16(pp, lane);
            if (lane < 16) yp[(size_t)(tb + j) * S5W] = (bf16)f2bf(gelu_tanh(y + dm * um[j]));
        }
    }
    if (!sample) { if (ch == S5CH - 1) { const size_t so = (size_t)((l * NB + b) * S5G + g) * S5N + lane; a.out[O_REP + so] = xr; a.out[O_IMP + so] = xi; } }
    else { const size_t so = (size_t)((l * DB + b) * S5G + g) * S5N + lane; a.out[O_RES + so] = xr; a.out[O_IMS + so] = xi; }
}

__device__ __forceinline__ void hgrn_prompt_item(const Args& a, int l, int item, int lane) {
    const int vg = item & 31, h = (item >> 5) & 7, b = item >> 8;
    const int kq = lane >> 2, vv = lane & 3, v0 = 4 * vg;
    const float* zb = (const float*)(a.ws + WS_Z) + (size_t)(b * SEQ) * INW + h * HK;
    const float* zq = zb + 1024 + kq * 8; const float* zf = zb + 2048 + kq * 8; const float* zv = zb + 3072 + v0 + vv;
    float* op = (float*)(a.ws + WS_O) + (size_t)(b * SEQ) * HW + h * HV + v0 + vv;
    float S[8];
#pragma unroll
    for (int i = 0; i < 8; ++i) S[i] = 0.f;
    f32x4 cq[4][2], cf[4][2]; float cv[4];
#pragma unroll
    for (int j = 0; j < 4; ++j) { cq[j][0] = *(const f32x4*)(zq + (size_t)j * INW); cq[j][1] = *(const f32x4*)(zq + (size_t)j * INW + 4);
        cf[j][0] = *(const f32x4*)(zf + (size_t)j * INW); cf[j][1] = *(const f32x4*)(zf + (size_t)j * INW + 4); cv[j] = zv[(size_t)j * INW]; }
    for (int t0 = 0; t0 < SEQ; t0 += 4) {
        f32x4 nq[4][2], nf[4][2]; float nv[4];
        const int tn = (t0 + 4 < SEQ) ? t0 + 4 : t0;
#pragma unroll
        for (int j = 0; j < 4; ++j) { nq[j][0] = *(const f32x4*)(zq + (size_t)(tn + j) * INW); nq[j][1] = *(const f32x4*)(zq + (size_t)(tn + j) * INW + 4);
            nf[j][0] = *(const f32x4*)(zf + (size_t)(tn + j) * INW); nf[j][1] = *(const f32x4*)(zf + (size_t)(tn + j) * INW + 4); nv[j] = zv[(size_t)(tn + j) * INW]; }
#pragma unroll
        for (int j = 0; j < 4; ++j) {
            float acc = 0.f;
#pragma unroll
            for (int i = 0; i < 8; ++i) { const float f = cf[j][i >> 2][i & 3], q = cq[j][i >> 2][i & 3]; S[i] = f * S[i] + (1.f - f) * cv[j]; acc += S[i] * q; }
            acc += __shfl_xor(acc, 4); acc += __shfl_xor(acc, 8); acc += __shfl_xor(acc, 16); acc += __shfl_xor(acc, 32);
            if (lane < 4) op[(size_t)(t0 + j) * HW] = acc;
        }
#pragma unroll
        for (int j = 0; j < 4; ++j) { cq[j][0] = nq[j][0]; cq[j][1] = nq[j][1]; cf[j][0] = nf[j][0]; cf[j][1] = nf[j][1]; cv[j] = nv[j]; }
    }
    float* sp = a.out + O_HP + ((size_t)((l * NB + b) * HH + h) * HK + kq * 8) * HV + v0 + vv;
#pragma unroll
    for (int i = 0; i < 8; ++i) sp[(size_t)i * HV] = S[i];
}
__device__ __forceinline__ void hgrn_sample_item(const Args& a, int l, int item, LAS unsigned char* lds, int tid) {
    const int h = item & 7, b = item >> 3, kq = tid >> 5, v4 = tid & 31;
    LAS float* red = (LAS float*)lds;
    const float* s0 = a.in[4] + ((size_t)((l * DB + b) * HH + h) * HK + kq * 8) * HV + 4 * v4;
    float* s1 = a.out + O_HS + ((size_t)((l * DB + b) * HH + h) * HK + kq * 8) * HV + 4 * v4;
    f32x4 S[8];
#pragma unroll
    for (int i = 0; i < 8; ++i) S[i] = *(const f32x4*)(s0 + (size_t)i * HV);
    const float* zb = (const float*)(a.ws + WS_Z) + (size_t)(MP + b * DSQ) * INW + h * HK;
#pragma unroll
    for (int t = 0; t < DSQ; ++t) {
        const float* zr = zb + (size_t)t * INW;
        const f32x4 q0 = *(const f32x4*)(zr + 1024 + kq * 8), q1 = *(const f32x4*)(zr + 1024 + kq * 8 + 4);
        const f32x4 f0 = *(const f32x4*)(zr + 2048 + kq * 8), f1 = *(const f32x4*)(zr + 2048 + kq * 8 + 4);
        const f32x4 vv = *(const f32x4*)(zr + 3072 + 4 * v4);
        f32x4 acc = (f32x4){0.f, 0.f, 0.f, 0.f};
#pragma unroll
        for (int i = 0; i < 8; ++i) { const float f = i < 4 ? f0[i & 3] : f1[i & 3], q = i < 4 ? q0[i & 3] : q1[i & 3]; S[i] = S[i] * f + vv * (1.f - f); acc += S[i] * q; }
        *(LAS f32x4*)(red + (t * 16 + kq) * 128 + 4 * v4) = acc;
    }
#pragma unroll
    for (int i = 0; i < 8; ++i) *(f32x4*)(s1 + (size_t)i * HV) = S[i];
    __syncthreads();
#pragma unroll
    for (int e = 0; e < 2; ++e) { const int idx = tid + 512 * e, t = idx >> 7, v = idx & 127; float s = 0.f;
#pragma unroll
        for (int k = 0; k < 16; ++k) s += red[(t * 16 + k) * 128 + v];
        ((float*)(a.ws + WS_O))[(size_t)(MP + b * DSQ + t) * HW + h * HV + v] = s; }
    __syncthreads();
}
__device__ __forceinline__ void hgrn_post_item(const Args& a, int l, int item, int lane) {
    const int h = item & 7, row = item >> 3;
    const f32x2 o = *(const f32x2*)((const float*)(a.ws + WS_O) + (size_t)row * HW + h * HV + 2 * lane);
    const float ss = wave_sum(o[0] * o[0] + o[1] * o[1]);
    const float r = 1.f / sqrtf(ss * (1.f / HV) + EPS);
    const f32x2 gg = *(const f32x2*)((const float*)(a.ws + WS_Z) + (size_t)row * INW + 4096 + h * HV + 2 * lane);
    const f32x2 gn = *(const f32x2*)(a.in[26] + (size_t)l * HW + h * HV + 2 * lane);
    *(unsigned*)((bf16*)(a.ws + WS_CAT) + (size_t)row * DM + 1024 + h * HV + 2 * lane) = pk2(o[0] * r * gn[0] * silu(gg[0]), o[1] * r * gn[1] * silu(gg[1]));
}

constexpr int PH_PER_LAYER = 12, N_PHASES = 1 + DEPTH * PH_PER_LAYER;
#ifndef MK_PER_PHASE
#define MK_PER_PHASE 1
#endif

__global__ void __launch_bounds__(512, 2) mega(Args args) {
    extern __shared__ __attribute__((aligned(16))) unsigned char lds_raw[];
    LAS unsigned char* lds = (LAS unsigned char*)lds_raw;
    const int tid = threadIdx.x, lane = tid & 63, wave = __builtin_amdgcn_readfirstlane(tid >> 6);
    const int G = gridDim.x, bid = blockIdx.x;
    volatile LAS unsigned* MISC = (volatile LAS unsigned*)(lds + LDSCTL_OFF);
    if (tid < 64) MISC[tid] = 0u;
    __syncthreads();
    const int lo = args.ph_lo, hi = args.ph_hi;
    XcdBarrier bar; bar.bar = (unsigned*)(args.ws + WS_CTL) + 4096; bar.x = 0; bar.st = nullptr;
    if (hi - lo > 1) bar = xcd_barrier_post((unsigned*)(args.ws + WS_CTL) + 4096, MISC + 8);
#define IN(k) (lo <= (k) && (k) < hi)
#define TIDL() int tidl = tid; asm volatile("" : "+v"(tidl)); const int lanel = tidl & 63, wavel = __builtin_amdgcn_readfirstlane(tidl >> 6); (void)lanel; (void)wavel
#define SEAM(k) do { if (IN((k) + 1)) xcd_barrier(bar); } while (0)

    if (IN(0)) { TIDL(); p0_prologue(args, lds, G, bid, tidl); SEAM(0); }

    for (int l = 0; l < DEPTH; ++l) {
        const int pb = 1 + l * PH_PER_LAYER;
        unsigned char* wl = args.ws + WS_W + (size_t)l * LW_END;
        const bf16* HB = (const bf16*)(args.ws + WS_HB); bf16* HID = (bf16*)(args.ws + WS_HID); float* A = (float*)(args.ws + WS_A); float* Z = (float*)(args.ws + WS_Z);
        const float* RS = (const float*)(args.ws + WS_RS);
#define FFN_PHASES(f) do { const int p0 = pb + ((f) ? 9 : 0); \
            if (IN(p0)) { pg8::Gemm g{HB, (const bf16*)(wl + ((f) ? LW_GU2 : LW_GU1)), MT, 2 * FF, DM}; pg8::StaticOrder S; S.init(MT, 2 * FF, G, bid); \
                EpiGU E{HID, RS}; pg8::gemm_phase<EpiGU, pg8::StaticOrder, true, true>(lds, g, S, E); SEAM(p0); } \
            if (IN(p0 + 1)) { pg8::Gemm g{HID, (const bf16*)(wl + ((f) ? LW_D2 : LW_D1)), MT, DM, FF}; pg8::StaticOrder S; S.init(MT, DM, G, bid); \
                EpiF32 E{A, DM}; pg8::gemm_phase<EpiF32, pg8::StaticOrder, true, true>(lds, g, S, E); SEAM(p0 + 1); } \
            if (IN(p0 + 2)) { TIDL(); norm_res_phase(args, args.in[6] + (size_t)(l * 3 + ((f) ? 2 : 0)) * DM, 0.5f, G, bid, tidl); SEAM(p0 + 2); } } while (0)
        FFN_PHASES(0);
        if (IN(pb + 3)) { pg8::Gemm g{HB, (const bf16*)(wl + LW_IN), MT, INW, DM}; pg8::StaticOrder S; S.init(MT, INW, G, bid);
            EpiWin E{Z, RS, (const float*)(args.ws + WS_LB) + (size_t)l * HW}; pg8::gemm_phase<EpiWin, pg8::StaticOrder, true, true>(lds, g, S, E); SEAM(pb + 3); }
        if (IN(pb + 4)) {
            TIDL();
            if (wavel < 4) { for (int it = bid * 4 + wavel; it < NB * HH * 32; it += G * 4) hgrn_prompt_item(args, l, it, lanel); }
            else { for (int it = bid * 4 + (wavel - 4); it < NB * S5G * S5CH; it += G * 4) s5_pass1_item(args, l, it, lanel); }
            __syncthreads();
            for (int it = bid; it < DB * HH; it += G) hgrn_sample_item(args, l, it, lds, tidl);
            SEAM(pb + 4); }
        if (IN(pb + 5)) {
            TIDL(); const int n5 = NB * S5G * S5CH + DB * S5G, npost = MT * HH;
            for (int it = bid * 8 + wavel; it < n5 + npost; it += G * 8) { if (it < n5) s5_pass2_item(args, l, it, lanel); else hgrn_post_item(args, l, it - n5, lanel); }
            SEAM(pb + 5); }
        if (IN(pb + 6)) { pg8::Gemm g{(const bf16*)(args.ws + WS_YSG), (const bf16*)(wl + LW_GLU), MT, S5W, S5W}; pg8::StaticOrder S; S.init(MT, S5W, G, bid);
            EpiGlu E{(bf16*)(args.ws + WS_CAT), (const bf16*)(args.ws + WS_YSG), args.in[24] + (size_t)l * S5W}; pg8::gemm_phase<EpiGlu, pg8::StaticOrder, true, true>(lds, g, S, E); SEAM(pb + 6); }
        if (IN(pb + 7)) { pg8::Gemm g{(const bf16*)(args.ws + WS_CAT), (const bf16*)(wl + LW_OUT), MT, DM, DM}; pg8::StaticOrder S; S.init(MT, DM, G, bid);
            EpiF32 E{A, DM}; pg8::gemm_phase<EpiF32, pg8::StaticOrder, true, true>(lds, g, S, E); SEAM(pb + 7); }
        if (IN(pb + 8)) { TIDL(); norm_res_phase(args, args.in[6] + (size_t)(l * 3 + 1) * DM, 1.0f, G, bid, tidl); SEAM(pb + 8); }
        FFN_PHASES(1);
    }
#undef IN
#undef SEAM
}

extern "C" void kernel_launch(void* const* d_in, const int* in_sizes, int n_in, void* d_out, int out_size, void* d_ws, size_t ws_size, hipStream_t stream) {
    static int grid = 0;
    if (grid == 0) {
        if (n_in != 27 || out_size != (int)O_END || ws_size < WS_END) { fprintf(stderr, "kernel_launch: unexpected shapes: n_in %d out %d ws %zu (need %zu)\n", n_in, out_size, ws_size, (size_t)WS_END); grid = -1; return; }
        int dev = 0, cus = 0, per_cu = 0;
        if (hipGetDevice(&dev) != hipSuccess || hipDeviceGetAttribute(&cus, hipDeviceAttributeMultiprocessorCount, dev) != hipSuccess) { grid = -1; return; }
        if (hipFuncSetAttribute((const void*)mega, hipFuncAttributeMaxDynamicSharedMemorySize, LDS_BYTES) != hipSuccess) { fprintf(stderr, "kernel_launch: hipFuncSetAttribute failed\n"); grid = -1; return; }
        if (hipOccupancyMaxActiveBlocksPerMultiprocessor(&per_cu, (const void*)mega, 512, LDS_BYTES) != hipSuccess || per_cu < 1) fprintf(stderr, "kernel_launch: occupancy query reports %d\n", per_cu);
        (void)hipGetLastError();
        grid = cus;
    }
    if (grid < 0) return;
    (void)hipMemsetAsync((char*)d_ws + WS_CTL, 0, CTL_ZERO_BYTES, stream);
    Args a{};
    for (int i = 0; i < 27; ++i) a.in[i] = (const float*)d_in[i];
    a.out = (float*)d_out; a.ws = (unsigned char*)d_ws;
#if MK_PER_PHASE
    for (int p = 0; p < N_PHASES; ++p) { a.ph_lo = p; a.ph_hi = p + 1; hipLaunchKernelGGL(mega, dim3(grid), dim3(512), LDS_BYTES, stream, a); }
#else
    a.ph_lo = 0; a.ph_hi = N_PHASES; hipLaunchKernelGGL(mega, dim3(grid), dim3(512), LDS_BYTES, stream, a);
#endif
}
```

```cpp
#include <hip/hip_runtime.h>
#include <cstdio>
#include <cstdint>
namespace pg8 {
#define PG8_LAS __attribute__((address_space(3)))
typedef unsigned short bf16_t;
typedef short bf16x8 __attribute__((ext_vector_type(8)));
typedef float f32x4 __attribute__((ext_vector_type(4)));
typedef unsigned u32x4 __attribute__((ext_vector_type(4)));
constexpr int BM = 256, BK = 64, HALF = 128, HTB = HALF * BK * 2  , STAGE_BYTES = 8 * HTB, NXCD = 8, WGM = 8;

__host__ __device__ __forceinline__ int lds_byte(int r, int c) { const int st = (r >> 4) * 2 + (c >> 5), rr = r & 15, cc = c & 31, ob = rr * 64 + cc * 2; return st * 1024 + (ob ^ (((ob >> 9) & 1) << 5)); }
__host__ __device__ __forceinline__ void stage_rc(int b, int& R, int& C) { const int st = b / 1024, sb = b % 1024, swz = sb ^ (((sb >> 9) & 1) << 5); R = (st >> 1) * 16 + swz / 64; C = (st & 1) * 32 + (swz % 64) / 2; }
__host__ __device__ __forceinline__ int perm32(int rho) { const int n = rho >> 4, i = rho & 15; return 8 * (i >> 2) + 4 * n + (i & 3); }

struct Unit { int pm, pn; };
struct Gemm { const bf16_t* A; const bf16_t* Bt; int M, N, K; };

struct StaticOrder {
    int nM, nN, nwg, G, c;
    __host__ __device__ void init(int M, int N, int G_, int c_) { nM = M / BM; nN = N / BM; nwg = nM * nN; G = G_; c = c_; }
    __host__ __device__ bool next(int i, Unit& u) const {
        const long L = (long)i * G + c; if (L >= nwg) return false;
        int wgid = (int)L; { const int q = nwg / NXCD, r = nwg % NXCD, xcd = wgid % NXCD, off = wgid / NXCD; wgid = (xcd < r ? xcd * (q + 1) : r * (q + 1) + (xcd - r) * q) + off; }
        const int nig = WGM * nN, gid = wgid / nig, fm = gid * WGM, gsz = (nM - fm) < WGM ? (nM - fm) : WGM;
        u.pm = fm + ((wgid % nig) % gsz); u.pn = (wgid % nig) / gsz; return true;
    }
    __device__ __forceinline__ void a_ready(const Unit&) const {}
    __device__ __forceinline__ void done(const Unit&) const {}
};

__device__ __forceinline__ unsigned cvt_pk_bf16(float lo, float hi) { unsigned r; asm volatile("v_cvt_pk_bf16_f32 %0, %1, %2" : "=v"(r) : "v"(lo), "v"(hi)); return r; }
typedef float f32x2 __attribute__((ext_vector_type(2)));
template <class Epi, class Sched, bool ALIGN_EPI = false, bool SP2 = false>
__device__ __forceinline__ void gemm_phase(PG8_LAS unsigned char* lds, const Gemm g, const Sched& S, const Epi& E) {
    int tid_l = threadIdx.x; asm volatile("" : "+v"(tid_l));
    const int tid = tid_l, wid = __builtin_amdgcn_readfirstlane(tid >> 6), lane = tid & 63, wr = wid >> 2, wc = wid & 3, fr = lane & 15, fq = lane >> 4;
    const int K = g.K, nt = K / BK;
    unsigned voffA[2], voffB[2];
#pragma unroll
    for (int i = 0; i < 2; ++i) { int R, C; stage_rc(tid * 16 + i * 8192, R, C); const int Rb = Epi::PERM ? ((R & ~31) + perm32(R & 31)) : R;
        voffA[i] = (unsigned)(R * K + C) * 2u; voffB[i] = (unsigned)(Rb * K + C) * 2u; }
    const size_t kstep = (size_t)(BK * 2);
    const size_t hstep = (size_t)HALF * K * 2;
    const size_t tstep = 2 * hstep;
    const unsigned ldsw = (unsigned)wid * 1024u;
    const int aoff = lds_byte(wr * 64 + fr, fq * 8), boff = lds_byte(wc * 32 + fr, fq * 8);
#define PG8_SA(b, h) (((b) * 2 + (h)) * HTB)
#define PG8_SB(b, h) ((4 + (b) * 2 + (h)) * HTB)
#define PG8_STAGE(bufoff, gbase, voff) do { _Pragma("unroll") for (int _i = 0; _i < 2; ++_i) \
        __builtin_amdgcn_global_load_lds((const unsigned*)((const char*)(gbase) + (voff)[_i]), (PG8_LAS unsigned*)(lds + (bufoff) + ldsw + _i * 8192), 16, 0, 0); } while (0)
#define PG8_LDA(dst, b, h) do { _Pragma("unroll") for (int m = 0; m < 4; ++m) _Pragma("unroll") for (int k = 0; k < 2; ++k) dst[m][k] = *(const PG8_LAS bf16x8*)(lds + PG8_SA(b, h) + aoff + m * 2048 + k * 1024); } while (0)
#define PG8_LDB(dst, b, h) do { _Pragma("unroll") for (int n = 0; n < 2; ++n) _Pragma("unroll") for (int k = 0; k < 2; ++k) dst[n][k] = *(const PG8_LAS bf16x8*)(lds + PG8_SB(b, h) + boff + n * 2048 + k * 1024); } while (0)
#define PG8_MMA(ai, bj, At, Bt) do { __builtin_amdgcn_s_setprio(1); _Pragma("unroll") for (int m = 0; m < 4; ++m) _Pragma("unroll") for (int n = 0; n < 2; ++n) _Pragma("unroll") for (int k = 0; k < 2; ++k) \
        acc[ai][bj][m][n] = __builtin_amdgcn_mfma_f32_16x16x32_bf16(Bt[n][k], At[m][k], acc[ai][bj][m][n], 0, 0, 0); __builtin_amdgcn_s_setprio(0); } while (0)
#define PG8_WAIT_V(n) asm volatile("s_waitcnt vmcnt(" #n ")" ::: "memory")
#define PG8_WAIT_L(n) asm volatile("s_waitcnt lgkmcnt(" #n ")" ::: "memory")
#define PG8_BAR __builtin_amdgcn_s_barrier()
#define PG8_SCHED __builtin_amdgcn_sched_barrier(0)
    Unit cur, nxt; int ui = 0;
    if (!S.next(0, cur)) return;
    f32x4 acc[2][2][4][2];
#pragma unroll
    for (int a = 0; a < 2; ++a)
#pragma unroll
        for (int b = 0; b < 2; ++b)
#pragma unroll
            for (int m = 0; m < 4; ++m)
#pragma unroll
                for (int n = 0; n < 2; ++n) acc[a][b][m][n] = (f32x4){0.f, 0.f, 0.f, 0.f};
    bf16x8 At[4][2], B0[2][2], B1[2][2];
    const char* cA = (const char*)g.A + (size_t)cur.pm * tstep; const char* cB = (const char*)g.Bt + (size_t)cur.pn * tstep;
    S.a_ready(cur);
    if constexpr (SP2) {
        PG8_STAGE(PG8_SB(0, 0), cB, voffB); PG8_STAGE(PG8_SB(0, 1), cB + hstep, voffB); PG8_STAGE(PG8_SA(0, 0), cA, voffA); PG8_STAGE(PG8_SA(0, 1), cA + hstep, voffA);
        if (wr == 1) PG8_BAR;
        PG8_WAIT_V(2); PG8_BAR;
        PG8_STAGE(PG8_SB(1, 0), cB + kstep, voffB); PG8_STAGE(PG8_SA(1, 0), cA + kstep, voffA); PG8_STAGE(PG8_SB(1, 1), cB + hstep + kstep, voffB);
        PG8_WAIT_V(6); PG8_BAR;
    } else {
        PG8_STAGE(PG8_SB(0, 0), cB, voffB); PG8_STAGE(PG8_SA(0, 0), cA, voffA); PG8_STAGE(PG8_SB(0, 1), cB + hstep, voffB); PG8_STAGE(PG8_SA(0, 1), cA + hstep, voffA);
        if (wr == 1) PG8_BAR;
        PG8_WAIT_V(4); PG8_BAR;
        PG8_STAGE(PG8_SB(1, 0), cB + kstep, voffB); PG8_STAGE(PG8_SA(1, 0), cA + kstep, voffA); PG8_STAGE(PG8_SB(1, 1), cB + hstep + kstep, voffB);
        PG8_WAIT_V(6); PG8_BAR;
    }
    for (;;) {
        const bool has_next = S.next(ui + 1, nxt);
        const char* nA = has_next ? (const char*)g.A + (size_t)nxt.pm * tstep : cA; const char* nB = has_next ? (const char*)g.Bt + (size_t)nxt.pn * tstep : cB;
        for (int t = 0; t < nt; t += 2) {
            const bool last = (t == nt - 2);
            const char* a1 = cA + (size_t)(t + 1) * kstep;
            const char* a2 = last ? nA : cA + (size_t)(t + 2) * kstep; const char* b2 = last ? nB : cB + (size_t)(t + 2) * kstep;
            const char* a3 = a2 + kstep; const char* b3 = b2 + kstep;
            if (last && has_next) S.a_ready(nxt);
            if constexpr (SP2) {
            PG8_LDB(B0, 0, 0); PG8_LDB(B1, 0, 1); PG8_SCHED; PG8_LDA(At, 0, 0); PG8_STAGE(PG8_SA(1, 1), a1 + hstep, voffA);
            PG8_WAIT_V(8); PG8_WAIT_L(0); PG8_BAR; PG8_MMA(0, 0, At, B0); PG8_MMA(0, 1, At, B1); PG8_BAR; PG8_SCHED;
            PG8_LDA(At, 0, 1); PG8_STAGE(PG8_SB(0, 0), b2, voffB); PG8_STAGE(PG8_SB(0, 1), b2 + hstep, voffB); PG8_STAGE(PG8_SA(0, 0), a2, voffA);
            PG8_WAIT_V(8); PG8_WAIT_L(0); PG8_BAR; PG8_MMA(1, 0, At, B0); PG8_MMA(1, 1, At, B1); PG8_BAR; PG8_SCHED;
            PG8_LDB(B0, 1, 0); PG8_LDB(B1, 1, 1); PG8_SCHED; PG8_LDA(At, 1, 0); PG8_STAGE(PG8_SA(0, 1), a2 + hstep, voffA);
            PG8_WAIT_V(8); PG8_WAIT_L(0); PG8_BAR; PG8_MMA(0, 0, At, B0); PG8_MMA(0, 1, At, B1); PG8_BAR; PG8_SCHED;
            PG8_LDA(At, 1, 1); PG8_STAGE(PG8_SB(1, 0), b3, voffB); PG8_STAGE(PG8_SB(1, 1), b3 + hstep, voffB); PG8_STAGE(PG8_SA(1, 0), a3, voffA);
            PG8_WAIT_V(8); PG8_WAIT_L(0); PG8_BAR; PG8_MMA(1, 0, At, B0); PG8_MMA(1, 1, At, B1); PG8_BAR; PG8_SCHED;
            } else {
            PG8_LDB(B0, 0, 0); PG8_SCHED; PG8_LDA(At, 0, 0); PG8_STAGE(PG8_SA(1, 1), a1 + hstep, voffA);
            PG8_WAIT_L(8); PG8_BAR; PG8_WAIT_L(0); PG8_MMA(0, 0, At, B0); PG8_BAR; PG8_SCHED;
            PG8_LDB(B1, 0, 1); PG8_STAGE(PG8_SB(0, 0), b2, voffB);
            PG8_BAR; PG8_WAIT_L(0); PG8_MMA(0, 1, At, B1); PG8_BAR;
            PG8_LDA(At, 0, 1); PG8_STAGE(PG8_SA(0, 0), a2, voffA);
            PG8_BAR; PG8_WAIT_L(0); PG8_MMA(1, 0, At, B0); PG8_BAR; PG8_SCHED;
            PG8_STAGE(PG8_SB(0, 1), b2 + hstep, voffB);
            PG8_WAIT_V(6); PG8_BAR; PG8_MMA(1, 1, At, B1); PG8_BAR;
            PG8_LDB(B0, 1, 0); PG8_SCHED; PG8_LDA(At, 1, 0); PG8_STAGE(PG8_SA(0, 1), a2 + hstep, voffA);
            PG8_WAIT_L(8); PG8_BAR; PG8_WAIT_L(0); PG8_MMA(0, 0, At, B0); PG8_BAR; PG8_SCHED;
            PG8_LDB(B1, 1, 1); PG8_STAGE(PG8_SB(1, 0), b3, voffB);
            PG8_BAR; PG8_WAIT_L(0); PG8_MMA(0, 1, At, B1); PG8_BAR;
            PG8_LDA(At, 1, 1); PG8_STAGE(PG8_SA(1, 0), a3, voffA);
            PG8_BAR; PG8_WAIT_L(0); PG8_MMA(1, 0, At, B0); PG8_BAR; PG8_SCHED;
            PG8_STAGE(PG8_SB(1, 1), b3 + hstep, voffB);
            PG8_WAIT_V(6); PG8_BAR; PG8_MMA(1, 1, At, B1); PG8_BAR;
            }
        }
        if constexpr (ALIGN_EPI) { if (wr == 0) PG8_BAR; }
        if constexpr (!Epi::AFTER_DRAIN) { E(acc, cur, wr, wc, fr, fq); S.done(cur); }
        if (!has_next) break;
#pragma unroll
        for (int a = 0; a < 2; ++a)
#pragma unroll
            for (int b = 0; b < 2; ++b)
#pragma unroll
                for (int m = 0; m < 4; ++m)
#pragma unroll
                    for (int n = 0; n < 2; ++n) acc[a][b][m][n] = (f32x4){0.f, 0.f, 0.f, 0.f};
        cur = nxt; cA = nA; cB = nB; ++ui;
        if constexpr (ALIGN_EPI) { if (wr == 1) PG8_BAR; }
    }
    PG8_WAIT_V(0);
    if constexpr (!ALIGN_EPI) { if (wr == 0) PG8_BAR; }
    PG8_BAR;
    if constexpr (Epi::AFTER_DRAIN) { E.fused(acc, cur, wr, wc, fr, fq, lds, wid, lane); S.done(cur); }
#undef PG8_SA
#undef PG8_SB
#undef PG8_STAGE
#undef PG8_LDA
#undef PG8_LDB
#undef PG8_MMA
#undef PG8_WAIT_V
#undef PG8_WAIT_L
#undef PG8_BAR
#undef PG8_SCHED
}
}
#define XB_TMO      128
#define XB_XCNT(j)  (256  + 64 * (j))
#define XB_XSUB(j)  (1280 + 64 * (j))
#define XB_XGEN(j)  (2304 + 64 * (j))
#define XB_TOP      3328
#define XB_TOPGEN   3392
#define XCD_BAR_WORDS 3456
#define XB_SPIN_CAP (1u << 18)
#define LAS __attribute__((address_space(3)))

__device__ __forceinline__ unsigned xb_ld(unsigned* p)              { return __hip_atomic_load(p, __ATOMIC_RELAXED, __HIP_MEMORY_SCOPE_AGENT); }
__device__ __forceinline__ unsigned xb_add(unsigned* p, unsigned v) { return __hip_atomic_fetch_add(p, v, __ATOMIC_RELAXED, __HIP_MEMORY_SCOPE_AGENT); }
__device__ __forceinline__ unsigned xb_xcc_id() { return (unsigned)__builtin_amdgcn_s_getreg((3 << 11) | 20) & 0xFu; }
#define XB_SPIN(cond, bar) do { unsigned _sp = 0; while (cond) { __builtin_amdgcn_s_sleep(1); \
    if ((++_sp & 255u) == 0u) { if (xb_ld(&(bar)[XB_TMO])) break; if (_sp > XB_SPIN_CAP) { atomicAdd(&(bar)[XB_TMO], 1u); break; } } } } while (0)

struct XcdBarrier {
    unsigned* bar; unsigned x;
    volatile LAS unsigned* st;
};

__device__ __forceinline__ XcdBarrier xcd_barrier_post(unsigned* bar, volatile LAS unsigned* st) {
    XcdBarrier b; b.bar = bar; b.x = xb_xcc_id(); b.st = st;
    if (threadIdx.x == 0) (void)xb_add(&bar[XB_XCNT(b.x)], 1u);
    return b;
}
__device__ __forceinline__ void xcd_barrier_complete(unsigned* bar, unsigned x, unsigned& nloc, unsigned& nx) {
    const unsigned G = gridDim.x * gridDim.y * gridDim.z;
    unsigned sum, cnt, mine, sp = 0u;
    for (;;) {
        sum = 0u; cnt = 0u; mine = 0u;
#pragma unroll
        for (unsigned j = 0; j < 16; ++j) { const unsigned c = xb_ld(&bar[XB_XCNT(j)]); sum += c; cnt += (c > 0u) ? 1u : 0u; mine = (j == x) ? c : mine; }
        if (sum == G) break;
        __builtin_amdgcn_s_sleep(1);
        if ((++sp & 255u) == 0u) { if (xb_ld(&bar[XB_TMO])) break; if (sp > XB_SPIN_CAP) { atomicAdd(&bar[XB_TMO], 1u); break; } }
    }
    nloc = mine > 0u ? mine : 1u; nx = cnt > 0u ? cnt : 1u;
}

__device__ __forceinline__ void xcd_barrier(const XcdBarrier& b) {
    asm volatile("s_waitcnt vmcnt(0)" ::: "memory");
    __syncthreads();
    if (threadIdx.x == 0) {
        unsigned* bar = b.bar;
        __builtin_amdgcn_s_waitcnt(0);
        unsigned nloc = b.st[0], nx = b.st[1];
        if (nloc == 0u) { xcd_barrier_complete(bar, b.x, nloc, nx); b.st[0] = nloc; b.st[1] = nx; }
        const unsigned old = xb_add(&bar[XB_XSUB(b.x)], 1u);
        const unsigned gen = old / nloc;
        if (old + 1u == (gen + 1u) * nloc) {
            __builtin_amdgcn_fence(__ATOMIC_RELEASE, "agent");
            asm volatile("s_waitcnt vmcnt(0)" ::: "memory");
            const unsigned og = xb_add(&bar[XB_TOP], 1u);
            const unsigned tg = og / nx;
            if (og + 1u == (tg + 1u) * nx) xb_add(&bar[XB_TOPGEN], 1u);
            else XB_SPIN(xb_ld(&bar[XB_TOPGEN]) == tg, bar);
            __builtin_amdgcn_fence(__ATOMIC_ACQUIRE, "agent");
            xb_add(&bar[XB_XGEN(b.x)], 1u);
            asm volatile("s_waitcnt vmcnt(0)" ::: "memory");
        } else {
            XB_SPIN(xb_ld(&bar[XB_XGEN(b.x)]) == gen, bar);
            __builtin_amdgcn_fence(__ATOMIC_ACQUIRE, "agent");
            asm volatile("s_waitcnt vmcnt(0)" ::: "memory");
        }
    }
    __syncthreads();
}

constexpr int DM = 2048, NB = 4, SEQ = 2048, DEPTH = 4, DB = 128, DSQ = 8;
constexpr int MP = NB * SEQ, MS = DB * DSQ, MT = MP + MS;
constexpr int S5W = 1024, S5G = 64, S5N = 64, S5C = 16;
constexpr int HW = 1024, HH = 8, HK = 128, HV = 128;
constexpr int FF = 5504, INW = 5120;
constexpr float EPS = 1e-6f;
constexpr int S5CH = 16, S5CL = SEQ / S5CH;

constexpr size_t O_Y = 0, O_REP = (size_t)MT * DM, O_IMP = O_REP + (size_t)DEPTH * NB * S5G * S5N, O_HP = O_IMP + (size_t)DEPTH * NB * S5G * S5N,
                 O_RES = O_HP + (size_t)DEPTH * NB * HH * HK * HV, O_IMS = O_RES + (size_t)DEPTH * DB * S5G * S5N, O_HS = O_IMS + (size_t)DEPTH * DB * S5G * S5N,
                 O_END = O_HS + (size_t)DEPTH * DB * HH * HK * HV;
static_assert(O_END == 92405760, "output size");

constexpr size_t MiB = 1u << 20;
constexpr size_t WS_CTL = 0, CTL_ZERO_BYTES = 1 * MiB;
constexpr size_t WS_AB = 1 * MiB;
constexpr size_t WS_BBR = WS_AB + 256 * 1024;
constexpr size_t WS_BBI = WS_BBR + 1 * MiB;
constexpr size_t WS_LB = WS_BBI + 1 * MiB;
constexpr size_t WS_RS = WS_LB + 64 * 1024;
constexpr size_t WS_S5E = WS_RS + 64 * 1024;
constexpr size_t WS_W = 16 * MiB;
constexpr size_t LW_GU1 = 0, LW_D1 = LW_GU1 + (size_t)2 * FF * DM * 2, LW_GU2 = LW_D1 + (size_t)DM * FF * 2, LW_D2 = LW_GU2 + (size_t)2 * FF * DM * 2,
                 LW_IN = LW_D2 + (size_t)DM * FF * 2, LW_GLU = LW_IN + (size_t)INW * DM * 2, LW_OUT = LW_GLU + (size_t)S5W * S5W * 2, LW_END = LW_OUT + (size_t)DM * DM * 2;
static_assert(LW_END == 166723584 && (LW_D1 % 256) == 0 && (LW_GLU % 256) == 0, "weight map");
constexpr size_t WS_HB = 656 * MiB;
constexpr size_t WS_HID = WS_HB + 36 * MiB;
constexpr size_t WS_A = WS_HID + 97 * MiB;
constexpr size_t WS_Z = WS_A + 72 * MiB;
constexpr size_t WS_CAT = WS_Z + 180 * MiB;
constexpr size_t WS_YSG = WS_CAT + 36 * MiB;
constexpr size_t WS_O = WS_YSG + 18 * MiB;
constexpr size_t WS_END = WS_O + 36 * MiB;
static_assert(WS_W + 4 * LW_END <= WS_HB && WS_S5E + 2 * MiB <= WS_W, "ws map");

constexpr int RING_BYTES = 131072, LDSCTL_OFF = RING_BYTES, LDS_BYTES = RING_BYTES + 1024;

#define GAS __attribute__((address_space(1)))
#define LAS __attribute__((address_space(3)))
typedef unsigned short bf16;
typedef float f32x4 __attribute__((ext_vector_type(4)));
typedef float f32x2 __attribute__((ext_vector_type(2)));
typedef unsigned v4u __attribute__((ext_vector_type(4)));
typedef unsigned v2u __attribute__((ext_vector_type(2)));
#define LDS_WAIT() asm volatile("s_waitcnt lgkmcnt(0)" ::: "memory")

__device__ __forceinline__ unsigned f2bf(float f) { unsigned u = __builtin_bit_cast(unsigned, f); return (u + 0x7fffu + ((u >> 16) & 1u)) >> 16; }
__device__ __forceinline__ unsigned pk2(float lo, float hi) { return f2bf(lo) | (f2bf(hi) << 16); }
__device__ __forceinline__ float bflo(unsigned w) { return __builtin_bit_cast(float, w << 16); }
__device__ __forceinline__ float bfhi(unsigned w) { return __builtin_bit_cast(float, w & 0xffff0000u); }
__device__ __forceinline__ float wave_sum(float v) {
#pragma unroll
    for (int o = 1; o < 64; o <<= 1) v += __shfl_xor(v, o);
    return v;
}
__device__ __forceinline__ float sigm(float x) { return 1.f / (1.f + __expf(-x)); }
__device__ __forceinline__ float silu(float x) { return x / (1.f + __expf(-x)); }
__device__ __forceinline__ float gelu_tanh(float v) { const float a = 0.7978845608f * (v + 0.044715f * v * v * v); const float th = 1.f - 2.f / (__expf(2.f * a) + 1.f); return 0.5f * v * (1.f + th); }

struct Args { const float* in[27]; float* out; unsigned char* ws; int ph_lo, ph_hi; };

struct EpiGU {
    static constexpr bool PERM = true, AFTER_DRAIN = false;
    bf16* O; const float* rs;
    __device__ __forceinline__ void operator()(const pg8::f32x4 (&acc)[2][2][4][2], const pg8::Unit& u, int wr, int wc, int fr, int fq) const {
        const int row0 = u.pm * 256 + wr * 64 + fr, col0 = u.pn * 128 + wc * 32 + 8 * fq;
#pragma unroll
        for (int ai = 0; ai < 2; ++ai)
#pragma unroll
            for (int m = 0; m < 4; ++m) {
                const int row = row0 + ai * 128 + m * 16; const float r = rs[row];
                float o[8];
#pragma unroll
                for (int n = 0; n < 2; ++n)
#pragma unroll
                    for (int j = 0; j < 4; ++j) { const float g = acc[ai][0][m][n][j] * r, uu = acc[ai][1][m][n][j] * r; o[4 * n + j] = silu(g) * uu; }
                v4u w; w.x = pk2(o[0], o[1]); w.y = pk2(o[2], o[3]); w.z = pk2(o[4], o[5]); w.w = pk2(o[6], o[7]);
                *(v4u*)(O + (size_t)row * FF + col0) = w;
            }
    }
};
struct EpiF32 {
    static constexpr bool PERM = false, AFTER_DRAIN = false;
    float* C; int ldc;
    __device__ __forceinline__ void operator()(const pg8::f32x4 (&acc)[2][2][4][2], const pg8::Unit& u, int wr, int wc, int fr, int fq) const {
        const int row0 = u.pm * 256 + wr * 64 + fr, col0 = u.pn * 256 + wc * 32 + 4 * fq;
#pragma unroll
        for (int ai = 0; ai < 2; ++ai)
#pragma unroll
            for (int m = 0; m < 4; ++m) { float* rowp = C + (size_t)(row0 + ai * 128 + m * 16) * ldc + col0;
#pragma unroll
                for (int bj = 0; bj < 2; ++bj)
#pragma unroll
                    for (int n = 0; n < 2; ++n) *(f32x4*)(rowp + bj * 128 + n * 16) = acc[ai][bj][m][n]; }
    }
};
struct EpiWin {
    static constexpr bool PERM = false, AFTER_DRAIN = false;
    float* Z; const float* rs; const float* lb;
    __device__ __forceinline__ void operator()(const pg8::f32x4 (&acc)[2][2][4][2], const pg8::Unit& u, int wr, int wc, int fr, int fq) const {
        const int row0 = u.pm * 256 + wr * 64 + fr, col0 = u.pn * 256 + wc * 32 + 4 * fq; const int kind = u.pn >> 2;
#pragma unroll
        for (int ai = 0; ai < 2; ++ai)
#pragma unroll
            for (int m = 0; m < 4; ++m) { const int row = row0 + ai * 128 + m * 16; const float r = rs[row]; float* rowp = Z + (size_t)row * INW + col0;
#pragma unroll
                for (int bj = 0; bj < 2; ++bj)
#pragma unroll
                    for (int n = 0; n < 2; ++n) { f32x4 v = acc[ai][bj][m][n] * r;
                        if (kind == 1) { v[0] = silu(v[0]); v[1] = silu(v[1]); v[2] = silu(v[2]); v[3] = silu(v[3]); }
                        else if (kind == 2) { const f32x4 l4 = *(const f32x4*)(lb + (col0 + bj * 128 + n * 16 - 2048));
#pragma unroll
                            for (int j = 0; j < 4; ++j) v[j] = l4[j] + (1.f - l4[j]) * sigm(v[j]); }
                        *(f32x4*)(rowp + bj * 128 + n * 16) = v; } }
    }
};
struct EpiGlu {
    static constexpr bool PERM = true, AFTER_DRAIN = false;
    bf16* CAT; const bf16* YSG; const float* bias;
    __device__ __forceinline__ void operator()(const pg8::f32x4 (&acc)[2][2][4][2], const pg8::Unit& u, int wr, int wc, int fr, int fq) const {
        const int row0 = u.pm * 256 + wr * 64 + fr, col0 = u.pn * 256 + wc * 32 + 8 * fq;
        f32x4 bv[2][2];
#pragma unroll
        for (int bj = 0; bj < 2; ++bj)
#pragma unroll
            for (int n = 0; n < 2; ++n) bv[bj][n] = *(const f32x4*)(bias + col0 + bj * 128 + 4 * n);
#pragma unroll
        for (int ai = 0; ai < 2; ++ai)
#pragma unroll
            for (int m = 0; m < 4; ++m) { const int row = row0 + ai * 128 + m * 16;
#pragma unroll
                for (int bj = 0; bj < 2; ++bj) { const int col = col0 + bj * 128;
                    const v4u y = *(const v4u*)(YSG + (size_t)row * S5W + col);
                    const f32x4 t0 = acc[ai][bj][m][0] + bv[bj][0], t1 = acc[ai][bj][m][1] + bv[bj][1];
                    v4u w; w.x = pk2(bflo(y.x) * sigm(t0[0]), bfhi(y.x) * sigm(t0[1])); w.y = pk2(bflo(y.y) * sigm(t0[2]), bfhi(y.y) * sigm(t0[3]));
                    w.z = pk2(bflo(y.z) * sigm(t1[0]), bfhi(y.z) * sigm(t1[1])); w.w = pk2(bflo(y.w) * sigm(t1[2]), bfhi(y.w) * sigm(t1[3]));
                    *(v4u*)(CAT + (size_t)row * DM + col) = w; } }
    }
};

__device__ __forceinline__ void tr_item(const float* W, int ldw, int j0, int k0, const float* gain, bf16* WT, int K, int n0d, LAS float* scr, int lane) {
#pragma unroll 8
    for (int i = 0; i < 32; ++i) { const int kk = 2 * i + (lane >> 5); float v = W[(size_t)(k0 + kk) * ldw + j0 + (lane & 31)]; if (gain) v *= gain[k0 + kk]; scr[kk * 33 + (lane & 31)] = v; }
    LDS_WAIT(); asm volatile("" ::: "memory");
    const int c = lane & 7;
#pragma unroll
    for (int j = 0; j < 4; ++j) { const int n = (lane >> 3) + 8 * j; const LAS float* s = scr + (8 * c) * 33 + n;
        v4u o; o.x = pk2(s[0 * 33], s[1 * 33]); o.y = pk2(s[2 * 33], s[3 * 33]); o.z = pk2(s[4 * 33], s[5 * 33]); o.w = pk2(s[6 * 33], s[7 * 33]);
        *(v4u*)(WT + (size_t)(n0d + n) * K + k0 + 8 * c) = o; }
    LDS_WAIT(); asm volatile("" ::: "memory");
}
__device__ __forceinline__ void p0_prologue(const Args& a, LAS unsigned char* lds, int G, int bid, int tid) {
    const int wave = __builtin_amdgcn_readfirstlane(tid >> 6), lane = tid & 63;
    LAS float* scr = (LAS float*)(lds + wave * 16384);
    const int gw = bid * 8 + wave, NGW = G * 8;
    constexpr int I_GU = 32 * 344, I_D = 86 * 64, I_IN = 32 * 160, I_GLU = 16 * 32, I_OUT = 32 * 64, I_L = 2 * I_GU + 2 * I_D + I_IN + I_GLU + I_OUT;
    for (int it = gw; it < DEPTH * I_L; it += NGW) {
        const int l = it / I_L; int r = it - l * I_L;
        unsigned char* wl = a.ws + WS_W + (size_t)l * LW_END;
        if (r < 2 * I_GU) { const int f = r / I_GU; r -= f * I_GU; const int kb = r / 344, nb = r % 344, pn = nb >> 3, rr = nb & 7;
            const float* src = (rr < 4 ? a.in[f ? 10 : 7] : a.in[f ? 11 : 8]) + (size_t)l * DM * FF;
            tr_item(src, FF, 128 * pn + 32 * (rr & 3), 64 * kb, a.in[5] + (size_t)(l * 3 + (f ? 2 : 0)) * DM, (bf16*)(wl + (f ? LW_GU2 : LW_GU1)), DM, 32 * nb, scr, lane); continue; }
        r -= 2 * I_GU;
        if (r < 2 * I_D) { const int f = r / I_D; r -= f * I_D; const int kb = r / 64, nb = r % 64;
            tr_item(a.in[f ? 12 : 9] + (size_t)l * FF * DM, DM, 32 * nb, 64 * kb, nullptr, (bf16*)(wl + (f ? LW_D2 : LW_D1)), FF, 32 * nb, scr, lane); continue; }
        r -= 2 * I_D;
        if (r < I_IN) { const int kb = r / 160, nb = r % 160;
            tr_item(a.in[13] + (size_t)l * DM * INW, INW, 32 * nb, 64 * kb, a.in[5] + (size_t)(l * 3 + 1) * DM, (bf16*)(wl + LW_IN), DM, 32 * nb, scr, lane); continue; }
        r -= I_IN;
        if (r < I_GLU) { const int kb = r / 32, nb = r % 32;
            tr_item(a.in[23] + (size_t)l * S5W * S5W, S5W, 32 * nb, 64 * kb, nullptr, (bf16*)(wl + LW_GLU), S5W, 32 * nb, scr, lane); continue; }
        r -= I_GLU;
        { const int kb = r / 64, nb = r % 64;
            tr_item(a.in[14] + (size_t)l * DM * DM, DM, 32 * nb, 64 * kb, nullptr, (bf16*)(wl + LW_OUT), DM, 32 * nb, scr, lane); }
    }
    for (int idx = bid * 512 + tid; idx < DEPTH * S5G * S5N; idx += G * 512) {
        const int lg = idx / S5N;
        const float lr = a.in[15][idx], li = a.in[16][idx], dt = expf(a.in[17][lg]);
        const float mag = expf(lr * dt), ang = li * dt;
        const float are = mag * cosf(ang), aim = mag * sinf(ang);
        const float p = are - 1.f, q = aim, den = lr * lr + li * li;
        const float zre = (p * lr + q * li) / den, zim = (q * lr - p * li) / den;
        ((f32x2*)(a.ws + WS_AB))[idx] = (f32x2){are, aim};
        const f32x4* br = (const f32x4*)(a.in[18] + (size_t)idx * 16); const f32x4* bi = (const f32x4*)(a.in[19] + (size_t)idx * 16);
        f32x4* obr = (f32x4*)(a.ws + WS_BBR) + (size_t)idx * 4; f32x4* obi = (f32x4*)(a.ws + WS_BBI) + (size_t)idx * 4;
#pragma unroll
        for (int c = 0; c < 4; ++c) { const f32x4 r4 = br[c], i4 = bi[c]; obr[c] = zre * r4 - zim * i4; obi[c] = zre * i4 + zim * r4; }
    }
    for (int idx = bid * 512 + tid; idx < HW; idx += G * 512) {
        const float x0 = a.in[25][idx], x1 = a.in[25][HW + idx], x2 = a.in[25][2 * HW + idx], x3 = a.in[25][3 * HW + idx];
        const float mx = fmaxf(fmaxf(x0, x1), fmaxf(x2, x3));
        const float e0 = expf(x0 - mx), e1 = expf(x1 - mx), e2 = expf(x2 - mx), e3 = expf(x3 - mx), inv = 1.f / (e0 + e1 + e2 + e3);
        float* lb = (float*)(a.ws + WS_LB);
        lb[idx] = 0.f; lb[HW + idx] = e1 * inv; lb[2 * HW + idx] = (e1 + e2) * inv; lb[3 * HW + idx] = (e1 + e2 + e3) * inv;
    }
    for (int row = gw; row < MT; row += NGW) {
        const float* xr = row < MP ? a.in[0] + (size_t)row * DM : a.in[1] + (size_t)(row - MP) * DM;
        float* hr = a.out + O_Y + (size_t)row * DM; bf16* hb = (bf16*)(a.ws + WS_HB) + (size_t)row * DM;
        float ss = 0.f;
#pragma unroll
        for (int j = 0; j < 8; ++j) { const f32x4 v = *(const f32x4*)(xr + 4 * lane + 256 * j); ss += (v[0] * v[0] + v[1] * v[1]) + (v[2] * v[2] + v[3] * v[3]);
            *(f32x4*)(hr + 4 * lane + 256 * j) = v; v2u w; w.x = pk2(v[0], v[1]); w.y = pk2(v[2], v[3]); *(v2u*)(hb + 4 * lane + 256 * j) = w; }
        ss = wave_sum(ss);
        if (lane == 0) ((float*)(a.ws + WS_RS))[row] = 1.f / sqrtf(ss * (1.f / DM) + EPS);
    }
}

__device__ __forceinline__ void norm_res_phase(const Args& a, const float* gain, float coef, int G, int bid, int tid) {
    const int wave = __builtin_amdgcn_readfirstlane(tid >> 6), lane = tid & 63;
    const int gw = bid * 8 + wave, NGW = G * 8;
    f32x4 gv[8];
#pragma unroll
    for (int j = 0; j < 8; ++j) gv[j] = *(const f32x4*)(gain + 4 * lane + 256 * j) * coef;
    for (int row = gw; row < MT; row += NGW) {
        const float* ar = (const float*)(a.ws + WS_A) + (size_t)row * DM; float* hr = a.out + O_Y + (size_t)row * DM; bf16* hb = (bf16*)(a.ws + WS_HB) + (size_t)row * DM;
        f32x4 av[8], hv[8]; float ss = 0.f;
#pragma unroll
        for (int j = 0; j < 8; ++j) { av[j] = *(const f32x4*)(ar + 4 * lane + 256 * j); hv[j] = *(const f32x4*)(hr + 4 * lane + 256 * j);
            ss += (av[j][0] * av[j][0] + av[j][1] * av[j][1]) + (av[j][2] * av[j][2] + av[j][3] * av[j][3]); }
        ss = wave_sum(ss);
        const float ra = 1.f / sqrtf(ss * (1.f / DM) + EPS);
        float s2 = 0.f;
#pragma unroll
        for (int j = 0; j < 8; ++j) { const f32x4 v = hv[j] + av[j] * gv[j] * ra; s2 += (v[0] * v[0] + v[1] * v[1]) + (v[2] * v[2] + v[3] * v[3]);
            *(f32x4*)(hr + 4 * lane + 256 * j) = v; v2u w; w.x = pk2(v[0], v[1]); w.y = pk2(v[2], v[3]); *(v2u*)(hb + 4 * lane + 256 * j) = w; }
        s2 = wave_sum(s2);
        if (lane == 0) ((float*)(a.ws + WS_RS))[row] = 1.f / sqrtf(s2 * (1.f / DM) + EPS);
    }
}

struct S5P { float are, aim; float bbr[16], bbi[16]; };
__device__ __forceinline__ void s5_load(const Args& a, int l, int g, int lane, S5P& p) {
    const int idx = (l * S5G + g) * S5N + lane;
    const f32x2 ab = ((const f32x2*)(a.ws + WS_AB))[idx]; p.are = ab[0]; p.aim = ab[1];
    const f32x4* br = (const f32x4*)(a.ws + WS_BBR) + (size_t)idx * 4; const f32x4* bi = (const f32x4*)(a.ws + WS_BBI) + (size_t)idx * 4;
#pragma unroll
    for (int c = 0; c < 4; ++c) { const f32x4 r4 = br[c], i4 = bi[c];
#pragma unroll
        for (int j = 0; j < 4; ++j) { p.bbr[4 * c + j] = r4[j]; p.bbi[4 * c + j] = i4[j]; } }
}
__device__ __forceinline__ void s5_step(const S5P& p, float um, float& xr, float& xi) {
    float br = 0.f, bi = 0.f;
#pragma unroll
    for (int c = 0; c < 16; ++c) { const float uc = __builtin_bit_cast(float, __builtin_amdgcn_readlane(__builtin_bit_cast(int, um), c)); br += p.bbr[c] * uc; bi += p.bbi[c] * uc; }
    const float nr = p.are * xr - p.aim * xi + br, ni = p.are * xi + p.aim * xr + bi;
    xr = nr; xi = ni;
}
__device__ __forceinline__ void s5_pass1_item(const Args& a, int l, int item, int lane) {
    const int ch = item % S5CH, g = (item / S5CH) % S5G, b = item / (S5CH * S5G);
    S5P p; s5_load(a, l, g, lane, p);
    const float* zp = (const float*)(a.ws + WS_Z) + (size_t)(b * SEQ + ch * S5CL) * INW + 16 * g + (lane & 15);
    float xr = 0.f, xi = 0.f;
    for (int tb = 0; tb < S5CL; tb += 8) {
        float um[8];
#pragma unroll
        for (int j = 0; j < 8; ++j) um[j] = zp[(size_t)(tb + j) * INW];
#pragma unroll
        for (int j = 0; j < 8; ++j) s5_step(p, um[j], xr, xi);
    }
    ((f32x2*)(a.ws + WS_S5E))[((b * S5G + g) * S5CH + ch) * S5N + lane] = (f32x2){xr, xi};
}
__device__ __forceinline__ float reduce16(const float (&p)[16], int lane) {
    float r8[8], r4[4], r2[2];
    { const bool hi = lane & 8;
#pragma unroll
      for (int i = 0; i < 8; ++i) { const float send = hi ? p[i] : p[i + 8], keep = hi ? p[i + 8] : p[i]; r8[i] = keep + __shfl_xor(send, 8); } }
    { const bool hi = lane & 4;
#pragma unroll
      for (int i = 0; i < 4; ++i) { const float send = hi ? r8[i] : r8[i + 4], keep = hi ? r8[i + 4] : r8[i]; r4[i] = keep + __shfl_xor(send, 4); } }
    { const bool hi = lane & 2;
#pragma unroll
      for (int i = 0; i < 2; ++i) { const float send = hi ? r4[i] : r4[i + 2], keep = hi ? r4[i + 2] : r4[i]; r2[i] = keep + __shfl_xor(send, 2); } }
    float r;
    { const bool hi = lane & 1; const float send = hi ? r2[0] : r2[1], keep = hi ? r2[1] : r2[0]; r = keep + __shfl_xor(send, 1); }
    r += __shfl_xor(r, 16); r += __shfl_xor(r, 32);
    return r;
}
__device__ __forceinline__ void s5_pass2_item(const Args& a, int l, int item, int lane) {
    int g, b, ch, row0, nsteps; bool sample = item >= NB * S5G * S5CH;
    if (!sample) { ch = item % S5CH; g = (item / S5CH) % S5G; b = item / (S5CH * S5G); row0 = b * SEQ + ch * S5CL; nsteps = S5CL; }
    else { const int it = item - NB * S5G * S5CH; g = it % S5G; b = it / S5G; ch = 0; row0 = MP + b * DSQ; nsteps = DSQ; }
    S5P p; s5_load(a, l, g, lane, p);
    float cre[16], cim[16];
#pragma unroll
    for (int c = 0; c < 16; ++c) { cre[c] = a.in[20][(size_t)((l * S5G + g) * S5C + c) * S5N + lane]; cim[c] = a.in[21][(size_t)((l * S5G + g) * S5C + c) * S5N + lane]; }
    float xr = 0.f, xi = 0.f;
    if (!sample) {
        float pr = p.are, pi = p.aim;
#pragma unroll
        for (int s = 0; s < 7; ++s) { const float nr = pr * pr - pi * pi, ni = 2.f * pr * pi; pr = nr; pi = ni; }
        const f32x2* E = (const f32x2*)(a.ws + WS_S5E) + (size_t)((b * S5G + g) * S5CH) * S5N + lane;
        for (int j = 0; j < ch; ++j) { const f32x2 e = E[j * S5N]; const float nr = pr * xr - pi * xi + e[0], ni = pr * xi + pi * xr + e[1]; xr = nr; xi = ni; }
    } else {
        const size_t si = (size_t)((l * DB + b) * S5G + g) * S5N + lane; xr = a.in[2][si]; xi = a.in[3][si];
    }
    const float dm = a.in[22][(size_t)l * S5W + 16 * g + (lane & 15)];
    const float* zp = (const float*)(a.ws + WS_Z) + (size_t)row0 * INW + 16 * g + (lane & 15);
    bf16* yp = (bf16*)(a.ws + WS_YSG) + (size_t)row0 * S5W + 16 * g + (lane & 15);
    for (int tb = 0; tb < nsteps; tb += 8) {
        float um[8];
#pragma unroll
        for (int j = 0; j < 8; ++j) um[j] = zp[(size_t)(tb + j) * INW];
#pragma unroll
        for (int j = 0; j < 8; ++j) {
            s5_step(p, um[j], xr, xi);
            float pp[16];
#pragma unroll
            for (int c = 0; c < 16; ++c) pp[c] = xr * cre[c] - xi * cim[c];
            const float y = reduce16(pp, lane);
            if (lane < 16) yp[(size_t)(tb + j) * S5W] = (bf16)f2bf(gelu_tanh(y + dm * um[j]));
        }
    }
    if (!sample) { if (ch == S5CH - 1) { const size_t so = (size_t)((l * NB + b) * S5G + g) * S5N + lane; a.out[O_REP + so] = xr; a.out[O_IMP + so] = xi; } }
    else { const size_t so = (size_t)((l * DB + b) * S5G + g) * S5N + lane; a.out[O_RES + so] = xr; a.out[O_IMS + so] = xi; }
}

__device__ __forceinline__ void hgrn_prompt_item(const Args& a, int l, int item, int lane) {
    const int vg = item & 31, h = (item >> 5) & 7, b = item >> 8;
    const int kq = lane >> 2, vv = lane & 3, v0 = 4 * vg;
    const float* zb = (const float*)(a.ws + WS_Z) + (size_t)(b * SEQ) * INW + h * HK;
    const float* zq = zb + 1024 + kq * 8; const float* zf = zb + 2048 + kq * 8; const float* zv = zb + 3072 + v0 + vv;
    float* op = (float*)(a.ws + WS_O) + (size_t)(b * SEQ) * HW + h * HV + v0 + vv;
    float S[8];
#pragma unroll
    for (int i = 0; i < 8; ++i) S[i] = 0.f;
    f32x4 cq[4][2], cf[4][2]; float cv[4];
#pragma unroll
    for (int j = 0; j < 4; ++j) { cq[j][0] = *(const f32x4*)(zq + (size_t)j * INW); cq[j][1] = *(const f32x4*)(zq + (size_t)j * INW + 4);
        cf[j][0] = *(const f32x4*)(zf + (size_t)j * INW); cf[j][1] = *(const f32x4*)(zf + (size_t)j * INW + 4); cv[j] = zv[(size_t)j * INW]; }
    for (int t0 = 0; t0 < SEQ; t0 += 4) {
        f32x4 nq[4][2], nf[4][2]; float nv[4];
        const int tn = (t0 + 4 < SEQ) ? t0 + 4 : t0;
#pragma unroll
        for (int j = 0; j < 4; ++j) { nq[j][0] = *(const f32x4*)(zq + (size_t)(tn + j) * INW); nq[j][1] = *(const f32x4*)(zq + (size_t)(tn + j) * INW + 4);
            nf[j][0] = *(const f32x4*)(zf + (size_t)(tn + j) * INW); nf[j][1] = *(const f32x4*)(zf + (size_t)(tn + j) * INW + 4); nv[j] = zv[(size_t)(tn + j) * INW]; }
#pragma unroll
        for (int j = 0; j < 4; ++j) {
            float acc = 0.f;
#pragma unroll
            for (int i = 0; i < 8; ++i) { const float f = cf[j][i >> 2][i & 3], q = cq[j][i >> 2][i & 3]; S[i] = f * S[i] + (1.f - f) * cv[j]; acc += S[i] * q; }
            acc += __shfl_xor(acc, 4); acc += __shfl_xor(acc, 8); acc += __shfl_xor(acc, 16); acc += __shfl_xor(acc, 32);
            if (lane < 4) op[(size_t)(t0 + j) * HW] = acc;
        }
#pragma unroll
        for (int j = 0; j < 4; ++j) { cq[j][0] = nq[j][0]; cq[j][1] = nq[j][1]; cf[j][0] = nf[j][0]; cf[j][1] = nf[j][1]; cv[j] = nv[j]; }
    }
    float* sp = a.out + O_HP + ((size_t)((l * NB + b) * HH + h) * HK + kq * 8) * HV + v0 + vv;
#pragma unroll
    for (int i = 0; i < 8; ++i) sp[(size_t)i * HV] = S[i];
}
__device__ __forceinline__ void hgrn_sample_item(const Args& a, int l, int item, LAS unsigned char* lds, int tid) {
    const int h = item & 7, b = item >> 3, kq = tid >> 5, v4 = tid & 31;
    LAS float* red = (LAS float*)lds;
    const float* s0 = a.in[4] + ((size_t)((l * DB + b) * HH + h) * HK + kq * 8) * HV + 4 * v4;
    float* s1 = a.out + O_HS + ((size_t)((l * DB + b) * HH + h) * HK + kq * 8) * HV + 4 * v4;
    f32x4 S[8];
#pragma unroll
    for (int i = 0; i < 8; ++i) S[i] = *(const f32x4*)(s0 + (size_t)i * HV);
    const float* zb = (const float*)(a.ws + WS_Z) + (size_t)(MP + b * DSQ) * INW + h * HK;
#pragma unroll
    for (int t = 0; t < DSQ; ++t) {
        const float* zr = zb + (size_t)t * INW;
        const f32x4 q0 = *(const f32x4*)(zr + 1024 + kq * 8), q1 = *(const f32x4*)(zr + 1024 + kq * 8 + 4);
        const f32x4 f0 = *(const f32x4*)(zr + 2048 + kq * 8), f1 = *(const f32x4*)(zr + 2048 + kq * 8 + 4);
        const f32x4 vv = *(const f32x4*)(zr + 3072 + 4 * v4);
        f32x4 acc = (f32x4){0.f, 0.f, 0.f, 0.f};
#pragma unroll
        for (int i = 0; i < 8; ++i) { const float f = i < 4 ? f0[i & 3] : f1[i & 3], q = i < 4 ? q0[i & 3] : q1[i & 3]; S[i] = S[i] * f + vv * (1.f - f); acc += S[i] * q; }
        *(LAS f32x4*)(red + (t * 16 + kq) * 128 + 4 * v4) = acc;
    }
#pragma unroll
    for (int i = 0; i < 8; ++i) *(f32x4*)(s1 + (size_t)i * HV) = S[i];
    __syncthreads();
#pragma unroll
    for (int e = 0; e < 2; ++e) { const int idx = tid + 512 * e, t = idx >> 7, v = idx & 127; float s = 0.f;
#pragma unroll
        for (int k = 0; k < 16; ++k) s += red[(t * 16 + k) * 128 + v];
        ((float*)(a.ws + WS_O))[(size_t)(MP + b * DSQ + t) * HW + h * HV + v] = s; }
    __syncthreads();
}
__device__ __forceinline__ void hgrn_post_item(const Args& a, int l, int item, int lane) {
    const int h = item & 7, row = item >> 3;
    const f32x2 o = *(const f32x2*)((const float*)(a.ws + WS_O) + (size_t)row * HW + h * HV + 2 * lane);
    const float ss = wave_sum(o[0] * o[0] + o[1] * o[1]);
    const float r = 1.f / sqrtf(ss * (1.f / HV) + EPS);
    const f32x2 gg = *(const f32x2*)((const float*)(a.ws + WS_Z) + (size_t)row * INW + 4096 + h * HV + 2 * lane);
    const f32x2 gn = *(const f32x2*)(a.in[26] + (size_t)l * HW + h * HV + 2 * lane);
    *(unsigned*)((bf16*)(a.ws + WS_CAT) + (size_t)row * DM + 1024 + h * HV + 2 * lane) = pk2(o[0] * r * gn[0] * silu(gg[0]), o[1] * r * gn[1] * silu(gg[1]));
}

constexpr int PH_PER_LAYER = 12, N_PHASES = 1 + DEPTH * PH_PER_LAYER;
#ifndef MK_PER_PHASE
#define MK_PER_PHASE 0
#endif

__global__ void __launch_bounds__(512, 2) mega(Args args) {
    extern __shared__ __attribute__((aligned(16))) unsigned char lds_raw[];
    LAS unsigned char* lds = (LAS unsigned char*)lds_raw;
    const int tid = threadIdx.x, lane = tid & 63, wave = __builtin_amdgcn_readfirstlane(tid >> 6);
    const int G = gridDim.x, bid = blockIdx.x;
    volatile LAS unsigned* MISC = (volatile LAS unsigned*)(lds + LDSCTL_OFF);
    if (tid < 64) MISC[tid] = 0u;
    __syncthreads();
    const int lo = args.ph_lo, hi = args.ph_hi;
    XcdBarrier bar; bar.bar = (unsigned*)(args.ws + WS_CTL) + 4096; bar.x = 0; bar.st = nullptr;
    if (hi - lo > 1) bar = xcd_barrier_post((unsigned*)(args.ws + WS_CTL) + 4096, MISC + 8);
#define IN(k) (lo <= (k) && (k) < hi)
#define TIDL() int tidl = tid; asm volatile("" : "+v"(tidl)); const int lanel = tidl & 63, wavel = __builtin_amdgcn_readfirstlane(tidl >> 6); (void)lanel; (void)wavel
#define SEAM(k) do { if (IN((k) + 1)) xcd_barrier(bar); } while (0)

    if (IN(0)) { TIDL(); p0_prologue(args, lds, G, bid, tidl); SEAM(0); }

    for (int l = 0; l < DEPTH; ++l) {
        const int pb = 1 + l * PH_PER_LAYER;
        unsigned char* wl = args.ws + WS_W + (size_t)l * LW_END;
        const bf16* HB = (const bf16*)(args.ws + WS_HB); bf16* HID = (bf16*)(args.ws + WS_HID); float* A = (float*)(args.ws + WS_A); float* Z = (float*)(args.ws + WS_Z);
        const float* RS = (const float*)(args.ws + WS_RS);
#define FFN_PHASES(f) do { const int p0 = pb + ((f) ? 9 : 0); \
            if (IN(p0)) { pg8::Gemm g{HB, (const bf16*)(wl + ((f) ? LW_GU2 : LW_GU1)), MT, 2 * FF, DM}; pg8::StaticOrder S; S.init(MT, 2 * FF, G, bid); \
                EpiGU E{HID, RS}; pg8::gemm_phase<EpiGU, pg8::StaticOrder, true, true>(lds, g, S, E); SEAM(p0); } \
            if (IN(p0 + 1)) { pg8::Gemm g{HID, (const bf16*)(wl + ((f) ? LW_D2 : LW_D1)), MT, DM, FF}; pg8::StaticOrder S; S.init(MT, DM, G, bid); \
                EpiF32 E{A, DM}; pg8::gemm_phase<EpiF32, pg8::StaticOrder, true, true>(lds, g, S, E); SEAM(p0 + 1); } \
            if (IN(p0 + 2)) { TIDL(); norm_res_phase(args, args.in[6] + (size_t)(l * 3 + ((f) ? 2 : 0)) * DM, 0.5f, G, bid, tidl); SEAM(p0 + 2); } } while (0)
        FFN_PHASES(0);
        if (IN(pb + 3)) { pg8::Gemm g{HB, (const bf16*)(wl + LW_IN), MT, INW, DM}; pg8::StaticOrder S; S.init(MT, INW, G, bid);
            EpiWin E{Z, RS, (const float*)(args.ws + WS_LB) + (size_t)l * HW}; pg8::gemm_phase<EpiWin, pg8::StaticOrder, true, true>(lds, g, S, E); SEAM(pb + 3); }
        if (IN(pb + 4)) {
            TIDL();
            if (wavel < 4) { for (int it = bid * 4 + wavel; it < NB * HH * 32; it += G * 4) hgrn_prompt_item(args, l, it, lanel); }
            else { for (int it = bid * 4 + (wavel - 4); it < NB * S5G * S5CH; it += G * 4) s5_pass1_item(args, l, it, lanel); }
            __syncthreads();
            for (int it = bid; it < DB * HH; it += G) hgrn_sample_item(args, l, it, lds, tidl);
            SEAM(pb + 4); }
        if (IN(pb + 5)) {
            TIDL(); const int n5 = NB * S5G * S5CH + DB * S5G, npost = MT * HH;
            for (int it = bid * 8 + wavel; it < n5 + npost; it += G * 8) { if (it < n5) s5_pass2_item(args, l, it, lanel); else hgrn_post_item(args, l, it - n5, lanel); }
            SEAM(pb + 5); }
        if (IN(pb + 6)) { pg8::Gemm g{(const bf16*)(args.ws + WS_YSG), (const bf16*)(wl + LW_GLU), MT, S5W, S5W}; pg8::StaticOrder S; S.init(MT, S5W, G, bid);
            EpiGlu E{(bf16*)(args.ws + WS_CAT), (const bf16*)(args.ws + WS_YSG), args.in[24] + (size_t)l * S5W}; pg8::gemm_phase<EpiGlu, pg8::StaticOrder, true, true>(lds, g, S, E); SEAM(pb + 6); }
        if (IN(pb + 7)) { pg8::Gemm g{(const bf16*)(args.ws + WS_CAT), (const bf16*)(wl + LW_OUT), MT, DM, DM}; pg8::StaticOrder S; S.init(MT, DM, G, bid);
            EpiF32 E{A, DM}; pg8::gemm_phase<EpiF32, pg8::StaticOrder, true, true>(lds, g, S, E); SEAM(pb + 7); }
        if (IN(pb + 8)) { TIDL(); norm_res_phase(args, args.in[6] + (size_t)(l * 3 + 1) * DM, 1.0f, G, bid, tidl); SEAM(pb + 8); }
        FFN_PHASES(1);
    }
#undef IN
#undef SEAM
}

extern "C" void kernel_launch(void* const* d_in, const int* in_sizes, int n_in, void* d_out, int out_size, void* d_ws, size_t ws_size, hipStream_t stream) {
    static int grid = 0;
    if (grid == 0) {
        if (n_in != 27 || out_size != (int)O_END || ws_size < WS_END) { fprintf(stderr, "kernel_launch: unexpected shapes: n_in %d out %d ws %zu (need %zu)\n", n_in, out_size, ws_size, (size_t)WS_END); grid = -1; return; }
        int dev = 0, cus = 0, per_cu = 0;
        if (hipGetDevice(&dev) != hipSuccess || hipDeviceGetAttribute(&cus, hipDeviceAttributeMultiprocessorCount, dev) != hipSuccess) { grid = -1; return; }
        if (hipFuncSetAttribute((const void*)mega, hipFuncAttributeMaxDynamicSharedMemorySize, LDS_BYTES) != hipSuccess) { fprintf(stderr, "kernel_launch: hipFuncSetAttribute failed\n"); grid = -1; return; }
        if (hipOccupancyMaxActiveBlocksPerMultiprocessor(&per_cu, (const void*)mega, 512, LDS_BYTES) != hipSuccess || per_cu < 1) fprintf(stderr, "kernel_launch: occupancy query reports %d\n", per_cu);
        (void)hipGetLastError();
        grid = cus;
    }
    if (grid < 0) return;
    (void)hipMemsetAsync((char*)d_ws + WS_CTL, 0, CTL_ZERO_BYTES, stream);
    Args a{};
    for (int i = 0; i < 27; ++i) a.in[i] = (const float*)d_in[i];
    a.out = (float*)d_out; a.ws = (unsigned char*)d_ws;
#if MK_PER_PHASE
    for (int p = 0; p < N_PHASES; ++p) { a.ph_lo = p; a.ph_hi = p + 1; hipLaunchKernelGGL(mega, dim3(grid), dim3(512), LDS_BYTES, stream, a); }
#else
    a.ph_lo = 0; a.ph_hi = N_PHASES; hipLaunchKernelGGL(mega, dim3(grid), dim3(512), LDS_BYTES, stream, a);
#endif
}
```

```cpp
#include <hip/hip_runtime.h>
#include <cstdio>
#include <cstdint>
namespace pg8 {
#define PG8_LAS __attribute__((address_space(3)))
typedef unsigned short bf16_t;
typedef short bf16x8 __attribute__((ext_vector_type(8)));
typedef float f32x4 __attribute__((ext_vector_type(4)));
typedef unsigned u32x4 __attribute__((ext_vector_type(4)));
constexpr int BM = 256, BK = 64, HALF = 128, HTB = HALF * BK * 2  , STAGE_BYTES = 8 * HTB, NXCD = 8, WGM = 8;

__host__ __device__ __forceinline__ int lds_byte(int r, int c) { const int st = (r >> 4) * 2 + (c >> 5), rr = r & 15, cc = c & 31, ob = rr * 64 + cc * 2; return st * 1024 + (ob ^ (((ob >> 9) & 1) << 5)); }
__host__ __device__ __forceinline__ void stage_rc(int b, int& R, int& C) { const int st = b / 1024, sb = b % 1024, swz = sb ^ (((sb >> 9) & 1) << 5); R = (st >> 1) * 16 + swz / 64; C = (st & 1) * 32 + (swz % 64) / 2; }
__host__ __device__ __forceinline__ int perm32(int rho) { const int n = rho >> 4, i = rho & 15; return 8 * (i >> 2) + 4 * n + (i & 3); }

struct Unit { int pm, pn; };
struct Gemm { const bf16_t* A; const bf16_t* Bt; int M, N, K; };

struct StaticOrder {
    int nM, nN, nwg, G, c;
    __host__ __device__ void init(int M, int N, int G_, int c_) { nM = M / BM; nN = N / BM; nwg = nM * nN; G = G_; c = c_; }
    __host__ __device__ bool next(int i, Unit& u) const {
        const long L = (long)i * G + c; if (L >= nwg) return false;
        int wgid = (int)L; { const int q = nwg / NXCD, r = nwg % NXCD, xcd = wgid % NXCD, off = wgid / NXCD; wgid = (xcd < r ? xcd * (q + 1) : r * (q + 1) + (xcd - r) * q) + off; }
        const int nig = WGM * nN, gid = wgid / nig, fm = gid * WGM, gsz = (nM - fm) < WGM ? (nM - fm) : WGM;
        u.pm = fm + ((wgid % nig) % gsz); u.pn = (wgid % nig) / gsz; return true;
    }
    __device__ __forceinline__ void a_ready(const Unit&) const {}
    __device__ __forceinline__ void done(const Unit&) const {}
};

__device__ __forceinline__ unsigned cvt_pk_bf16(float lo, float hi) { unsigned r; asm volatile("v_cvt_pk_bf16_f32 %0, %1, %2" : "=v"(r) : "v"(lo), "v"(hi)); return r; }
typedef float f32x2 __attribute__((ext_vector_type(2)));
template <class Epi, class Sched, bool ALIGN_EPI = false, bool SP2 = false>
__device__ __forceinline__ void gemm_phase(PG8_LAS unsigned char* lds, const Gemm g, const Sched& S, const Epi& E) {
    int tid_l = threadIdx.x; asm volatile("" : "+v"(tid_l));
    const int tid = tid_l, wid = __builtin_amdgcn_readfirstlane(tid >> 6), lane = tid & 63, wr = wid >> 2, wc = wid & 3, fr = lane & 15, fq = lane >> 4;
    const int K = g.K, nt = K / BK;
    unsigned voffA[2], voffB[2];
#pragma unroll
    for (int i = 0; i < 2; ++i) { int R, C; stage_rc(tid * 16 + i * 8192, R, C); const int Rb = Epi::PERM ? ((R & ~31) + perm32(R & 31)) : R;
        voffA[i] = (unsigned)(R * K + C) * 2u; voffB[i] = (unsigned)(Rb * K + C) * 2u; }
    const size_t kstep = (size_t)(BK * 2);
    const size_t hstep = (size_t)HALF * K * 2;
    const size_t tstep = 2 * hstep;
    const unsigned ldsw = (unsigned)wid * 1024u;
    const int aoff = lds_byte(wr * 64 + fr, fq * 8), boff = lds_byte(wc * 32 + fr, fq * 8);
#define PG8_SA(b, h) (((b) * 2 + (h)) * HTB)
#define PG8_SB(b, h) ((4 + (b) * 2 + (h)) * HTB)
#define PG8_STAGE(bufoff, gbase, voff) do { _Pragma("unroll") for (int _i = 0; _i < 2; ++_i) \
        __builtin_amdgcn_global_load_lds((const unsigned*)((const char*)(gbase) + (voff)[_i]), (PG8_LAS unsigned*)(lds + (bufoff) + ldsw + _i * 8192), 16, 0, 0); } while (0)
#define PG8_LDA(dst, b, h) do { _Pragma("unroll") for (int m = 0; m < 4; ++m) _Pragma("unroll") for (int k = 0; k < 2; ++k) dst[m][k] = *(const PG8_LAS bf16x8*)(lds + PG8_SA(b, h) + aoff + m * 2048 + k * 1024); } while (0)
#define PG8_LDB(dst, b, h) do { _Pragma("unroll") for (int n = 0; n < 2; ++n) _Pragma("unroll") for (int k = 0; k < 2; ++k) dst[n][k] = *(const PG8_LAS bf16x8*)(lds + PG8_SB(b, h) + boff + n * 2048 + k * 1024); } while (0)
#define PG8_MMA(ai, bj, At, Bt) do { __builtin_amdgcn_s_setprio(1); _Pragma("unroll") for (int m = 0; m < 4; ++m) _Pragma("unroll") for (int n = 0; n < 2; ++n) _Pragma("unroll") for (int k = 0; k < 2; ++k) \
        acc[ai][bj][m][n] = __builtin_amdgcn_mfma_f32_16x16x32_bf16(Bt[n][k], At[m][k], acc[ai][bj][m][n], 0, 0, 0); __builtin_amdgcn_s_setprio(0); } while (0)
#define PG8_WAIT_V(n) asm volatile("s_waitcnt vmcnt(" #n ")" ::: "memory")
#define PG8_WAIT_L(n) asm volatile("s_waitcnt lgkmcnt(" #n ")" ::: "memory")
#define PG8_BAR __builtin_amdgcn_s_barrier()
#define PG8_SCHED __builtin_amdgcn_sched_barrier(0)
    Unit cur, nxt; int ui = 0;
    if (!S.next(0, cur)) return;
    f32x4 acc[2][2][4][2];
#pragma unroll
    for (int a = 0; a < 2; ++a)
#pragma unroll
        for (int b = 0; b < 2; ++b)
#pragma unroll
            for (int m = 0; m < 4; ++m)
#pragma unroll
                for (int n = 0; n < 2; ++n) acc[a][b][m][n] = (f32x4){0.f, 0.f, 0.f, 0.f};
    bf16x8 At[4][2], B0[2][2], B1[2][2];
    const char* cA = (const char*)g.A + (size_t)cur.pm * tstep; const char* cB = (const char*)g.Bt + (size_t)cur.pn * tstep;
    S.a_ready(cur);
    if constexpr (SP2) {
        PG8_STAGE(PG8_SB(0, 0), cB, voffB); PG8_STAGE(PG8_SB(0, 1), cB + hstep, voffB); PG8_STAGE(PG8_SA(0, 0), cA, voffA); PG8_STAGE(PG8_SA(0, 1), cA + hstep, voffA);
        if (wr == 1) PG8_BAR;
        PG8_WAIT_V(2); PG8_BAR;
        PG8_STAGE(PG8_SB(1, 0), cB + kstep, voffB); PG8_STAGE(PG8_SA(1, 0), cA + kstep, voffA); PG8_STAGE(PG8_SB(1, 1), cB + hstep + kstep, voffB);
        PG8_WAIT_V(6); PG8_BAR;
    } else {
        PG8_STAGE(PG8_SB(0, 0), cB, voffB); PG8_STAGE(PG8_SA(0, 0), cA, voffA); PG8_STAGE(PG8_SB(0, 1), cB + hstep, voffB); PG8_STAGE(PG8_SA(0, 1), cA + hstep, voffA);
        if (wr == 1) PG8_BAR;
        PG8_WAIT_V(4); PG8_BAR;
        PG8_STAGE(PG8_SB(1, 0), cB + kstep, voffB); PG8_STAGE(PG8_SA(1, 0), cA + kstep, voffA); PG8_STAGE(PG8_SB(1, 1), cB + hstep + kstep, voffB);
        PG8_WAIT_V(6); PG8_BAR;
    }
    for (;;) {
        const bool has_next = S.next(ui + 1, nxt);
        const char* nA = has_next ? (const char*)g.A + (size_t)nxt.pm * tstep : cA; const char* nB = has_next ? (const char*)g.Bt + (size_t)nxt.pn * tstep : cB;
        for (int t = 0; t < nt; t += 2) {
            const bool last = (t == nt - 2);
            const char* a1 = cA + (size_t)(t + 1) * kstep;
            const char* a2 = last ? nA : cA + (size_t)(t + 2) * kstep; const char* b2 = last ? nB : cB + (size_t)(t + 2) * kstep;
            const char* a3 = a2 + kstep; const char* b3 = b2 + kstep;
            if (last && has_next) S.a_ready(nxt);
            if constexpr (SP2) {
            PG8_LDB(B0, 0, 0); PG8_LDB(B1, 0, 1); PG8_SCHED; PG8_LDA(At, 0, 0); PG8_STAGE(PG8_SA(1, 1), a1 + hstep, voffA);
            PG8_WAIT_V(8); PG8_WAIT_L(0); PG8_BAR; PG8_MMA(0, 0, At, B0); PG8_MMA(0, 1, At, B1); PG8_BAR; PG8_SCHED;
            PG8_LDA(At, 0, 1); PG8_STAGE(PG8_SB(0, 0), b2, voffB); PG8_STAGE(PG8_SB(0, 1), b2 + hstep, voffB); PG8_STAGE(PG8_SA(0, 0), a2, voffA);
            PG8_WAIT_V(8); PG8_WAIT_L(0); PG8_BAR; PG8_MMA(1, 0, At, B0); PG8_MMA(1, 1, At, B1); PG8_BAR; PG8_SCHED;
            PG8_LDB(B0, 1, 0); PG8_LDB(B1, 1, 1); PG8_SCHED; PG8_LDA(At, 1, 0); PG8_STAGE(PG8_SA(0, 1), a2 + hstep, voffA);
            PG8_WAIT_V(8); PG8_WAIT_L(0); PG8_BAR; PG8_MMA(0, 0, At, B0); PG8_MMA(0, 1, At, B1); PG8_BAR; PG8_SCHED;
            PG8_LDA(At, 1, 1); PG8_STAGE(PG8_SB(1, 0), b3, voffB); PG8_STAGE(PG8_SB(1, 1), b3 + hstep, voffB); PG8_STAGE(PG8_SA(1, 0), a3, voffA);
            PG8_WAIT_V(8); PG8_WAIT_L(0); PG8_BAR; PG8_MMA(1, 0, At, B0); PG8_MMA(1, 1, At, B1); PG8_BAR; PG8_SCHED;
            } else {
            PG8_LDB(B0, 0, 0); PG8_SCHED; PG8_LDA(At, 0, 0); PG8_STAGE(PG8_SA(1, 1), a1 + hstep, voffA);
            PG8_WAIT_L(8); PG8_BAR; PG8_WAIT_L(0); PG8_MMA(0, 0, At, B0); PG8_BAR; PG8_SCHED;
            PG8_LDB(B1, 0, 1); PG8_STAGE(PG8_SB(0, 0), b2, voffB);
            PG8_BAR; PG8_WAIT_L(0); PG8_MMA(0, 1, At, B1); PG8_BAR;
            PG8_LDA(At, 0, 1); PG8_STAGE(PG8_SA(0, 0), a2, voffA);
            PG8_BAR; PG8_WAIT_L(0); PG8_MMA(1, 0, At, B0); PG8_BAR; PG8_SCHED;
            PG8_STAGE(PG8_SB(0, 1), b2 + hstep, voffB);
            PG8_WAIT_V(6); PG8_BAR; PG8_MMA(1, 1, At, B1); PG8_BAR;
            PG8_LDB(B0, 1, 0); PG8_SCHED; PG8_LDA(At, 1, 0); PG8_STAGE(PG8_SA(0, 1), a2 + hstep, voffA);
            PG8_WAIT_L(8); PG8_BAR; PG8_WAIT_L(0); PG8_MMA(0, 0, At, B0); PG8_BAR; PG8_SCHED;
            PG8_LDB(B1, 1, 1); PG8_STAGE(PG8_SB(1, 0), b3, voffB);
            PG8_BAR; PG8_WAIT_L(0); PG8_MMA(0, 1, At, B1); PG8_BAR;
            PG8_LDA(At, 1, 1); PG8_STAGE(PG8_SA(1, 0), a3, voffA);
            PG8_BAR; PG8_WAIT_L(0); PG8_MMA(1, 0, At, B0); PG8_BAR; PG8_SCHED;
            PG8_STAGE(PG8_SB(1, 1), b3 + hstep, voffB);
            PG8_WAIT_V(6); PG8_BAR; PG8_MMA(1, 1, At, B1); PG8_BAR;
            }
        }
        if constexpr (ALIGN_EPI) { if (wr == 0) PG8_BAR; }
        if constexpr (!Epi::AFTER_DRAIN) { E(acc, cur, wr, wc, fr, fq); S.done(cur); }
        if (!has_next) break;
#pragma unroll
        for (int a = 0; a < 2; ++a)
#pragma unroll
            for (int b = 0; b < 2; ++b)
#pragma unroll
                for (int m = 0; m < 4; ++m)
#pragma unroll
                    for (int n = 0; n < 2; ++n) acc[a][b][m][n] = (f32x4){0.f, 0.f, 0.f, 0.f};
        cur = nxt; cA = nA; cB = nB; ++ui;
        if constexpr (ALIGN_EPI) { if (wr == 1) PG8_BAR; }
    }
    PG8_WAIT_V(0);
    if constexpr (!ALIGN_EPI) { if (wr == 0) PG8_BAR; }
    PG8_BAR;
    if constexpr (Epi::AFTER_DRAIN) { E.fused(acc, cur, wr, wc, fr, fq, lds, wid, lane); S.done(cur); }
#undef PG8_SA
#undef PG8_SB
#undef PG8_STAGE
#undef PG8_LDA
#undef PG8_LDB
#undef PG8_MMA
#undef PG8_WAIT_V
#undef PG8_WAIT_L
#undef PG8_BAR
#undef PG8_SCHED
}
}
#define XB_TMO      128
#define XB_XCNT(j)  (256  + 64 * (j))
#define XB_XSUB(j)  (1280 + 64 * (j))
#define XB_XGEN(j)  (2304 + 64 * (j))
#define XB_TOP      3328
#define XB_TOPGEN   3392
#define XCD_BAR_WORDS 3456
#define XB_SPIN_CAP (1u << 18)
#define LAS __attribute__((address_space(3)))

__device__ __forceinline__ unsigned xb_ld(unsigned* p)              { return __hip_atomic_load(p, __ATOMIC_RELAXED, __HIP_MEMORY_SCOPE_AGENT); }
__device__ __forceinline__ unsigned xb_add(unsigned* p, unsigned v) { return __hip_atomic_fetch_add(p, v, __ATOMIC_RELAXED, __HIP_MEMORY_SCOPE_AGENT); }
__device__ __forceinline__ unsigned xb_xcc_id() { return (unsigned)__builtin_amdgcn_s_getreg((3 << 11) | 20) & 0xFu; }
#define XB_SPIN(cond, bar) do { unsigned _sp = 0; while (cond) { __builtin_amdgcn_s_sleep(1); \
    if ((++_sp & 255u) == 0u) { if (xb_ld(&(bar)[XB_TMO])) break; if (_sp > XB_SPIN_CAP) { atomicAdd(&(bar)[XB_TMO], 1u); break; } } } } while (0)

struct XcdBarrier {
    unsigned* bar; unsigned x;
    volatile LAS unsigned* st;
};

__device__ __forceinline__ XcdBarrier xcd_barrier_post(unsigned* bar, volatile LAS unsigned* st) {
    XcdBarrier b; b.bar = bar; b.x = xb_xcc_id(); b.st = st;
    if (threadIdx.x == 0) (void)xb_add(&bar[XB_XCNT(b.x)], 1u);
    return b;
}
__device__ __forceinline__ void xcd_barrier_complete(unsigned* bar, unsigned x, unsigned& nloc, unsigned& nx) {
    const unsigned G = gridDim.x * gridDim.y * gridDim.z;
    unsigned sum, cnt, mine, sp = 0u;
    for (;;) {
        sum = 0u; cnt = 0u; mine = 0u;
#pragma unroll
        for (unsigned j = 0; j < 16; ++j) { const unsigned c = xb_ld(&bar[XB_XCNT(j)]); sum += c; cnt += (c > 0u) ? 1u : 0u; mine = (j == x) ? c : mine; }
        if (sum == G) break;
        __builtin_amdgcn_s_sleep(1);
        if ((++sp & 255u) == 0u) { if (xb_ld(&bar[XB_TMO])) break; if (sp > XB_SPIN_CAP) { atomicAdd(&bar[XB_TMO], 1u); break; } }
    }
    nloc = mine > 0u ? mine : 1u; nx = cnt > 0u ? cnt : 1u;
}

__device__ __forceinline__ void xcd_barrier(const XcdBarrier& b) {
    asm volatile("s_waitcnt vmcnt(0)" ::: "memory");
    __syncthreads();
    if (threadIdx.x == 0) {
        unsigned* bar = b.bar;
        __builtin_amdgcn_s_waitcnt(0);
        unsigned nloc = b.st[0], nx = b.st[1];
        if (nloc == 0u) { xcd_barrier_complete(bar, b.x, nloc, nx); b.st[0] = nloc; b.st[1] = nx; }
        const unsigned old = xb_add(&bar[XB_XSUB(b.x)], 1u);
        const unsigned gen = old / nloc;
        if (old + 1u == (gen + 1u) * nloc) {
            __builtin_amdgcn_fence(__ATOMIC_RELEASE, "agent");
            asm volatile("s_waitcnt vmcnt(0)" ::: "memory");
            const unsigned og = xb_add(&bar[XB_TOP], 1u);
            const unsigned tg = og / nx;
            if (og + 1u == (tg + 1u) * nx) xb_add(&bar[XB_TOPGEN], 1u);
            else XB_SPIN(xb_ld(&bar[XB_TOPGEN]) == tg, bar);
            __builtin_amdgcn_fence(__ATOMIC_ACQUIRE, "agent");
            xb_add(&bar[XB_XGEN(b.x)], 1u);
            asm volatile("s_waitcnt vmcnt(0)" ::: "memory");
        } else {
            XB_SPIN(xb_ld(&bar[XB_XGEN(b.x)]) == gen, bar);
            __builtin_amdgcn_fence(__ATOMIC_ACQUIRE, "agent");
            asm volatile("s_waitcnt vmcnt(0)" ::: "memory");
        }
    }
    __syncthreads();
}

constexpr int DM = 2048, NB = 4, SEQ = 2048, DEPTH = 4, DB = 128, DSQ = 8;
constexpr int MP = NB * SEQ, MS = DB * DSQ, MT = MP + MS;
constexpr int S5W = 1024, S5G = 64, S5N = 64, S5C = 16;
constexpr int HW = 1024, HH = 8, HK = 128, HV = 128;
constexpr int FF = 5504, INW = 5120;
constexpr float EPS = 1e-6f;
constexpr int S5CH = 16, S5CL = SEQ / S5CH;

constexpr size_t O_Y = 0, O_REP = (size_t)MT * DM, O_IMP = O_REP + (size_t)DEPTH * NB * S5G * S5N, O_HP = O_IMP + (size_t)DEPTH * NB * S5G * S5N,
                 O_RES = O_HP + (size_t)DEPTH * NB * HH * HK * HV, O_IMS = O_RES + (size_t)DEPTH * DB * S5G * S5N, O_HS = O_IMS + (size_t)DEPTH * DB * S5G * S5N,
                 O_END = O_HS + (size_t)DEPTH * DB * HH * HK * HV;
static_assert(O_END == 92405760, "output size");

constexpr size_t MiB = 1u << 20;
constexpr size_t WS_CTL = 0, CTL_ZERO_BYTES = 1 * MiB;
constexpr size_t WS_AB = 1 * MiB;
constexpr size_t WS_BBR = WS_AB + 256 * 1024;
constexpr size_t WS_BBI = WS_BBR + 1 * MiB;
constexpr size_t WS_LB = WS_BBI + 1 * MiB;
constexpr size_t WS_RS = WS_LB + 64 * 1024;
constexpr size_t WS_S5E = WS_RS + 64 * 1024;
constexpr size_t WS_W = 16 * MiB;
constexpr size_t LW_GU1 = 0, LW_D1 = LW_GU1 + (size_t)2 * FF * DM * 2, LW_GU2 = LW_D1 + (size_t)DM * FF * 2, LW_D2 = LW_GU2 + (size_t)2 * FF * DM * 2,
                 LW_IN = LW_D2 + (size_t)DM * FF * 2, LW_GLU = LW_IN + (size_t)INW * DM * 2, LW_OUT = LW_GLU + (size_t)S5W * S5W * 2, LW_END = LW_OUT + (size_t)DM * DM * 2;
static_assert(LW_END == 166723584 && (LW_D1 % 256) == 0 && (LW_GLU % 256) == 0, "weight map");
constexpr size_t WS_HB = 656 * MiB;
constexpr size_t WS_HID = WS_HB + 36 * MiB;
constexpr size_t WS_A = WS_HID + 97 * MiB;
constexpr size_t WS_Z = WS_A + 72 * MiB;
constexpr size_t WS_CAT = WS_Z + 180 * MiB;
constexpr size_t WS_YSG = WS_CAT + 36 * MiB;
constexpr size_t WS_O = WS_YSG + 18 * MiB;
constexpr size_t WS_END = WS_O + 36 * MiB;
static_assert(WS_W + 4 * LW_END <= WS_HB && WS_S5E + 2 * MiB <= WS_W, "ws map");

constexpr int RING_BYTES = 131072, LDSCTL_OFF = RING_BYTES, LDS_BYTES = RING_BYTES + 1024;

#define GAS __attribute__((address_space(1)))
#define LAS __attribute__((address_space(3)))
typedef unsigned short bf16;
typedef float f32x4 __attribute__((ext_vector_type(4)));
typedef float f32x2 __attribute__((ext_vector_type(2)));
typedef unsigned v4u __attribute__((ext_vector_type(4)));
typedef unsigned v2u __attribute__((ext_vector_type(2)));
#define LDS_WAIT() asm volatile("s_waitcnt lgkmcnt(0)" ::: "memory")

__device__ __forceinline__ unsigned f2bf(float f) { unsigned u = __builtin_bit_cast(unsigned, f); return (u + 0x7fffu + ((u >> 16) & 1u)) >> 16; }
__device__ __forceinline__ unsigned pk2(float lo, float hi) { return f2bf(lo) | (f2bf(hi) << 16); }
__device__ __forceinline__ float bflo(unsigned w) { return __builtin_bit_cast(float, w << 16); }
__device__ __forceinline__ float bfhi(unsigned w) { return __builtin_bit_cast(float, w & 0xffff0000u); }
__device__ __forceinline__ float wave_sum(float v) {
#pragma unroll
    for (int o = 1; o < 64; o <<= 1) v += __shfl_xor(v, o);
    return v;
}
__device__ __forceinline__ float sigm(float x) { return 1.f / (1.f + __expf(-x)); }
__device__ __forceinline__ float silu(float x) { return x / (1.f + __expf(-x)); }
__device__ __forceinline__ float gelu_tanh(float v) { const float a = 0.7978845608f * (v + 0.044715f * v * v * v); const float th = 1.f - 2.f / (__expf(2.f * a) + 1.f); return 0.5f * v * (1.f + th); }

struct Args { const float* in[27]; float* out; unsigned char* ws; int ph_lo, ph_hi; };

struct EpiGU {
    static constexpr bool PERM = true, AFTER_DRAIN = false;
    bf16* O; const float* rs;
    __device__ __forceinline__ void operator()(const pg8::f32x4 (&acc)[2][2][4][2], const pg8::Unit& u, int wr, int wc, int fr, int fq) const {
        const int row0 = u.pm * 256 + wr * 64 + fr, col0 = u.pn * 128 + wc * 32 + 8 * fq;
#pragma unroll
        for (int ai = 0; ai < 2; ++ai)
#pragma unroll
            for (int m = 0; m < 4; ++m) {
                const int row = row0 + ai * 128 + m * 16; const float r = rs[row];
                float o[8];
#pragma unroll
                for (int n = 0; n < 2; ++n)
#pragma unroll
                    for (int j = 0; j < 4; ++j) { const float g = acc[ai][0][m][n][j] * r, uu = acc[ai][1][m][n][j] * r; o[4 * n + j] = silu(g) * uu; }
                v4u w; w.x = pk2(o[0], o[1]); w.y = pk2(o[2], o[3]); w.z = pk2(o[4], o[5]); w.w = pk2(o[6], o[7]);
                *(v4u*)(O + (size_t)row * FF + col0) = w;
            }
    }
};
struct EpiF32 {
    static constexpr bool PERM = false, AFTER_DRAIN = false;
    float* C; int ldc;
    __device__ __forceinline__ void operator()(const pg8::f32x4 (&acc)[2][2][4][2], const pg8::Unit& u, int wr, int wc, int fr, int fq) const {
        const int row0 = u.pm * 256 + wr * 64 + fr, col0 = u.pn * 256 + wc * 32 + 4 * fq;
#pragma unroll
        for (int ai = 0; ai < 2; ++ai)
#pragma unroll
            for (int m = 0; m < 4; ++m) { float* rowp = C + (size_t)(row0 + ai * 128 + m * 16) * ldc + col0;
#pragma unroll
                for (int bj = 0; bj < 2; ++bj)
#pragma unroll
                    for (int n = 0; n < 2; ++n) *(f32x4*)(rowp + bj * 128 + n * 16) = acc[ai][bj][m][n]; }
    }
};
struct EpiWin {
    static constexpr bool PERM = false, AFTER_DRAIN = false;
    float* Z; const float* rs; const float* lb;
    __device__ __forceinline__ void operator()(const pg8::f32x4 (&acc)[2][2][4][2], const pg8::Unit& u, int wr, int wc, int fr, int fq) const {
        const int row0 = u.pm * 256 + wr * 64 + fr, col0 = u.pn * 256 + wc * 32 + 4 * fq; const int kind = u.pn >> 2;
#pragma unroll
        for (int ai = 0; ai < 2; ++ai)
#pragma unroll
            for (int m = 0; m < 4; ++m) { const int row = row0 + ai * 128 + m * 16; const float r = rs[row]; float* rowp = Z + (size_t)row * INW + col0;
#pragma unroll
                for (int bj = 0; bj < 2; ++bj)
#pragma unroll
                    for (int n = 0; n < 2; ++n) { f32x4 v = acc[ai][bj][m][n] * r;
                        if (kind == 1) { v[0] = silu(v[0]); v[1] = silu(v[1]); v[2] = silu(v[2]); v[3] = silu(v[3]); }
                        else if (kind == 2) { const f32x4 l4 = *(const f32x4*)(lb + (col0 + bj * 128 + n * 16 - 2048));
#pragma unroll
                            for (int j = 0; j < 4; ++j) v[j] = l4[j] + (1.f - l4[j]) * sigm(v[j]); }
                        *(f32x4*)(rowp + bj * 128 + n * 16) = v; } }
    }
};
struct EpiGlu {
    static constexpr bool PERM = true, AFTER_DRAIN = false;
    bf16* CAT; const bf16* YSG; const float* bias;
    __device__ __forceinline__ void operator()(const pg8::f32x4 (&acc)[2][2][4][2], const pg8::Unit& u, int wr, int wc, int fr, int fq) const {
        const int row0 = u.pm * 256 + wr * 64 + fr, col0 = u.pn * 256 + wc * 32 + 8 * fq;
        f32x4 bv[2][2];
#pragma unroll
        for (int bj = 0; bj < 2; ++bj)
#pragma unroll
            for (int n = 0; n < 2; ++n) bv[bj][n] = *(const f32x4*)(bias + col0 + bj * 128 + 4 * n);
#pragma unroll
        for (int ai = 0; ai < 2; ++ai)
#pragma unroll
            for (int m = 0; m < 4; ++m) { const int row = row0 + ai * 128 + m * 16;
#pragma unroll
                for (int bj = 0; bj < 2; ++bj) { const int col = col0 + bj * 128;
                    const v4u y = *(const v4u*)(YSG + (size_t)row * S5W + col);
                    const f32x4 t0 = acc[ai][bj][m][0] + bv[bj][0], t1 = acc[ai][bj][m][1] + bv[bj][1];
                    v4u w; w.x = pk2(bflo(y.x) * sigm(t0[0]), bfhi(y.x) * sigm(t0[1])); w.y = pk2(bflo(y.y) * sigm(t0[2]), bfhi(y.y) * sigm(t0[3]));
                    w.z = pk2(bflo(y.z) * sigm(t1[0]), bfhi(y.z) * sigm(t1[1])); w.w = pk2(bflo(y.w) * sigm(t1[2]), bfhi(y.w) * sigm(t1[3]));
                    *(v4u*)(CAT + (size_t)row * DM + col) = w; } }
    }
};

__device__ __forceinline__ void tr_item(const float* W, int ldw, int j0, int k0, const float* gain, bf16* WT, int K, int n0d, LAS float* scr, int lane) {
#pragma unroll 8
    for (int i = 0; i < 32; ++i) { const int kk = 2 * i + (lane >> 5); float v = W[(size_t)(k0 + kk) * ldw + j0 + (lane & 31)]; if (gain) v *= gain[k0 + kk]; scr[kk * 33 + (lane & 31)] = v; }
    LDS_WAIT(); asm volatile("" ::: "memory");
    const int c = lane & 7;
#pragma unroll
    for (int j = 0; j < 4; ++j) { const int n = (lane >> 3) + 8 * j; const LAS float* s = scr + (8 * c) * 33 + n;
        v4u o; o.x = pk2(s[0 * 33], s[1 * 33]); o.y = pk2(s[2 * 33], s[3 * 33]); o.z = pk2(s[4 * 33], s[5 * 33]); o.w = pk2(s[6 * 33], s[7 * 33]);
        *(v4u*)(WT + (size_t)(n0d + n) * K + k0 + 8 * c) = o; }
    LDS_WAIT(); asm volatile("" ::: "memory");
}
__device__ __forceinline__ void p0_prologue(const Args& a, LAS unsigned char* lds, int G, int bid, int tid) {
    const int wave = __builtin_amdgcn_readfirstlane(tid >> 6), lane = tid & 63;
    LAS float* scr = (LAS float*)(lds + wave * 16384);
    const int gw = bid * 8 + wave, NGW = G * 8;
    constexpr int I_GU = 32 * 344, I_D = 86 * 64, I_IN = 32 * 160, I_GLU = 16 * 32, I_OUT = 32 * 64, I_L = 2 * I_GU + 2 * I_D + I_IN + I_GLU + I_OUT;
    for (int it = gw; it < DEPTH * I_L; it += NGW) {
        const int l = it / I_L; int r = it - l * I_L;
        unsigned char* wl = a.ws + WS_W + (size_t)l * LW_END;
        if (r < 2 * I_GU) { const int f = r / I_GU; r -= f * I_GU; const int kb = r / 344, nb = r % 344, pn = nb >> 3, rr = nb & 7;
            const float* src = (rr < 4 ? a.in[f ? 10 : 7] : a.in[f ? 11 : 8]) + (size_t)l * DM * FF;
            tr_item(src, FF, 128 * pn + 32 * (rr & 3), 64 * kb, a.in[5] + (size_t)(l * 3 + (f ? 2 : 0)) * DM, (bf16*)(wl + (f ? LW_GU2 : LW_GU1)), DM, 32 * nb, scr, lane); continue; }
        r -= 2 * I_GU;
        if (r < 2 * I_D) { const int f = r / I_D; r -= f * I_D; const int kb = r / 64, nb = r % 64;
            tr_item(a.in[f ? 12 : 9] + (size_t)l * FF * DM, DM, 32 * nb, 64 * kb, nullptr, (bf16*)(wl + (f ? LW_D2 : LW_D1)), FF, 32 * nb, scr, lane); continue; }
        r -= 2 * I_D;
        if (r < I_IN) { const int kb = r / 160, nb = r % 160;
            tr_item(a.in[13] + (size_t)l * DM * INW, INW, 32 * nb, 64 * kb, a.in[5] + (size_t)(l * 3 + 1) * DM, (bf16*)(wl + LW_IN), DM, 32 * nb, scr, lane); continue; }
        r -= I_IN;
        if (r < I_GLU) { const int kb = r / 32, nb = r % 32;
            tr_item(a.in[23] + (size_t)l * S5W * S5W, S5W, 32 * nb, 64 * kb, nullptr, (bf16*)(wl + LW_GLU), S5W, 32 * nb, scr, lane); continue; }
        r -= I_GLU;
        { const int kb = r / 64, nb = r % 64;
            tr_item(a.in[14] + (size_t)l * DM * DM, DM, 32 * nb, 64 * kb, nullptr, (bf16*)(wl + LW_OUT), DM, 32 * nb, scr, lane); }
    }
    for (int idx = bid * 512 + tid; idx < DEPTH * S5G * S5N; idx += G * 512) {
        const int lg = idx / S5N;
        const float lr = a.in[15][idx], li = a.in[16][idx], dt = expf(a.in[17][lg]);
        const float mag = expf(lr * dt), ang = li * dt;
        const float are = mag * cosf(ang), aim = mag * sinf(ang);
        const float p = are - 1.f, q = aim, den = lr * lr + li * li;
        const float zre = (p * lr + q * li) / den, zim = (q * lr - p * li) / den;
        ((f32x2*)(a.ws + WS_AB))[idx] = (f32x2){are, aim};
        const f32x4* br = (const f32x4*)(a.in[18] + (size_t)idx * 16); const f32x4* bi = (const f32x4*)(a.in[19] + (size_t)idx * 16);
        f32x4* obr = (f32x4*)(a.ws + WS_BBR) + (size_t)idx * 4; f32x4* obi = (f32x4*)(a.ws + WS_BBI) + (size_t)idx * 4;
#pragma unroll
        for (int c = 0; c < 4; ++c) { const f32x4 r4 = br[c], i4 = bi[c]; obr[c] = zre * r4 - zim * i4; obi[c] = zre * i4 + zim * r4; }
    }
    for (int idx = bid * 512 + tid; idx < HW; idx += G * 512) {
        const float x0 = a.in[25][idx], x1 = a.in[25][HW + idx], x2 = a.in[25][2 * HW + idx], x3 = a.in[25][3 * HW + idx];
        const float mx = fmaxf(fmaxf(x0, x1), fmaxf(x2, x3));
        const float e0 = expf(x0 - mx), e1 = expf(x1 - mx), e2 = expf(x2 - mx), e3 = expf(x3 - mx), inv = 1.f / (e0 + e1 + e2 + e3);
        float* lb = (float*)(a.ws + WS_LB);
        lb[idx] = 0.f; lb[HW + idx] = e1 * inv; lb[2 * HW + idx] = (e1 + e2) * inv; lb[3 * HW + idx] = (e1 + e2 + e3) * inv;
    }
    for (int row = gw; row < MT; row += NGW) {
        const float* xr = row < MP ? a.in[0] + (size_t)row * DM : a.in[1] + (size_t)(row - MP) * DM;
        float* hr = a.out + O_Y + (size_t)row * DM; bf16* hb = (bf16*)(a.ws + WS_HB) + (size_t)row * DM;
        float ss = 0.f;
#pragma unroll
        for (int j = 0; j < 8; ++j) { const f32x4 v = *(const f32x4*)(xr + 4 * lane + 256 * j); ss += (v[0] * v[0] + v[1] * v[1]) + (v[2] * v[2] + v[3] * v[3]);
            *(f32x4*)(hr + 4 * lane + 256 * j) = v; v2u w; w.x = pk2(v[0], v[1]); w.y = pk2(v[2], v[3]); *(v2u*)(hb + 4 * lane + 256 * j) = w; }
        ss = wave_sum(ss);
        if (lane == 0) ((float*)(a.ws + WS_RS))[row] = 1.f / sqrtf(ss * (1.f / DM) + EPS);
    }
}

__device__ __forceinline__ void norm_res_phase(const Args& a, const float* gain, float coef, int G, int bid, int tid) {
    const int wave = __builtin_amdgcn_readfirstlane(tid >> 6), lane = tid & 63;
    const int gw = bid * 8 + wave, NGW = G * 8;
    f32x4 gv[8];
#pragma unroll
    for (int j = 0; j < 8; ++j) gv[j] = *(const f32x4*)(gain + 4 * lane + 256 * j) * coef;
    for (int row = gw; row < MT; row += NGW) {
        const float* ar = (const float*)(a.ws + WS_A) + (size_t)row * DM; float* hr = a.out + O_Y + (size_t)row * DM; bf16* hb = (bf16*)(a.ws + WS_HB) + (size_t)row * DM;
        f32x4 av[8], hv[8]; float ss = 0.f;
#pragma unroll
        for (int j = 0; j < 8; ++j) { av[j] = *(const f32x4*)(ar + 4 * lane + 256 * j); hv[j] = *(const f32x4*)(hr + 4 * lane + 256 * j);
            ss += (av[j][0] * av[j][0] + av[j][1] * av[j][1]) + (av[j][2] * av[j][2] + av[j][3] * av[j][3]); }
        ss = wave_sum(ss);
        const float ra = 1.f / sqrtf(ss * (1.f / DM) + EPS);
        float s2 = 0.f;
#pragma unroll
        for (int j = 0; j < 8; ++j) { const f32x4 v = hv[j] + av[j] * gv[j] * ra; s2 += (v[0] * v[0] + v[1] * v[1]) + (v[2] * v[2] + v[3] * v[3]);
            *(f32x4*)(hr + 4 * lane + 256 * j) = v; v2u w; w.x = pk2(v[0], v[1]); w.y = pk2(v[2], v[3]); *(v2u*)(hb + 4 * lane + 256 * j) = w; }
        s2 = wave_sum(s2);
        if (lane == 0) ((float*)(a.ws + WS_RS))[row] = 1.f / sqrtf(s2 * (1.f / DM) + EPS);
    }
}

struct S5P { float are, aim; float bbr[16], bbi[16]; };
__device__ __forceinline__ void s5_load(const Args& a, int l, int g, int lane, S5P& p) {
    const int idx = (l * S5G + g) * S5N + lane;
    const f32x2 ab = ((const f32x2*)(a.ws + WS_AB))[idx]; p.are = ab[0]; p.aim = ab[1];
    const f32x4* br = (const f32x4*)(a.ws + WS_BBR) + (size_t)idx * 4; const f32x4* bi = (const f32x4*)(a.ws + WS_BBI) + (size_t)idx * 4;
#pragma unroll
    for (int c = 0; c < 4; ++c) { const f32x4 r4 = br[c], i4 = bi[c];
#pragma unroll
        for (int j = 0; j < 4; ++j) { p.bbr[4 * c + j] = r4[j]; p.bbi[4 * c + j] = i4[j]; } }
}
__device__ __forceinline__ void s5_step(const S5P& p, float um, float& xr, float& xi) {
    float br = 0.f, bi = 0.f;
#pragma unroll
    for (int c = 0; c < 16; ++c) { const float uc = __builtin_bit_cast(float, __builtin_amdgcn_readlane(__builtin_bit_cast(int, um), c)); br += p.bbr[c] * uc; bi += p.bbi[c] * uc; }
    const float nr = p.are * xr - p.aim * xi + br, ni = p.are * xi + p.aim * xr + bi;
    xr = nr; xi = ni;
}
__device__ __forceinline__ void s5_pass1_item(const Args& a, int l, int item, int lane) {
    const int ch = item % S5CH, g = (item / S5CH) % S5G, b = item / (S5CH * S5G);
    S5P p; s5_load(a, l, g, lane, p);
    const float* zp = (const float*)(a.ws + WS_Z) + (size_t)(b * SEQ + ch * S5CL) * INW + 16 * g + (lane & 15);
    float xr = 0.f, xi = 0.f;
    for (int tb = 0; tb < S5CL; tb += 8) {
        float um[8];
#pragma unroll
        for (int j = 0; j < 8; ++j) um[j] = zp[(size_t)(tb + j) * INW];
#pragma unroll
        for (int j = 0; j < 8; ++j) s5_step(p, um[j], xr, xi);
    }
    ((f32x2*)(a.ws + WS_S5E))[((b * S5G + g) * S5CH + ch) * S5N + lane] = (f32x2){xr, xi};
}
__device__ __forceinline__ float reduce16(const float (&p)[16], int lane) {
    float r8[8], r4[4], r2[2];
    { const bool hi = lane & 8;
#pragma unroll
      for (int i = 0; i < 8; ++i) { const float send = hi ? p[i] : p[i + 8], keep = hi ? p[i + 8] : p[i]; r8[i] = keep + __shfl_xor(send, 8); } }
    { const bool hi = lane & 4;
#pragma unroll
      for (int i = 0; i < 4; ++i) { const float send = hi ? r8[i] : r8[i + 4], keep = hi ? r8[i + 4] : r8[i]; r4[i] = keep + __shfl_xor(send, 4); } }
    { const bool hi = lane & 2;
#pragma unroll
      for (int i = 0; i < 2; ++i) { const float send = hi ? r4[i] : r4[i + 2], keep = hi ? r4[i + 2] : r4[i]; r2[i] = keep + __shfl_xor(send, 2); } }
    float r;
    { const bool hi = lane & 1; const float send = hi ? r2[0] : r2[1], keep = hi ? r2[1] : r2[0]; r = keep + __shfl_xor(send, 1); }
    r += __shfl_xor(r, 16); r += __shfl_xor(r, 32);
    return r;
}
__device__ __forceinline__ void s5_pass2_item(const Args& a, int l, int item, int lane) {
    int g, b, ch, row0, nsteps; bool sample = item >= NB * S5G * S5CH;
    if (!sample) { ch = item % S5CH; g = (item / S5CH) % S5G; b = item / (S5CH * S5G); row0 = b * SEQ + ch * S5CL; nsteps = S5CL; }
    else { const int it = item - NB * S5G * S5CH; g = it % S5G; b = it / S5G; ch = 0; row0 = MP + b * DSQ; nsteps = DSQ; }
    S5P p; s5_load(a, l, g, lane, p);
    float cre[16], cim[16];
#pragma unroll
    for (int c = 0; c < 16; ++c) { cre[c] = a.in[20][(size_t)((l * S5G + g) * S5C + c) * S5N + lane]; cim[c] = a.in[21][(size_t)((l * S5G + g) * S5C + c) * S5N + lane]; }
    float xr = 0.f, xi = 0.f;
    if (!sample) {
        float pr = p.are, pi = p.aim;
#pragma unroll
        for (int s = 0; s < 7; ++s) { const float nr = pr * pr - pi * pi, ni = 2.f * pr * pi; pr = nr; pi = ni; }
        const f32x2* E = (const f32x2*)(a.ws + WS_S5E) + (size_t)((b * S5G + g) * S5CH) * S5N + lane;
        for (int j = 0; j < ch; ++j) { const f32x2 e = E[j * S5N]; const float nr = pr * xr - pi * xi + e[0], ni = pr * xi + pi * xr + e[1]; xr = nr; xi = ni; }
    } else {
        const size_t si = (size_t)((l * DB + b) * S5G + g) * S5N + lane; xr = a.in[2][si]; xi = a.in[3][si];
    }
    const float dm = a.in[22][(size_t)l * S5W + 16 * g + (lane & 15)];
    const float* zp = (const float*)(a.ws + WS_Z) + (size_t)row0 * INW + 16 * g + (lane & 15);
    bf16* yp = (bf16*)(a.ws + WS_YSG) + (size_t)row0 * S5W + 16 * g + (lane & 15);
    for (int tb = 0; tb < nsteps; tb += 8) {
        float um[8];
#pragma unroll
        for (int j = 0; j < 8; ++j) um[j] = zp[(size_t)(tb + j) * INW];
#pragma unroll
        for (int j = 0; j < 8; ++j) {
            s5_step(p, um[j], xr, xi);
            float pp[16];
#pragma unroll
            for (int c = 0; c < 16; ++c) pp[c] = xr * cre[c] - xi * cim[c];
            const float y = reduce16(pp, lane);
            if (lane < 16) yp[(size_t)(tb + j) * S5W] = (bf16)f2bf(gelu_tanh(y + dm * um[j]));
        }
    }
    if (!sample) { if (ch == S5CH - 1) { const size_t so = (size_t)((l * NB + b) * S5G + g) * S5N + lane; a.out[O_REP + so] = xr; a.out[O_IMP + so] = xi; } }
    else { const size_t so = (size_t)((l * DB + b) * S5G + g) * S5N + lane; a.out[O_RES + so] = xr; a.out[O_IMS + so] = xi; }
}

__device__ __forceinline__ void hgrn_prompt_item(const Args& a, int l, int item, int lane) {
    const int vg = item & 31, h = (item >> 5) & 7, b = item >> 8;
    const int kq = lane >> 2, vv = lane & 3, v0 = 4 * vg;
    const float* zb = (const float*)(a.ws + WS_Z) + (size_t)(b * SEQ) * INW + h * HK;
    const float* zq = zb + 1024 + kq * 8; const float* zf = zb + 2048 + kq * 8; const float* zv = zb + 3072 + v0 + vv;
    float* op = (float*)(a.ws + WS_O) + (size_t)(b * SEQ) * HW + h * HV + v0 + vv;
    float S[8];
#pragma unroll
    for (int i = 0; i < 8; ++i) S[i] = 0.f;
    f32x4 cq[4][2], cf[4][2]; float cv[4];
#pragma unroll
    for (int j = 0; j < 4; ++j) { cq[j][0] = *(const f32x4*)(zq + (size_t)j * INW); cq[j][1] = *(const f32x4*)(zq + (size_t)j * INW + 4);
        cf[j][0] = *(const f32x4*)(zf + (size_t)j * INW); cf[j][1] = *(const f32x4*)(zf + (size_t)j * INW + 4); cv[j] = zv[(size_t)j * INW]; }
    for (int t0 = 0; t0 < SEQ; t0 += 4) {
        f32x4 nq[4][2], nf[4][2]; float nv[4];
        const int tn = (t0 + 4 < SEQ) ? t0 + 4 : t0;
#pragma unroll
        for (int j = 0; j < 4; ++j) { nq[j][0] = *(const f32x4*)(zq + (size_t)(tn + j) * INW); nq[j][1] = *(const f32x4*)(zq + (size_t)(tn + j) * INW + 4);
            nf[j][0] = *(const f32x4*)(zf + (size_t)(tn + j) * INW); nf[j][1] = *(const f32x4*)(zf + (size_t)(tn + j) * INW + 4); nv[j] = zv[(size_t)(tn + j) * INW]; }
#pragma unroll
        for (int j = 0; j < 4; ++j) {
            float acc = 0.f;
#pragma unroll
            for (int i = 0; i < 8; ++i) { const float f = cf[j][i >> 2][i & 3], q = cq[j][i >> 2][i & 3]; S[i] = f * S[i] + (1.f - f) * cv[j]; acc += S[i] * q; }
            acc += __shfl_xor(acc, 4); acc += __shfl_xor(acc, 8); acc += __shfl_xor(acc, 16); acc += __shfl_xor(acc, 32);
            if (lane < 4) op[(size_t)(t0 + j) * HW] = acc;
        }
#pragma unroll
        for (int j = 0; j < 4; ++j) { cq[j][0] = nq[j][0]; cq[j][1] = nq[j][1]; cf[j][0] = nf[j][0]; cf[j][1] = nf[j][1]; cv[j] = nv[j]; }
    }
    float* sp = a.out + O_HP + ((size_t)((l * NB + b) * HH + h) * HK + kq * 8) * HV + v0 + vv;
#pragma unroll
    for (int i = 0; i < 8; ++i) sp[(size_t)i * HV] = S[i];
}
__device__ __forceinline__ void hgrn_sample_item(const Args& a, int l, int item, LAS unsigned char* lds, int tid) {
    const int h = item & 7, b = item >> 3, kq = tid >> 5, v4 = tid & 31;
    LAS float* red = (LAS float*)lds;
    const float* s0 = a.in[4] + ((size_t)((l * DB + b) * HH + h) * HK + kq * 8) * HV + 4 * v4;
    float* s1 = a.out + O_HS + ((size_t)((l * DB + b) * HH + h) * HK + kq * 8) * HV + 4 * v4;
    f32x4 S[8];
#pragma unroll
    for (int i = 0; i < 8; ++i) S[i] = *(const f32x4*)(s0 + (size_t)i * HV);
    const float* zb = (const float*)(a.ws + WS_Z) + (size_t)(MP + b * DSQ) * INW + h * HK;
#pragma unroll
    for (int t = 0; t < DSQ; ++t) {
        const float* zr = zb + (size_t)t * INW;
        const f32x4 q0 = *(const f32x4*)(zr + 1024 + kq * 8), q1 = *(const f32x4*)(zr + 1024 + kq * 8 + 4);
        const f32x4 f0 = *(const f32x4*)(zr + 2048 + kq * 8), f1 = *(const f32x4*)(zr + 2048 + kq * 8 + 4);
        const f32x4 vv = *(const f32x4*)(zr + 3072 + 4 * v4);
        f32x4 acc = (f32x4){0.f, 0.f, 0.f, 0.f};
#pragma unroll
        for (int i = 0; i < 8; ++i) { const float f = i < 4 ? f0[i & 3] : f1[i & 3], q = i < 4 ? q0[i & 3] : q1[i & 3]; S[i] = S[i] * f + vv * (1.f - f); acc += S[i] * q; }
        *(LAS f32x4*)(red + (t * 16 + kq) * 128 + 4 * v4) = acc;
    }
#pragma unroll
    for (int i = 0; i < 8; ++i) *(f32x4*)(s1 + (size_t)i * HV) = S[i];
    __syncthreads();
#pragma unroll
    for (int e = 0; e < 2; ++e) { const int idx = tid + 512 * e, t = idx >> 7, v = idx & 127; float s = 0.f;
#pragma unroll
        for (int k = 0; k < 16; ++k) s += red[(t * 16 + k) * 128 + v];
        ((float*)(a.ws + WS_O))[(size_t)(MP + b * DSQ + t) * HW + h * HV + v] = s; }
    __syncthreads();
}
__device__ __forceinline__ void hgrn_post_item(const Args& a, int l, int item, int lane) {
    const int h = item & 7, row = item >> 3;
    const f32x2 o = *(const f32x2*)((const float*)(a.ws + WS_O) + (size_t)row * HW + h * HV + 2 * lane);
    const float ss = wave_sum(o[0] * o[0] + o[1] * o[1]);
    const float r = 1.f / sqrtf(ss * (1.f / HV) + EPS);
    const f32x2 gg = *(const f32x2*)((const float*)(a.ws + WS_Z) + (size_t)row * INW + 4096 + h * HV + 2 * lane);
    const f32x2 gn = *(const f32x2*)(a.in[26] + (size_t)l * HW + h * HV + 2 * lane);
    *(unsigned*)((bf16*)(a.ws + WS_CAT) + (size_t)row * DM + 1024 + h * HV + 2 * lane) = pk2(o[0] * r * gn[0] * silu(gg[0]), o[1] * r * gn[1] * silu(gg[1]));
}

typedef short bf16x8_t __attribute__((ext_vector_type(8)));
constexpr int GC = 64, GNCH = SEQ / GC, GITEMS = NB * HH * GNCH;
constexpr int KS = 272, TS = 144;
constexpr int L_SUM = 0, L_VT = 2048, L_KD = L_VT + 128 * TS;
constexpr int L_Q = L_VT + 128 * TS, L_QR = L_Q + 64 * KS, L_KT = L_QR + 64 * KS, L_ATT = L_KT + 10 * 16 * KS, L_SSQ = L_ATT + 64 * TS, L_RR = L_SSQ + 64 * 8 * 4, L_GEND = L_RR + 256;
static_assert(L_GEND <= RING_BYTES, "GLA LDS map");
constexpr size_t WS_SLOC = WS_END, WS_SIN = WS_SLOC + 64 * MiB, WS_DEC = WS_SIN + 32 * MiB, WS_END2 = WS_DEC + 1 * MiB;

__device__ __forceinline__ v4u pack8(const float (&x)[16], int o) { v4u w; w.x = pk2(x[o], x[o + 1]); w.y = pk2(x[o + 2], x[o + 3]); w.z = pk2(x[o + 4], x[o + 5]); w.w = pk2(x[o + 6], x[o + 7]); return w; }

__device__ __forceinline__ void gla_a_item(const Args& a, int item, LAS unsigned char* lds, int tid) {
    const int j = item & 31, h = (item >> 5) & 7, b = item >> 8;
    const int k = tid & 127, ti = __builtin_amdgcn_readfirstlane(tid >> 7), lane = tid & 63, w = __builtin_amdgcn_readfirstlane(tid >> 6);
    const float* zr = (const float*)(a.ws + WS_Z) + (size_t)(b * SEQ + j * GC + ti * 16) * INW + h * HK + k;
    float fv[16], vv[16];
#pragma unroll
    for (int s = 0; s < 16; ++s) { fv[s] = zr[(size_t)s * INW + 2048]; vv[s] = zr[(size_t)s * INW + 3072]; }
    float c[16]; float run = 0.f;
#pragma unroll
    for (int s = 0; s < 16; ++s) { run += __logf(fv[s]); c[s] = run; }
    LAS float* sums = (LAS float*)(lds + L_SUM);
    sums[ti * 128 + k] = run;
    *(LAS v4u*)(lds + L_VT + k * TS + ti * 32) = pack8(vv, 0); *(LAS v4u*)(lds + L_VT + k * TS + ti * 32 + 16) = pack8(vv, 8);
    __syncthreads();
    const float s0 = sums[k], s1 = sums[128 + k], s2 = sums[256 + k], s3 = sums[384 + k];
    const float P4 = (s0 + s1) + (s2 + s3);
    const float rest = ti == 0 ? (s1 + s2 + s3) : ti == 1 ? (s2 + s3) : ti == 2 ? s3 : 0.f;
    float kd[16];
#pragma unroll
    for (int s = 0; s < 16; ++s) kd[s] = (1.f - fv[s]) * __expf(rest + (run - c[s]));
    *(LAS v4u*)(lds + L_KD + k * TS + ti * 32) = pack8(kd, 0); *(LAS v4u*)(lds + L_KD + k * TS + ti * 32 + 16) = pack8(kd, 8);
    if (ti == 0) ((float*)(a.ws + WS_DEC))[(size_t)item * 128 + k] = __expf(P4);
    __syncthreads();
    const int r = lane & 15, g = lane >> 4;
    bf16x8_t af[2];
#pragma unroll
    for (int st = 0; st < 2; ++st) af[st] = *(const LAS bf16x8_t*)(lds + L_KD + (16 * w + r) * TS + (32 * st + 8 * g) * 2);
    float* out = (float*)(a.ws + WS_SLOC) + (size_t)item * 16384;
#pragma unroll
    for (int vt = 0; vt < 8; ++vt) {
        f32x4 acc = (f32x4){0.f, 0.f, 0.f, 0.f};
#pragma unroll
        for (int st = 0; st < 2; ++st) { const bf16x8_t bfr = *(const LAS bf16x8_t*)(lds + L_VT + (16 * vt + r) * TS + (32 * st + 8 * g) * 2);
            acc = __builtin_amdgcn_mfma_f32_16x16x32_bf16(af[st], bfr, acc, 0, 0, 0); }
        *(f32x4*)(out + (size_t)(16 * vt + r) * 128 + 16 * w + 4 * g) = acc;
    }
    __syncthreads();
}

__device__ __forceinline__ void gla_b_phase(const Args& a, int l, int G, int bid, int tid) {
    for (int gid = bid * 512 + tid; gid < NB * HH * 4096; gid += G * 512) {
        const int bh = gid >> 12, rem = gid & 4095, v = rem >> 5, k4 = (rem & 31) * 4;
        f32x4 S = (f32x4){0.f, 0.f, 0.f, 0.f};
        const float* sl = (const float*)(a.ws + WS_SLOC) + (size_t)(bh * GNCH) * 16384 + v * 128 + k4;
        const float* dc = (const float*)(a.ws + WS_DEC) + (size_t)(bh * GNCH) * 128 + k4;
        bf16* si = (bf16*)(a.ws + WS_SIN) + (size_t)(bh * GNCH) * 16384 + v * 128 + k4;
#pragma unroll 8
        for (int j = 0; j < GNCH; ++j) {
            v2u wv; wv.x = pk2(S[0], S[1]); wv.y = pk2(S[2], S[3]); *(v2u*)(si + (size_t)j * 16384) = wv;
            const f32x4 x = *(const f32x4*)(sl + (size_t)j * 16384), d = *(const f32x4*)(dc + (size_t)j * 128);
            S = d * S + x;
        }
        float* sp = a.out + O_HP + ((size_t)(l * NB * HH + bh) * HK + k4) * HV + v;
#pragma unroll
        for (int i = 0; i < 4; ++i) sp[(size_t)i * HV] = S[i];
    }
}

__device__ __forceinline__ void gla_c_item(const Args& a, int l, int item, LAS unsigned char* lds, int tid) {
    const int j = item & 31, h = (item >> 5) & 7, b = item >> 8;
    const int k = tid & 127, ti = __builtin_amdgcn_readfirstlane(tid >> 7), lane = tid & 63, w = __builtin_amdgcn_readfirstlane(tid >> 6);
    const int r = lane & 15, g = lane >> 4;
    const int row0 = b * SEQ + j * GC;
    const float* zr = (const float*)(a.ws + WS_Z) + (size_t)(row0 + ti * 16) * INW + h * HK + k;
    float fv[16], vv[16], qv[16];
#pragma unroll
    for (int s = 0; s < 16; ++s) { fv[s] = zr[(size_t)s * INW + 2048]; vv[s] = zr[(size_t)s * INW + 3072]; qv[s] = zr[(size_t)s * INW + 1024]; }
    bf16x8_t sfr[4];
    { const bf16* si = (const bf16*)(a.ws + WS_SIN) + (size_t)item * 16384 + (size_t)(16 * w + r) * 128 + 8 * g;
#pragma unroll
      for (int st = 0; st < 4; ++st) sfr[st] = *(const bf16x8_t*)(si + 32 * st); }
    float gz[16];
    { const float* zg = (const float*)(a.ws + WS_Z) + (size_t)row0 * INW + 4096 + h * HV + 16 * w + r;
#pragma unroll
      for (int tt = 0; tt < 4; ++tt)
#pragma unroll
        for (int i = 0; i < 4; ++i) gz[tt * 4 + i] = zg[(size_t)(16 * tt + 4 * g + i) * INW]; }
    const float gn = a.in[26][(size_t)l * HW + h * HV + 16 * w + r];
    float c[16]; float run = 0.f;
#pragma unroll
    for (int s = 0; s < 16; ++s) { run += __logf(fv[s]); c[s] = run; }
    LAS float* sums = (LAS float*)(lds + L_SUM);
    sums[ti * 128 + k] = run;
    *(LAS v4u*)(lds + L_VT + k * TS + ti * 32) = pack8(vv, 0); *(LAS v4u*)(lds + L_VT + k * TS + ti * 32 + 16) = pack8(vv, 8);
    { LAS unsigned* az = (LAS unsigned*)(lds + L_ATT); for (int i = tid; i < 64 * TS / 4; i += 512) az[i] = 0u; }
    __syncthreads();
    const float s0 = sums[k], s1 = sums[128 + k], s2 = sums[256 + k];
    const float myP = ti == 0 ? 0.f : ti == 1 ? s0 : ti == 2 ? (s0 + s1) : (s0 + s1 + s2);
#pragma unroll
    for (int s = 0; s < 16; ++s) {
        const int t = 16 * ti + s;
        *(LAS bf16*)(lds + L_Q + t * KS + k * 2) = (bf16)f2bf(qv[s] * __expf(myP + c[s]));
        *(LAS bf16*)(lds + L_QR + t * KS + k * 2) = (bf16)f2bf(qv[s] * __expf(c[s]));
    }
#pragma unroll
    for (int tp = 0; tp < 4; ++tp) {
        if (tp >= ti) {
            const float dP = (tp == ti) ? 0.f : (tp == ti + 1) ? (ti == 0 ? s0 : ti == 1 ? s1 : s2) : (tp == ti + 2) ? (ti == 0 ? (s0 + s1) : (s1 + s2)) : (s0 + s1 + s2);
            LAS unsigned char* kt = lds + L_KT + (tp * (tp + 1) / 2 + ti) * (16 * KS);
#pragma unroll
            for (int s = 0; s < 16; ++s) *(LAS bf16*)(kt + s * KS + k * 2) = (bf16)f2bf((1.f - fv[s]) * __expf(fminf(dP - c[s], 60.f)));
        }
    }
    __syncthreads();
#pragma unroll
    for (int rep = 0; rep < 2; ++rep) {
        const int q = w + 8 * rep;
        if (q < 10) {
            const int tq = q < 1 ? 0 : q < 3 ? 1 : q < 6 ? 2 : 3, sj = q - tq * (tq + 1) / 2;
            f32x4 acc = (f32x4){0.f, 0.f, 0.f, 0.f};
#pragma unroll
            for (int st = 0; st < 4; ++st) {
                const bf16x8_t af = *(const LAS bf16x8_t*)(lds + L_QR + (16 * tq + r) * KS + (32 * st + 8 * g) * 2);
                const bf16x8_t bfr = *(const LAS bf16x8_t*)(lds + L_KT + q * (16 * KS) + r * KS + (32 * st + 8 * g) * 2);
                acc = __builtin_amdgcn_mfma_f32_16x16x32_bf16(af, bfr, acc, 0, 0, 0);
            }
#pragma unroll
            for (int i = 0; i < 4; ++i) { const int t = 16 * tq + 4 * g + i, s = 16 * sj + r; *(LAS bf16*)(lds + L_ATT + t * TS + s * 2) = (bf16)f2bf(s <= t ? acc[i] : 0.f); }
        }
    }
    __syncthreads();
    f32x4 o[4];
#pragma unroll
    for (int tt = 0; tt < 4; ++tt) {
        f32x4 acc = (f32x4){0.f, 0.f, 0.f, 0.f};
#pragma unroll
        for (int st = 0; st < 4; ++st) { const bf16x8_t af = *(const LAS bf16x8_t*)(lds + L_Q + (16 * tt + r) * KS + (32 * st + 8 * g) * 2);
            acc = __builtin_amdgcn_mfma_f32_16x16x32_bf16(af, sfr[st], acc, 0, 0, 0); }
#pragma unroll
        for (int st = 0; st < 2; ++st) if (st == 0 || tt >= 2) {
            const bf16x8_t af = *(const LAS bf16x8_t*)(lds + L_ATT + (16 * tt + r) * TS + (32 * st + 8 * g) * 2);
            const bf16x8_t bfr = *(const LAS bf16x8_t*)(lds + L_VT + (16 * w + r) * TS + (32 * st + 8 * g) * 2);
            acc = __builtin_amdgcn_mfma_f32_16x16x32_bf16(af, bfr, acc, 0, 0, 0); }
        o[tt] = acc;
    }
    LAS float* ssq = (LAS float*)(lds + L_SSQ); LAS float* rr = (LAS float*)(lds + L_RR);
#pragma unroll
    for (int tt = 0; tt < 4; ++tt)
#pragma unroll
        for (int i = 0; i < 4; ++i) { float p = o[tt][i] * o[tt][i]; p += __shfl_xor(p, 1); p += __shfl_xor(p, 2); p += __shfl_xor(p, 4); p += __shfl_xor(p, 8);
            if (r == 0) ssq[(16 * tt + 4 * g + i) * 8 + w] = p; }
    __syncthreads();
    if (tid < 64) { float s = 0.f;
#pragma unroll
        for (int x = 0; x < 8; ++x) s += ssq[tid * 8 + x];
        rr[tid] = 1.f / sqrtf(s * (1.f / HV) + EPS); }
    __syncthreads();
    bf16* cp = (bf16*)(a.ws + WS_CAT) + (size_t)row0 * DM + 1024 + h * HV + 16 * w + r;
#pragma unroll
    for (int tt = 0; tt < 4; ++tt)
#pragma unroll
        for (int i = 0; i < 4; ++i) { const int t = 16 * tt + 4 * g + i; cp[(size_t)t * DM] = (bf16)f2bf(o[tt][i] * rr[t] * gn * silu(gz[tt * 4 + i])); }
    __syncthreads();
}
constexpr int PH_PER_LAYER = 13, N_PHASES = 1 + DEPTH * PH_PER_LAYER;
#ifndef PROBE_DUP
#define PROBE_DUP 0
#endif
#ifndef MK_PER_PHASE
#define MK_PER_PHASE 0
#endif

__global__ void __launch_bounds__(512, 2) mega(Args args) {
    extern __shared__ __attribute__((aligned(16))) unsigned char lds_raw[];
    LAS unsigned char* lds = (LAS unsigned char*)lds_raw;
    const int tid = threadIdx.x, lane = tid & 63, wave = __builtin_amdgcn_readfirstlane(tid >> 6);
    const int G = gridDim.x, bid = blockIdx.x;
    volatile LAS unsigned* MISC = (volatile LAS unsigned*)(lds + LDSCTL_OFF);
    if (tid < 64) MISC[tid] = 0u;
    __syncthreads();
    const int lo = args.ph_lo, hi = args.ph_hi;
    XcdBarrier bar; bar.bar = (unsigned*)(args.ws + WS_CTL) + 4096; bar.x = 0; bar.st = nullptr;
    if (hi - lo > 1) bar = xcd_barrier_post((unsigned*)(args.ws + WS_CTL) + 4096, MISC + 8);
#define IN(k) (lo <= (k) && (k) < hi)
#define TIDL() int tidl = tid; asm volatile("" : "+v"(tidl)); const int lanel = tidl & 63, wavel = __builtin_amdgcn_readfirstlane(tidl >> 6); (void)lanel; (void)wavel
#define SEAM(k) do { if (IN((k) + 1)) xcd_barrier(bar); } while (0)

    if (IN(0)) { for (int rep = 0; rep < ((PROBE_DUP & 16) ? 2 : 1); ++rep) { TIDL(); p0_prologue(args, lds, G, bid, tidl); } SEAM(0); }

    for (int l = 0; l < DEPTH; ++l) {
        const int pb = 1 + l * PH_PER_LAYER;
        unsigned char* wl = args.ws + WS_W + (size_t)l * LW_END;
        const bf16* HB = (const bf16*)(args.ws + WS_HB); bf16* HID = (bf16*)(args.ws + WS_HID); float* A = (float*)(args.ws + WS_A); float* Z = (float*)(args.ws + WS_Z);
        const float* RS = (const float*)(args.ws + WS_RS);
#define FFN_PHASES(f) do { const int p0 = pb + ((f) ? 10 : 0); \
            if (IN(p0)) { pg8::Gemm g{HB, (const bf16*)(wl + ((f) ? LW_GU2 : LW_GU1)), MT, 2 * FF, DM}; pg8::StaticOrder S; S.init(MT, 2 * FF, G, bid); \
                EpiGU E{HID, RS}; pg8::gemm_phase<EpiGU, pg8::StaticOrder, true, true>(lds, g, S, E); if (PROBE_DUP & 4) pg8::gemm_phase<EpiGU, pg8::StaticOrder, true, true>(lds, g, S, E); SEAM(p0); } \
            if (IN(p0 + 1)) { pg8::Gemm g{HID, (const bf16*)(wl + ((f) ? LW_D2 : LW_D1)), MT, DM, FF}; pg8::StaticOrder S; S.init(MT, DM, G, bid); \
                EpiF32 E{A, DM}; pg8::gemm_phase<EpiF32, pg8::StaticOrder, true, true>(lds, g, S, E); if (PROBE_DUP & 8) pg8::gemm_phase<EpiF32, pg8::StaticOrder, true, true>(lds, g, S, E); SEAM(p0 + 1); } \
            if (IN(p0 + 2)) { TIDL(); norm_res_phase(args, args.in[6] + (size_t)(l * 3 + ((f) ? 2 : 0)) * DM, 0.5f, G, bid, tidl); SEAM(p0 + 2); } } while (0)
        FFN_PHASES(0);
        if (IN(pb + 3)) { pg8::Gemm g{HB, (const bf16*)(wl + LW_IN), MT, INW, DM}; pg8::StaticOrder S; S.init(MT, INW, G, bid);
            EpiWin E{Z, RS, (const float*)(args.ws + WS_LB) + (size_t)l * HW}; pg8::gemm_phase<EpiWin, pg8::StaticOrder, true, true>(lds, g, S, E); SEAM(pb + 3); }
        if (IN(pb + 4)) {
            for (int rep = 0; rep < ((PROBE_DUP & 1) ? 2 : 1); ++rep) {
            TIDL();
            for (int it = bid; it < GITEMS; it += G) gla_a_item(args, it, lds, tidl);
            for (int it = bid; it < DB * HH; it += G) hgrn_sample_item(args, l, it, lds, tidl);
            for (int it = bid * 8 + wavel; it < NB * S5G * S5CH; it += G * 8) s5_pass1_item(args, l, it, lanel);
            }
            SEAM(pb + 4); }
        if (IN(pb + 5)) { TIDL(); gla_b_phase(args, l, G, bid, tidl); SEAM(pb + 5); }
        if (IN(pb + 6)) {
            for (int rep = 0; rep < ((PROBE_DUP & 2) ? 2 : 1); ++rep) {
            TIDL(); const int n5 = NB * S5G * S5CH + DB * S5G, npost = MS * HH;
            for (int it = bid; it < GITEMS; it += G) gla_c_item(args, l, it, lds, tidl);
            for (int it = bid * 8 + wavel; it < n5 + npost; it += G * 8) { if (it < n5) s5_pass2_item(args, l, it, lanel); else hgrn_post_item(args, l, it - n5 + MP * HH, lanel); }
            }
            SEAM(pb + 6); }
        if (IN(pb + 7)) { pg8::Gemm g{(const bf16*)(args.ws + WS_YSG), (const bf16*)(wl + LW_GLU), MT, S5W, S5W}; pg8::StaticOrder S; S.init(MT, S5W, G, bid);
            EpiGlu E{(bf16*)(args.ws + WS_CAT), (const bf16*)(args.ws + WS_YSG), args.in[24] + (size_t)l * S5W}; pg8::gemm_phase<EpiGlu, pg8::StaticOrder, true, true>(lds, g, S, E); SEAM(pb + 7); }
        if (IN(pb + 8)) { pg8::Gemm g{(const bf16*)(args.ws + WS_CAT), (const bf16*)(wl + LW_OUT), MT, DM, DM}; pg8::StaticOrder S; S.init(MT, DM, G, bid);
            EpiF32 E{A, DM}; pg8::gemm_phase<EpiF32, pg8::StaticOrder, true, true>(lds, g, S, E); SEAM(pb + 8); }
        if (IN(pb + 9)) { TIDL(); norm_res_phase(args, args.in[6] + (size_t)(l * 3 + 1) * DM, 1.0f, G, bid, tidl); SEAM(pb + 9); }
        FFN_PHASES(1);
    }
#undef IN
#undef SEAM
}

extern "C" void kernel_launch(void* const* d_in, const int* in_sizes, int n_in, void* d_out, int out_size, void* d_ws, size_t ws_size, hipStream_t stream) {
    static int grid = 0;
    if (grid == 0) {
        if (n_in != 27 || out_size != (int)O_END || ws_size < WS_END2) { fprintf(stderr, "kernel_launch: unexpected shapes: n_in %d out %d ws %zu (need %zu)\n", n_in, out_size, ws_size, (size_t)WS_END2); grid = -1; return; }
        int dev = 0, cus = 0, per_cu = 0;
        if (hipGetDevice(&dev) != hipSuccess || hipDeviceGetAttribute(&cus, hipDeviceAttributeMultiprocessorCount, dev) != hipSuccess) { grid = -1; return; }
        if (hipFuncSetAttribute((const void*)mega, hipFuncAttributeMaxDynamicSharedMemorySize, LDS_BYTES) != hipSuccess) { fprintf(stderr, "kernel_launch: hipFuncSetAttribute failed\n"); grid = -1; return; }
        if (hipOccupancyMaxActiveBlocksPerMultiprocessor(&per_cu, (const void*)mega, 512, LDS_BYTES) != hipSuccess || per_cu < 1) fprintf(stderr, "kernel_launch: occupancy query reports %d\n", per_cu);
        (void)hipGetLastError();
        grid = cus;
    }
    if (grid < 0) return;
    (void)hipMemsetAsync((char*)d_ws + WS_CTL, 0, CTL_ZERO_BYTES, stream);
    Args a{};
    for (int i = 0; i < 27; ++i) a.in[i] = (const float*)d_in[i];
    a.out = (float*)d_out; a.ws = (unsigned char*)d_ws;
#if MK_PER_PHASE
    for (int p = 0; p < N_PHASES; ++p) { a.ph_lo = p; a.ph_hi = p + 1; hipLaunchKernelGGL(mega, dim3(grid), dim3(512), LDS_BYTES, stream, a); }
#else
    a.ph_lo = 0; a.ph_hi = N_PHASES; hipLaunchKernelGGL(mega, dim3(grid), dim3(512), LDS_BYTES, stream, a);
#endif
}
```

```cpp
#include <hip/hip_runtime.h>
#include <cstdio>
#include <cstdint>
namespace pg8 {
#define PG8_LAS __attribute__((address_space(3)))
typedef unsigned short bf16_t;
typedef short bf16x8 __attribute__((ext_vector_type(8)));
typedef float f32x4 __attribute__((ext_vector_type(4)));
typedef unsigned u32x4 __attribute__((ext_vector_type(4)));
constexpr int BM = 256, BK = 64, HALF = 128, HTB = HALF * BK * 2  , STAGE_BYTES = 8 * HTB, NXCD = 8, WGM = 8;

__host__ __device__ __forceinline__ int lds_byte(int r, int c) { const int st = (r >> 4) * 2 + (c >> 5), rr = r & 15, cc = c & 31, ob = rr * 64 + cc * 2; return st * 1024 + (ob ^ (((ob >> 9) & 1) << 5)); }
__host__ __device__ __forceinline__ void stage_rc(int b, int& R, int& C) { const int st = b / 1024, sb = b % 1024, swz = sb ^ (((sb >> 9) & 1) << 5); R = (st >> 1) * 16 + swz / 64; C = (st & 1) * 32 + (swz % 64) / 2; }
__host__ __device__ __forceinline__ int perm32(int rho) { const int n = rho >> 4, i = rho & 15; return 8 * (i >> 2) + 4 * n + (i & 3); }

struct Unit { int pm, pn; };
struct Gemm { const bf16_t* A; const bf16_t* Bt; int M, N, K; };

struct StaticOrder {
    int nM, nN, nwg, G, c;
    __host__ __device__ void init(int M, int N, int G_, int c_) { nM = M / BM; nN = N / BM; nwg = nM * nN; G = G_; c = c_; }
    __host__ __device__ bool next(int i, Unit& u) const {
        const long L = (long)i * G + c; if (L >= nwg) return false;
        int wgid = (int)L; { const int q = nwg / NXCD, r = nwg % NXCD, xcd = wgid % NXCD, off = wgid / NXCD; wgid = (xcd < r ? xcd * (q + 1) : r * (q + 1) + (xcd - r) * q) + off; }
        const int nig = WGM * nN, gid = wgid / nig, fm = gid * WGM, gsz = (nM - fm) < WGM ? (nM - fm) : WGM;
        u.pm = fm + ((wgid % nig) % gsz); u.pn = (wgid % nig) / gsz; return true;
    }
    __device__ __forceinline__ void a_ready(const Unit&) const {}
    __device__ __forceinline__ void done(const Unit&) const {}
};

__device__ __forceinline__ unsigned cvt_pk_bf16(float lo, float hi) { unsigned r; asm volatile("v_cvt_pk_bf16_f32 %0, %1, %2" : "=v"(r) : "v"(lo), "v"(hi)); return r; }
typedef float f32x2 __attribute__((ext_vector_type(2)));
template <class Epi, class Sched, bool ALIGN_EPI = false, bool SP2 = false>
__device__ __forceinline__ void gemm_phase(PG8_LAS unsigned char* lds, const Gemm g, const Sched& S, const Epi& E) {
    int tid_l = threadIdx.x; asm volatile("" : "+v"(tid_l));
    const int tid = tid_l, wid = __builtin_amdgcn_readfirstlane(tid >> 6), lane = tid & 63, wr = wid >> 2, wc = wid & 3, fr = lane & 15, fq = lane >> 4;
    const int K = g.K, nt = K / BK;
    unsigned voffA[2], voffB[2];
#pragma unroll
    for (int i = 0; i < 2; ++i) { int R, C; stage_rc(tid * 16 + i * 8192, R, C); const int Rb = Epi::PERM ? ((R & ~31) + perm32(R & 31)) : R;
        voffA[i] = (unsigned)(R * K + C) * 2u; voffB[i] = (unsigned)(Rb * K + C) * 2u; }
    const size_t kstep = (size_t)(BK * 2);
    const size_t hstep = (size_t)HALF * K * 2;
    const size_t tstep = 2 * hstep;
    const unsigned ldsw = (unsigned)wid * 1024u;
    const int aoff = lds_byte(wr * 64 + fr, fq * 8), boff = lds_byte(wc * 32 + fr, fq * 8);
#define PG8_SA(b, h) (((b) * 2 + (h)) * HTB)
#define PG8_SB(b, h) ((4 + (b) * 2 + (h)) * HTB)
#define PG8_STAGE(bufoff, gbase, voff) do { _Pragma("unroll") for (int _i = 0; _i < 2; ++_i) \
        __builtin_amdgcn_global_load_lds((const unsigned*)((const char*)(gbase) + (voff)[_i]), (PG8_LAS unsigned*)(lds + (bufoff) + ldsw + _i * 8192), 16, 0, 0); } while (0)
#define PG8_LDA(dst, b, h) do { _Pragma("unroll") for (int m = 0; m < 4; ++m) _Pragma("unroll") for (int k = 0; k < 2; ++k) dst[m][k] = *(const PG8_LAS bf16x8*)(lds + PG8_SA(b, h) + aoff + m * 2048 + k * 1024); } while (0)
#define PG8_LDB(dst, b, h) do { _Pragma("unroll") for (int n = 0; n < 2; ++n) _Pragma("unroll") for (int k = 0; k < 2; ++k) dst[n][k] = *(const PG8_LAS bf16x8*)(lds + PG8_SB(b, h) + boff + n * 2048 + k * 1024); } while (0)
#define PG8_MMA(ai, bj, At, Bt) do { __builtin_amdgcn_s_setprio(1); _Pragma("unroll") for (int m = 0; m < 4; ++m) _Pragma("unroll") for (int n = 0; n < 2; ++n) _Pragma("unroll") for (int k = 0; k < 2; ++k) \
        acc[ai][bj][m][n] = __builtin_amdgcn_mfma_f32_16x16x32_bf16(Bt[n][k], At[m][k], acc[ai][bj][m][n], 0, 0, 0); __builtin_amdgcn_s_setprio(0); } while (0)
#define PG8_WAIT_V(n) asm volatile("s_waitcnt vmcnt(" #n ")" ::: "memory")
#define PG8_WAIT_L(n) asm volatile("s_waitcnt lgkmcnt(" #n ")" ::: "memory")
#define PG8_BAR __builtin_amdgcn_s_barrier()
#define PG8_SCHED __builtin_amdgcn_sched_barrier(0)
    Unit cur, nxt; int ui = 0;
    if (!S.next(0, cur)) return;
    f32x4 acc[2][2][4][2];
#pragma unroll
    for (int a = 0; a < 2; ++a)
#pragma unroll
        for (int b = 0; b < 2; ++b)
#pragma unroll
            for (int m = 0; m < 4; ++m)
#pragma unroll
                for (int n = 0; n < 2; ++n) acc[a][b][m][n] = (f32x4){0.f, 0.f, 0.f, 0.f};
    bf16x8 At[4][2], B0[2][2], B1[2][2];
    const char* cA = (const char*)g.A + (size_t)cur.pm * tstep; const char* cB = (const char*)g.Bt + (size_t)cur.pn * tstep;
    S.a_ready(cur);
    if constexpr (SP2) {
        PG8_STAGE(PG8_SB(0, 0), cB, voffB); PG8_STAGE(PG8_SB(0, 1), cB + hstep, voffB); PG8_STAGE(PG8_SA(0, 0), cA, voffA); PG8_STAGE(PG8_SA(0, 1), cA + hstep, voffA);
        if (wr == 1) PG8_BAR;
        PG8_WAIT_V(2); PG8_BAR;
        PG8_STAGE(PG8_SB(1, 0), cB + kstep, voffB); PG8_STAGE(PG8_SA(1, 0), cA + kstep, voffA); PG8_STAGE(PG8_SB(1, 1), cB + hstep + kstep, voffB);
        PG8_WAIT_V(6); PG8_BAR;
    } else {
        PG8_STAGE(PG8_SB(0, 0), cB, voffB); PG8_STAGE(PG8_SA(0, 0), cA, voffA); PG8_STAGE(PG8_SB(0, 1), cB + hstep, voffB); PG8_STAGE(PG8_SA(0, 1), cA + hstep, voffA);
        if (wr == 1) PG8_BAR;
        PG8_WAIT_V(4); PG8_BAR;
        PG8_STAGE(PG8_SB(1, 0), cB + kstep, voffB); PG8_STAGE(PG8_SA(1, 0), cA + kstep, voffA); PG8_STAGE(PG8_SB(1, 1), cB + hstep + kstep, voffB);
        PG8_WAIT_V(6); PG8_BAR;
    }
    for (;;) {
        const bool has_next = S.next(ui + 1, nxt);
        const char* nA = has_next ? (const char*)g.A + (size_t)nxt.pm * tstep : cA; const char* nB = has_next ? (const char*)g.Bt + (size_t)nxt.pn * tstep : cB;
        for (int t = 0; t < nt; t += 2) {
            const bool last = (t == nt - 2);
            const char* a1 = cA + (size_t)(t + 1) * kstep;
            const char* a2 = last ? nA : cA + (size_t)(t + 2) * kstep; const char* b2 = last ? nB : cB + (size_t)(t + 2) * kstep;
            const char* a3 = a2 + kstep; const char* b3 = b2 + kstep;
            if (last && has_next) S.a_ready(nxt);
            if constexpr (SP2) {
            PG8_LDB(B0, 0, 0); PG8_LDB(B1, 0, 1); PG8_SCHED; PG8_LDA(At, 0, 0); PG8_STAGE(PG8_SA(1, 1), a1 + hstep, voffA);
            PG8_WAIT_V(8); PG8_WAIT_L(0); PG8_BAR; PG8_MMA(0, 0, At, B0); PG8_MMA(0, 1, At, B1); PG8_BAR; PG8_SCHED;
            PG8_LDA(At, 0, 1); PG8_STAGE(PG8_SB(0, 0), b2, voffB); PG8_STAGE(PG8_SB(0, 1), b2 + hstep, voffB); PG8_STAGE(PG8_SA(0, 0), a2, voffA);
            PG8_WAIT_V(8); PG8_WAIT_L(0); PG8_BAR; PG8_MMA(1, 0, At, B0); PG8_MMA(1, 1, At, B1); PG8_BAR; PG8_SCHED;
            PG8_LDB(B0, 1, 0); PG8_LDB(B1, 1, 1); PG8_SCHED; PG8_LDA(At, 1, 0); PG8_STAGE(PG8_SA(0, 1), a2 + hstep, voffA);
            PG8_WAIT_V(8); PG8_WAIT_L(0); PG8_BAR; PG8_MMA(0, 0, At, B0); PG8_MMA(0, 1, At, B1); PG8_BAR; PG8_SCHED;
            PG8_LDA(At, 1, 1); PG8_STAGE(PG8_SB(1, 0), b3, voffB); PG8_STAGE(PG8_SB(1, 1), b3 + hstep, voffB); PG8_STAGE(PG8_SA(1, 0), a3, voffA);
            PG8_WAIT_V(8); PG8_WAIT_L(0); PG8_BAR; PG8_MMA(1, 0, At, B0); PG8_MMA(1, 1, At, B1); PG8_BAR; PG8_SCHED;
            } else {
            PG8_LDB(B0, 0, 0); PG8_SCHED; PG8_LDA(At, 0, 0); PG8_STAGE(PG8_SA(1, 1), a1 + hstep, voffA);
            PG8_WAIT_L(8); PG8_BAR; PG8_WAIT_L(0); PG8_MMA(0, 0, At, B0); PG8_BAR; PG8_SCHED;
            PG8_LDB(B1, 0, 1); PG8_STAGE(PG8_SB(0, 0), b2, voffB);
            PG8_BAR; PG8_WAIT_L(0); PG8_MMA(0, 1, At, B1); PG8_BAR;
            PG8_LDA(At, 0, 1); PG8_STAGE(PG8_SA(0, 0), a2, voffA);
            PG8_BAR; PG8_WAIT_L(0); PG8_MMA(1, 0, At, B0); PG8_BAR; PG8_SCHED;
            PG8_STAGE(PG8_SB(0, 1), b2 + hstep, voffB);
            PG8_WAIT_V(6); PG8_BAR; PG8_MMA(1, 1, At, B1); PG8_BAR;
            PG8_LDB(B0, 1, 0); PG8_SCHED; PG8_LDA(At, 1, 0); PG8_STAGE(PG8_SA(0, 1), a2 + hstep, voffA);
            PG8_WAIT_L(8); PG8_BAR; PG8_WAIT_L(0); PG8_MMA(0, 0, At, B0); PG8_BAR; PG8_SCHED;
            PG8_LDB(B1, 1, 1); PG8_STAGE(PG8_SB(1, 0), b3, voffB);
            PG8_BAR; PG8_WAIT_L(0); PG8_MMA(0, 1, At, B1); PG8_BAR;
            PG8_LDA(At, 1, 1); PG8_STAGE(PG8_SA(1, 0), a3, voffA);
            PG8_BAR; PG8_WAIT_L(0); PG8_MMA(1, 0, At, B0); PG8_BAR; PG8_SCHED;
            PG8_STAGE(PG8_SB(1, 1), b3 + hstep, voffB);
            PG8_WAIT_V(6); PG8_BAR; PG8_MMA(1, 1, At, B1); PG8_BAR;
            }
        }
        if constexpr (ALIGN_EPI) { if (wr == 0) PG8_BAR; }
        if constexpr (!Epi::AFTER_DRAIN) { E(acc, cur, wr, wc, fr, fq); S.done(cur); }
        if (!has_next) break;
#pragma unroll
        for (int a = 0; a < 2; ++a)
#pragma unroll
            for (int b = 0; b < 2; ++b)
#pragma unroll
                for (int m = 0; m < 4; ++m)
#pragma unroll
                    for (int n = 0; n < 2; ++n) acc[a][b][m][n] = (f32x4){0.f, 0.f, 0.f, 0.f};
        cur = nxt; cA = nA; cB = nB; ++ui;
        if constexpr (ALIGN_EPI) { if (wr == 1) PG8_BAR; }
    }
    PG8_WAIT_V(0);
    if constexpr (!ALIGN_EPI) { if (wr == 0) PG8_BAR; }
    PG8_BAR;
    if constexpr (Epi::AFTER_DRAIN) { E.fused(acc, cur, wr, wc, fr, fq, lds, wid, lane); S.done(cur); }
#undef PG8_SA
#undef PG8_SB
#undef PG8_STAGE
#undef PG8_LDA
#undef PG8_LDB
#undef PG8_MMA
#undef PG8_WAIT_V
#undef PG8_WAIT_L
#undef PG8_BAR
#undef PG8_SCHED
}
}
#define XB_TMO      128
#define XB_XCNT(j)  (256  + 64 * (j))
#define XB_XSUB(j)  (1280 + 64 * (j))
#define XB_XGEN(j)  (2304 + 64 * (j))
#define XB_TOP      3328
#define XB_TOPGEN   3392
#define XCD_BAR_WORDS 3456
#define XB_SPIN_CAP (1u << 18)
#define LAS __attribute__((address_space(3)))

__device__ __forceinline__ unsigned xb_ld(unsigned* p)              { return __hip_atomic_load(p, __ATOMIC_RELAXED, __HIP_MEMORY_SCOPE_AGENT); }
__device__ __forceinline__ unsigned xb_add(unsigned* p, unsigned v) { return __hip_atomic_fetch_add(p, v, __ATOMIC_RELAXED, __HIP_MEMORY_SCOPE_AGENT); }
__device__ __forceinline__ unsigned xb_xcc_id() { return (unsigned)__builtin_amdgcn_s_getreg((3 << 11) | 20) & 0xFu; }
#define XB_SPIN(cond, bar) do { unsigned _sp = 0; while (cond) { __builtin_amdgcn_s_sleep(1); \
    if ((++_sp & 255u) == 0u) { if (xb_ld(&(bar)[XB_TMO])) break; if (_sp > XB_SPIN_CAP) { atomicAdd(&(bar)[XB_TMO], 1u); break; } } } } while (0)

struct XcdBarrier {
    unsigned* bar; unsigned x;
    volatile LAS unsigned* st;
};

__device__ __forceinline__ XcdBarrier xcd_barrier_post(unsigned* bar, volatile LAS unsigned* st) {
    XcdBarrier b; b.bar = bar; b.x = xb_xcc_id(); b.st = st;
    if (threadIdx.x == 0) (void)xb_add(&bar[XB_XCNT(b.x)], 1u);
    return b;
}
__device__ __forceinline__ void xcd_barrier_complete(unsigned* bar, unsigned x, unsigned& nloc, unsigned& nx) {
    const unsigned G = gridDim.x * gridDim.y * gridDim.z;
    unsigned sum, cnt, mine, sp = 0u;
    for (;;) {
        sum = 0u; cnt = 0u; mine = 0u;
#pragma unroll
        for (unsigned j = 0; j < 16; ++j) { const unsigned c = xb_ld(&bar[XB_XCNT(j)]); sum += c; cnt += (c > 0u) ? 1u : 0u; mine = (j == x) ? c : mine; }
        if (sum == G) break;
        __builtin_amdgcn_s_sleep(1);
        if ((++sp & 255u) == 0u) { if (xb_ld(&bar[XB_TMO])) break; if (sp > XB_SPIN_CAP) { atomicAdd(&bar[XB_TMO], 1u); break; } }
    }
    nloc = mine > 0u ? mine : 1u; nx = cnt > 0u ? cnt : 1u;
}

__device__ __forceinline__ void xcd_barrier(const XcdBarrier& b) {
    asm volatile("s_waitcnt vmcnt(0)" ::: "memory");
    __syncthreads();
    if (threadIdx.x == 0) {
        unsigned* bar = b.bar;
        __builtin_amdgcn_s_waitcnt(0);
        unsigned nloc = b.st[0], nx = b.st[1];
        if (nloc == 0u) { xcd_barrier_complete(bar, b.x, nloc, nx); b.st[0] = nloc; b.st[1] = nx; }
        const unsigned old = xb_add(&bar[XB_XSUB(b.x)], 1u);
        const unsigned gen = old / nloc;
        if (old + 1u == (gen + 1u) * nloc) {
            __builtin_amdgcn_fence(__ATOMIC_RELEASE, "agent");
            asm volatile("s_waitcnt vmcnt(0)" ::: "memory");
            const unsigned og = xb_add(&bar[XB_TOP], 1u);
            const unsigned tg = og / nx;
            if (og + 1u == (tg + 1u) * nx) xb_add(&bar[XB_TOPGEN], 1u);
            else XB_SPIN(xb_ld(&bar[XB_TOPGEN]) == tg, bar);
            __builtin_amdgcn_fence(__ATOMIC_ACQUIRE, "agent");
            xb_add(&bar[XB_XGEN(b.x)], 1u);
            asm volatile("s_waitcnt vmcnt(0)" ::: "memory");
        } else {
            XB_SPIN(xb_ld(&bar[XB_XGEN(b.x)]) == gen, bar);
            __builtin_amdgcn_fence(__ATOMIC_ACQUIRE, "agent");
            asm volatile("s_waitcnt vmcnt(0)" ::: "memory");
        }
    }
    __syncthreads();
}

constexpr int DM = 2048, NB = 4, SEQ = 2048, DEPTH = 4, DB = 128, DSQ = 8;
constexpr int MP = NB * SEQ, MS = DB * DSQ, MT = MP + MS;
constexpr int S5W = 1024, S5G = 64, S5N = 64, S5C = 16;
constexpr int HW = 1024, HH = 8, HK = 128, HV = 128;
constexpr int FF = 5504, INW = 5120;
constexpr float EPS = 1e-6f;
constexpr int S5CH = 16, S5CL = SEQ / S5CH;

constexpr size_t O_Y = 0, O_REP = (size_t)MT * DM, O_IMP = O_REP + (size_t)DEPTH * NB * S5G * S5N, O_HP = O_IMP + (size_t)DEPTH * NB * S5G * S5N,
                 O_RES = O_HP + (size_t)DEPTH * NB * HH * HK * HV, O_IMS = O_RES + (size_t)DEPTH * DB * S5G * S5N, O_HS = O_IMS + (size_t)DEPTH * DB * S5G * S5N,
                 O_END = O_HS + (size_t)DEPTH * DB * HH * HK * HV;
static_assert(O_END == 92405760, "output size");

constexpr size_t MiB = 1u << 20;
constexpr size_t WS_CTL = 0, CTL_ZERO_BYTES = 1 * MiB;
constexpr size_t WS_AB = 1 * MiB;
constexpr size_t WS_BBR = WS_AB + 256 * 1024;
constexpr size_t WS_BBI = WS_BBR + 1 * MiB;
constexpr size_t WS_LB = WS_BBI + 1 * MiB;
constexpr size_t WS_RS = WS_LB + 64 * 1024;
constexpr size_t WS_S5E = WS_RS + 64 * 1024;
constexpr size_t WS_W = 16 * MiB;
constexpr size_t LW_GU1 = 0, LW_D1 = LW_GU1 + (size_t)2 * FF * DM * 2, LW_GU2 = LW_D1 + (size_t)DM * FF * 2, LW_D2 = LW_GU2 + (size_t)2 * FF * DM * 2,
                 LW_IN = LW_D2 + (size_t)DM * FF * 2, LW_GLU = LW_IN + (size_t)INW * DM * 2, LW_OUT = LW_GLU + (size_t)S5W * S5W * 2, LW_END = LW_OUT + (size_t)DM * DM * 2;
static_assert(LW_END == 166723584 && (LW_D1 % 256) == 0 && (LW_GLU % 256) == 0, "weight map");
constexpr size_t WS_HB = 656 * MiB;
constexpr size_t WS_HID = WS_HB + 36 * MiB;
constexpr size_t WS_A = WS_HID + 97 * MiB;
constexpr size_t WS_Z = WS_A + 72 * MiB;
constexpr size_t WS_CAT = WS_Z + 180 * MiB;
constexpr size_t WS_YSG = WS_CAT + 36 * MiB;
constexpr size_t WS_O = WS_YSG + 18 * MiB;
constexpr size_t WS_END = WS_O + 36 * MiB;
static_assert(WS_W + 4 * LW_END <= WS_HB && WS_S5E + 2 * MiB <= WS_W, "ws map");

constexpr int RING_BYTES = 131072, LDSCTL_OFF = RING_BYTES, LDS_BYTES = RING_BYTES + 1024;

#define GAS __attribute__((address_space(1)))
#define LAS __attribute__((address_space(3)))
typedef unsigned short bf16;
typedef float f32x4 __attribute__((ext_vector_type(4)));
typedef float f32x2 __attribute__((ext_vector_type(2)));
typedef unsigned v4u __attribute__((ext_vector_type(4)));
typedef unsigned v2u __attribute__((ext_vector_type(2)));
#define LDS_WAIT() asm volatile("s_waitcnt lgkmcnt(0)" ::: "memory")

__device__ __forceinline__ unsigned f2bf(float f) { unsigned u = __builtin_bit_cast(unsigned, f); return (u + 0x7fffu + ((u >> 16) & 1u)) >> 16; }
__device__ __forceinline__ unsigned pk2(float lo, float hi) { return f2bf(lo) | (f2bf(hi) << 16); }
__device__ __forceinline__ float bflo(unsigned w) { return __builtin_bit_cast(float, w << 16); }
__device__ __forceinline__ float bfhi(unsigned w) { return __builtin_bit_cast(float, w & 0xffff0000u); }
__device__ __forceinline__ float wave_sum(float v) {
#pragma unroll
    for (int o = 1; o < 64; o <<= 1) v += __shfl_xor(v, o);
    return v;
}
__device__ __forceinline__ float sigm(float x) { return 1.f / (1.f + __expf(-x)); }
__device__ __forceinline__ float silu(float x) { return x / (1.f + __expf(-x)); }
__device__ __forceinline__ float gelu_tanh(float v) { const float a = 0.7978845608f * (v + 0.044715f * v * v * v); const float th = 1.f - 2.f / (__expf(2.f * a) + 1.f); return 0.5f * v * (1.f + th); }

struct Args { const float* in[27]; float* out; unsigned char* ws; int ph_lo, ph_hi; };

struct EpiGU {
    static constexpr bool PERM = true, AFTER_DRAIN = false;
    bf16* O; const float* rs;
    __device__ __forceinline__ void operator()(const pg8::f32x4 (&acc)[2][2][4][2], const pg8::Unit& u, int wr, int wc, int fr, int fq) const {
        const int row0 = u.pm * 256 + wr * 64 + fr, col0 = u.pn * 128 + wc * 32 + 8 * fq;
#pragma unroll
        for (int ai = 0; ai < 2; ++ai)
#pragma unroll
            for (int m = 0; m < 4; ++m) {
                const int row = row0 + ai * 128 + m * 16; const float r = rs[row];
                float o[8];
#pragma unroll
                for (int n = 0; n < 2; ++n)
#pragma unroll
                    for (int j = 0; j < 4; ++j) { const float g = acc[ai][0][m][n][j] * r, uu = acc[ai][1][m][n][j] * r; o[4 * n + j] = silu(g) * uu; }
                v4u w; w.x = pk2(o[0], o[1]); w.y = pk2(o[2], o[3]); w.z = pk2(o[4], o[5]); w.w = pk2(o[6], o[7]);
                *(v4u*)(O + (size_t)row * FF + col0) = w;
            }
    }
};
struct EpiF32 {
    static constexpr bool PERM = false, AFTER_DRAIN = false;
    float* C; int ldc;
    __device__ __forceinline__ void operator()(const pg8::f32x4 (&acc)[2][2][4][2], const pg8::Unit& u, int wr, int wc, int fr, int fq) const {
        const int row0 = u.pm * 256 + wr * 64 + fr, col0 = u.pn * 256 + wc * 32 + 4 * fq;
#pragma unroll
        for (int ai = 0; ai < 2; ++ai)
#pragma unroll
            for (int m = 0; m < 4; ++m) { float* rowp = C + (size_t)(row0 + ai * 128 + m * 16) * ldc + col0;
#pragma unroll
                for (int bj = 0; bj < 2; ++bj)
#pragma unroll
                    for (int n = 0; n < 2; ++n) *(f32x4*)(rowp + bj * 128 + n * 16) = acc[ai][bj][m][n]; }
    }
};
struct EpiWin {
    static constexpr bool PERM = false, AFTER_DRAIN = false;
    float* Z; const float* rs; const float* lb;
    __device__ __forceinline__ void operator()(const pg8::f32x4 (&acc)[2][2][4][2], const pg8::Unit& u, int wr, int wc, int fr, int fq) const {
        const int row0 = u.pm * 256 + wr * 64 + fr, col0 = u.pn * 256 + wc * 32 + 4 * fq; const int kind = u.pn >> 2;
#pragma unroll
        for (int ai = 0; ai < 2; ++ai)
#pragma unroll
            for (int m = 0; m < 4; ++m) { const int row = row0 + ai * 128 + m * 16; const float r = rs[row]; float* rowp = Z + (size_t)row * INW + col0;
#pragma unroll
                for (int bj = 0; bj < 2; ++bj)
#pragma unroll
                    for (int n = 0; n < 2; ++n) { f32x4 v = acc[ai][bj][m][n] * r;
                        if (kind == 1) { v[0] = silu(v[0]); v[1] = silu(v[1]); v[2] = silu(v[2]); v[3] = silu(v[3]); }
                        else if (kind == 2) { const f32x4 l4 = *(const f32x4*)(lb + (col0 + bj * 128 + n * 16 - 2048));
#pragma unroll
                            for (int j = 0; j < 4; ++j) v[j] = l4[j] + (1.f - l4[j]) * sigm(v[j]); }
                        *(f32x4*)(rowp + bj * 128 + n * 16) = v; } }
    }
};
struct EpiGlu {
    static constexpr bool PERM = true, AFTER_DRAIN = false;
    bf16* CAT; const bf16* YSG; const float* bias;
    __device__ __forceinline__ void operator()(const pg8::f32x4 (&acc)[2][2][4][2], const pg8::Unit& u, int wr, int wc, int fr, int fq) const {
        const int row0 = u.pm * 256 + wr * 64 + fr, col0 = u.pn * 256 + wc * 32 + 8 * fq;
        f32x4 bv[2][2];
#pragma unroll
        for (int bj = 0; bj < 2; ++bj)
#pragma unroll
            for (int n = 0; n < 2; ++n) bv[bj][n] = *(const f32x4*)(bias + col0 + bj * 128 + 4 * n);
#pragma unroll
        for (int ai = 0; ai < 2; ++ai)
#pragma unroll
            for (int m = 0; m < 4; ++m) { const int row = row0 + ai * 128 + m * 16;
#pragma unroll
                for (int bj = 0; bj < 2; ++bj) { const int col = col0 + bj * 128;
                    const v4u y = *(const v4u*)(YSG + (size_t)row * S5W + col);
                    const f32x4 t0 = acc[ai][bj][m][0] + bv[bj][0], t1 = acc[ai][bj][m][1] + bv[bj][1];
                    v4u w; w.x = pk2(bflo(y.x) * sigm(t0[0]), bfhi(y.x) * sigm(t0[1])); w.y = pk2(bflo(y.y) * sigm(t0[2]), bfhi(y.y) * sigm(t0[3]));
                    w.z = pk2(bflo(y.z) * sigm(t1[0]), bfhi(y.z) * sigm(t1[1])); w.w = pk2(bflo(y.w) * sigm(t1[2]), bfhi(y.w) * sigm(t1[3]));
                    *(v4u*)(CAT + (size_t)row * DM + col) = w; } }
    }
};

__device__ __forceinline__ void s5_tables_item(const Args& a, int lg, LAS unsigned char* lds, int tid);
__device__ __forceinline__ void tr_item(const float* W, int ldw, int j0, int k0, const float* gain, bf16* WT, int K, int n0d, LAS float* scr, int lane) {
#pragma unroll 8
    for (int i = 0; i < 32; ++i) { const int kk = 2 * i + (lane >> 5); float v = W[(size_t)(k0 + kk) * ldw + j0 + (lane & 31)]; if (gain) v *= gain[k0 + kk]; scr[kk * 33 + (lane & 31)] = v; }
    LDS_WAIT(); asm volatile("" ::: "memory");
    const int c = lane & 7;
#pragma unroll
    for (int j = 0; j < 4; ++j) { const int n = (lane >> 3) + 8 * j; const LAS float* s = scr + (8 * c) * 33 + n;
        v4u o; o.x = pk2(s[0 * 33], s[1 * 33]); o.y = pk2(s[2 * 33], s[3 * 33]); o.z = pk2(s[4 * 33], s[5 * 33]); o.w = pk2(s[6 * 33], s[7 * 33]);
        *(v4u*)(WT + (size_t)(n0d + n) * K + k0 + 8 * c) = o; }
    LDS_WAIT(); asm volatile("" ::: "memory");
}
__device__ __forceinline__ void p0_prologue(const Args& a, LAS unsigned char* lds, int G, int bid, int tid) {
    const int wave = __builtin_amdgcn_readfirstlane(tid >> 6), lane = tid & 63;
    LAS float* scr = (LAS float*)(lds + wave * 16384);
    const int gw = bid * 8 + wave, NGW = G * 8;
    constexpr int I_GU = 32 * 344, I_D = 86 * 64, I_IN = 32 * 160, I_GLU = 16 * 32, I_OUT = 32 * 64, I_L = 2 * I_GU + 2 * I_D + I_IN + I_GLU + I_OUT;
    for (int it = gw; it < DEPTH * I_L; it += NGW) {
        const int l = it / I_L; int r = it - l * I_L;
        unsigned char* wl = a.ws + WS_W + (size_t)l * LW_END;
        if (r < 2 * I_GU) { const int f = r / I_GU; r -= f * I_GU; const int kb = r / 344, nb = r % 344, pn = nb >> 3, rr = nb & 7;
            const float* src = (rr < 4 ? a.in[f ? 10 : 7] : a.in[f ? 11 : 8]) + (size_t)l * DM * FF;
            tr_item(src, FF, 128 * pn + 32 * (rr & 3), 64 * kb, a.in[5] + (size_t)(l * 3 + (f ? 2 : 0)) * DM, (bf16*)(wl + (f ? LW_GU2 : LW_GU1)), DM, 32 * nb, scr, lane); continue; }
        r -= 2 * I_GU;
        if (r < 2 * I_D) { const int f = r / I_D; r -= f * I_D; const int kb = r / 64, nb = r % 64;
            tr_item(a.in[f ? 12 : 9] + (size_t)l * FF * DM, DM, 32 * nb, 64 * kb, nullptr, (bf16*)(wl + (f ? LW_D2 : LW_D1)), FF, 32 * nb, scr, lane); continue; }
        r -= 2 * I_D;
        if (r < I_IN) { const int kb = r / 160, nb = r % 160;
            tr_item(a.in[13] + (size_t)l * DM * INW, INW, 32 * nb, 64 * kb, a.in[5] + (size_t)(l * 3 + 1) * DM, (bf16*)(wl + LW_IN), DM, 32 * nb, scr, lane); continue; }
        r -= I_IN;
        if (r < I_GLU) { const int kb = r / 32, nb = r % 32;
            tr_item(a.in[23] + (size_t)l * S5W * S5W, S5W, 32 * nb, 64 * kb, nullptr, (bf16*)(wl + LW_GLU), S5W, 32 * nb, scr, lane); continue; }
        r -= I_GLU;
        { const int kb = r / 64, nb = r % 64;
            tr_item(a.in[14] + (size_t)l * DM * DM, DM, 32 * nb, 64 * kb, nullptr, (bf16*)(wl + LW_OUT), DM, 32 * nb, scr, lane); }
    }
    __syncthreads();
    for (int lg = bid; lg < DEPTH * S5G; lg += G) s5_tables_item(a, lg, lds, tid);
    for (int idx = bid * 512 + tid; idx < HW; idx += G * 512) {
        const float x0 = a.in[25][idx], x1 = a.in[25][HW + idx], x2 = a.in[25][2 * HW + idx], x3 = a.in[25][3 * HW + idx];
        const float mx = fmaxf(fmaxf(x0, x1), fmaxf(x2, x3));
        const float e0 = expf(x0 - mx), e1 = expf(x1 - mx), e2 = expf(x2 - mx), e3 = expf(x3 - mx), inv = 1.f / (e0 + e1 + e2 + e3);
        float* lb = (float*)(a.ws + WS_LB);
        lb[idx] = 0.f; lb[HW + idx] = e1 * inv; lb[2 * HW + idx] = (e1 + e2) * inv; lb[3 * HW + idx] = (e1 + e2 + e3) * inv;
    }
    for (int row = gw; row < MT; row += NGW) {
        const float* xr = row < MP ? a.in[0] + (size_t)row * DM : a.in[1] + (size_t)(row - MP) * DM;
        float* hr = a.out + O_Y + (size_t)row * DM; bf16* hb = (bf16*)(a.ws + WS_HB) + (size_t)row * DM;
        float ss = 0.f;
#pragma unroll
        for (int j = 0; j < 8; ++j) { const f32x4 v = *(const f32x4*)(xr + 4 * lane + 256 * j); ss += (v[0] * v[0] + v[1] * v[1]) + (v[2] * v[2] + v[3] * v[3]);
            *(f32x4*)(hr + 4 * lane + 256 * j) = v; v2u w; w.x = pk2(v[0], v[1]); w.y = pk2(v[2], v[3]); *(v2u*)(hb + 4 * lane + 256 * j) = w; }
        ss = wave_sum(ss);
        if (lane == 0) ((float*)(a.ws + WS_RS))[row] = 1.f / sqrtf(ss * (1.f / DM) + EPS);
    }
}

__device__ __forceinline__ void norm_res_phase(const Args& a, const float* gain, float coef, int G, int bid, int tid) {
    const int wave = __builtin_amdgcn_readfirstlane(tid >> 6), lane = tid & 63;
    const int gw = bid * 8 + wave, NGW = G * 8;
    f32x4 gv[8];
#pragma unroll
    for (int j = 0; j < 8; ++j) gv[j] = *(const f32x4*)(gain + 4 * lane + 256 * j) * coef;
    for (int row = gw; row < MT; row += NGW) {
        const float* ar = (const float*)(a.ws + WS_A) + (size_t)row * DM; float* hr = a.out + O_Y + (size_t)row * DM; bf16* hb = (bf16*)(a.ws + WS_HB) + (size_t)row * DM;
        f32x4 av[8], hv[8]; float ss = 0.f;
#pragma unroll
        for (int j = 0; j < 8; ++j) { av[j] = *(const f32x4*)(ar + 4 * lane + 256 * j); hv[j] = *(const f32x4*)(hr + 4 * lane + 256 * j);
            ss += (av[j][0] * av[j][0] + av[j][1] * av[j][1]) + (av[j][2] * av[j][2] + av[j][3] * av[j][3]); }
        ss = wave_sum(ss);
        const float ra = 1.f / sqrtf(ss * (1.f / DM) + EPS);
        float s2 = 0.f;
#pragma unroll
        for (int j = 0; j < 8; ++j) { const f32x4 v = hv[j] + av[j] * gv[j] * ra; s2 += (v[0] * v[0] + v[1] * v[1]) + (v[2] * v[2] + v[3] * v[3]);
            *(f32x4*)(hr + 4 * lane + 256 * j) = v; v2u w; w.x = pk2(v[0], v[1]); w.y = pk2(v[2], v[3]); *(v2u*)(hb + 4 * lane + 256 * j) = w; }
        s2 = wave_sum(s2);
        if (lane == 0) ((float*)(a.ws + WS_RS))[row] = 1.f / sqrtf(s2 * (1.f / DM) + EPS);
    }
}

__device__ __forceinline__ void hgrn_sample_item(const Args& a, int l, int item, LAS unsigned char* lds, int tid) {
    const int h = item & 7, b = item >> 3, kq = tid >> 5, v4 = tid & 31;
    LAS float* red = (LAS float*)lds;
    const float* s0 = a.in[4] + ((size_t)((l * DB + b) * HH + h) * HK + kq * 8) * HV + 4 * v4;
    float* s1 = a.out + O_HS + ((size_t)((l * DB + b) * HH + h) * HK + kq * 8) * HV + 4 * v4;
    f32x4 S[8];
#pragma unroll
    for (int i = 0; i < 8; ++i) S[i] = *(const f32x4*)(s0 + (size_t)i * HV);
    const float* zb = (const float*)(a.ws + WS_Z) + (size_t)(MP + b * DSQ) * INW + h * HK;
#pragma unroll
    for (int t = 0; t < DSQ; ++t) {
        const float* zr = zb + (size_t)t * INW;
        const f32x4 q0 = *(const f32x4*)(zr + 1024 + kq * 8), q1 = *(const f32x4*)(zr + 1024 + kq * 8 + 4);
        const f32x4 f0 = *(const f32x4*)(zr + 2048 + kq * 8), f1 = *(const f32x4*)(zr + 2048 + kq * 8 + 4);
        const f32x4 vv = *(const f32x4*)(zr + 3072 + 4 * v4);
        f32x4 acc = (f32x4){0.f, 0.f, 0.f, 0.f};
#pragma unroll
        for (int i = 0; i < 8; ++i) { const float f = i < 4 ? f0[i & 3] : f1[i & 3], q = i < 4 ? q0[i & 3] : q1[i & 3]; S[i] = S[i] * f + vv * (1.f - f); acc += S[i] * q; }
        *(LAS f32x4*)(red + (t * 16 + kq) * 128 + 4 * v4) = acc;
    }
#pragma unroll
    for (int i = 0; i < 8; ++i) *(f32x4*)(s1 + (size_t)i * HV) = S[i];
    __syncthreads();
#pragma unroll
    for (int e = 0; e < 2; ++e) { const int idx = tid + 512 * e, t = idx >> 7, v = idx & 127; float s = 0.f;
#pragma unroll
        for (int k = 0; k < 16; ++k) s += red[(t * 16 + k) * 128 + v];
        ((float*)(a.ws + WS_O))[(size_t)(MP + b * DSQ + t) * HW + h * HV + v] = s; }
    __syncthreads();
}
__device__ __forceinline__ void hgrn_post_item(const Args& a, int l, int item, int lane) {
    const int h = item & 7, row = item >> 3;
    const f32x2 o = *(const f32x2*)((const float*)(a.ws + WS_O) + (size_t)row * HW + h * HV + 2 * lane);
    const float ss = wave_sum(o[0] * o[0] + o[1] * o[1]);
    const float r = 1.f / sqrtf(ss * (1.f / HV) + EPS);
    const f32x2 gg = *(const f32x2*)((const float*)(a.ws + WS_Z) + (size_t)row * INW + 4096 + h * HV + 2 * lane);
    const f32x2 gn = *(const f32x2*)(a.in[26] + (size_t)l * HW + h * HV + 2 * lane);
    *(unsigned*)((bf16*)(a.ws + WS_CAT) + (size_t)row * DM + 1024 + h * HV + 2 * lane) = pk2(o[0] * r * gn[0] * silu(gg[0]), o[1] * r * gn[1] * silu(gg[1]));
}

typedef short bf16x8_t __attribute__((ext_vector_type(8)));
constexpr int GC = 64, GNCH = SEQ / GC, GITEMS = NB * HH * GNCH;
constexpr int KS = 272, TS = 144;
constexpr int L_SUM = 0, L_VT = 2048, L_KD = L_VT + 128 * TS;
constexpr int L_Q = L_VT + 128 * TS, L_QR = L_Q + 64 * KS, L_KT = L_QR + 64 * KS, L_ATT = L_KT + 10 * 16 * KS, L_SSQ = L_ATT + 64 * TS, L_RR = L_SSQ + 64 * 8 * 4, L_GEND = L_RR + 256;
static_assert(L_GEND <= RING_BYTES, "GLA LDS map");
constexpr size_t WS_SLOC = WS_END, WS_SIN = WS_SLOC + 64 * MiB, WS_DEC = WS_SIN + 32 * MiB, WS_END2 = WS_DEC + 1 * MiB;

__device__ __forceinline__ v4u pack8(const float (&x)[16], int o) { v4u w; w.x = pk2(x[o], x[o + 1]); w.y = pk2(x[o + 2], x[o + 3]); w.z = pk2(x[o + 4], x[o + 5]); w.w = pk2(x[o + 6], x[o + 7]); return w; }

__device__ __forceinline__ void gla_a_item(const Args& a, int item, LAS unsigned char* lds, int tid) {
    const int j = item & 31, h = (item >> 5) & 7, b = item >> 8;
    const int k = tid & 127, ti = __builtin_amdgcn_readfirstlane(tid >> 7), lane = tid & 63, w = __builtin_amdgcn_readfirstlane(tid >> 6);
    const float* zr = (const float*)(a.ws + WS_Z) + (size_t)(b * SEQ + j * GC + ti * 16) * INW + h * HK + k;
    float fv[16], vv[16];
#pragma unroll
    for (int s = 0; s < 16; ++s) { fv[s] = zr[(size_t)s * INW + 2048]; vv[s] = zr[(size_t)s * INW + 3072]; }
    float c[16]; float run = 0.f;
#pragma unroll
    for (int s = 0; s < 16; ++s) { run += __logf(fv[s]); c[s] = run; }
    LAS float* sums = (LAS float*)(lds + L_SUM);
    sums[ti * 128 + k] = run;
    *(LAS v4u*)(lds + L_VT + k * TS + ti * 32) = pack8(vv, 0); *(LAS v4u*)(lds + L_VT + k * TS + ti * 32 + 16) = pack8(vv, 8);
    __syncthreads();
    const float s0 = sums[k], s1 = sums[128 + k], s2 = sums[256 + k], s3 = sums[384 + k];
    const float P4 = (s0 + s1) + (s2 + s3);
    const float rest = ti == 0 ? (s1 + s2 + s3) : ti == 1 ? (s2 + s3) : ti == 2 ? s3 : 0.f;
    float kd[16];
#pragma unroll
    for (int s = 0; s < 16; ++s) kd[s] = (1.f - fv[s]) * __expf(rest + (run - c[s]));
    *(LAS v4u*)(lds + L_KD + k * TS + ti * 32) = pack8(kd, 0); *(LAS v4u*)(lds + L_KD + k * TS + ti * 32 + 16) = pack8(kd, 8);
    if (ti == 0) ((float*)(a.ws + WS_DEC))[(size_t)item * 128 + k] = __expf(P4);
    __syncthreads();
    const int r = lane & 15, g = lane >> 4;
    bf16x8_t af[2];
#pragma unroll
    for (int st = 0; st < 2; ++st) af[st] = *(const LAS bf16x8_t*)(lds + L_KD + (16 * w + r) * TS + (32 * st + 8 * g) * 2);
    float* out = (float*)(a.ws + WS_SLOC) + (size_t)item * 16384;
#pragma unroll
    for (int vt = 0; vt < 8; ++vt) {
        f32x4 acc = (f32x4){0.f, 0.f, 0.f, 0.f};
#pragma unroll
        for (int st = 0; st < 2; ++st) { const bf16x8_t bfr = *(const LAS bf16x8_t*)(lds + L_VT + (16 * vt + r) * TS + (32 * st + 8 * g) * 2);
            acc = __builtin_amdgcn_mfma_f32_16x16x32_bf16(af[st], bfr, acc, 0, 0, 0); }
        *(f32x4*)(out + (size_t)(16 * vt + r) * 128 + 16 * w + 4 * g) = acc;
    }
    __syncthreads();
}

__device__ __forceinline__ void gla_b_phase(const Args& a, int l, int G, int bid, int tid) {
    for (int gid = bid * 512 + tid; gid < NB * HH * 4096; gid += G * 512) {
        const int bh = gid >> 12, rem = gid & 4095, v = rem >> 5, k4 = (rem & 31) * 4;
        f32x4 S = (f32x4){0.f, 0.f, 0.f, 0.f};
        const float* sl = (const float*)(a.ws + WS_SLOC) + (size_t)(bh * GNCH) * 16384 + v * 128 + k4;
        const float* dc = (const float*)(a.ws + WS_DEC) + (size_t)(bh * GNCH) * 128 + k4;
        bf16* si = (bf16*)(a.ws + WS_SIN) + (size_t)(bh * GNCH) * 16384 + v * 128 + k4;
#pragma unroll 8
        for (int j = 0; j < GNCH; ++j) {
            v2u wv; wv.x = pk2(S[0], S[1]); wv.y = pk2(S[2], S[3]); *(v2u*)(si + (size_t)j * 16384) = wv;
            const f32x4 x = *(const f32x4*)(sl + (size_t)j * 16384), d = *(const f32x4*)(dc + (size_t)j * 128);
            S = d * S + x;
        }
        float* sp = a.out + O_HP + ((size_t)(l * NB * HH + bh) * HK + k4) * HV + v;
#pragma unroll
        for (int i = 0; i < 4; ++i) sp[(size_t)i * HV] = S[i];
    }
}

__device__ __forceinline__ void gla_c_item(const Args& a, int l, int item, LAS unsigned char* lds, int tid) {
    const int j = item & 31, h = (item >> 5) & 7, b = item >> 8;
    const int k = tid & 127, ti = __builtin_amdgcn_readfirstlane(tid >> 7), lane = tid & 63, w = __builtin_amdgcn_readfirstlane(tid >> 6);
    const int r = lane & 15, g = lane >> 4;
    const int row0 = b * SEQ + j * GC;
    const float* zr = (const float*)(a.ws + WS_Z) + (size_t)(row0 + ti * 16) * INW + h * HK + k;
    float fv[16], vv[16], qv[16];
#pragma unroll
    for (int s = 0; s < 16; ++s) { fv[s] = zr[(size_t)s * INW + 2048]; vv[s] = zr[(size_t)s * INW + 3072]; qv[s] = zr[(size_t)s * INW + 1024]; }
    bf16x8_t sfr[4];
    { const bf16* si = (const bf16*)(a.ws + WS_SIN) + (size_t)item * 16384 + (size_t)(16 * w + r) * 128 + 8 * g;
#pragma unroll
      for (int st = 0; st < 4; ++st) sfr[st] = *(const bf16x8_t*)(si + 32 * st); }
    float gz[16];
    { const float* zg = (const float*)(a.ws + WS_Z) + (size_t)row0 * INW + 4096 + h * HV + 16 * w + r;
#pragma unroll
      for (int tt = 0; tt < 4; ++tt)
#pragma unroll
        for (int i = 0; i < 4; ++i) gz[tt * 4 + i] = zg[(size_t)(16 * tt + 4 * g + i) * INW]; }
    const float gn = a.in[26][(size_t)l * HW + h * HV + 16 * w + r];
    float c[16]; float run = 0.f;
#pragma unroll
    for (int s = 0; s < 16; ++s) { run += __logf(fv[s]); c[s] = run; }
    LAS float* sums = (LAS float*)(lds + L_SUM);
    sums[ti * 128 + k] = run;
    *(LAS v4u*)(lds + L_VT + k * TS + ti * 32) = pack8(vv, 0); *(LAS v4u*)(lds + L_VT + k * TS + ti * 32 + 16) = pack8(vv, 8);
    { LAS unsigned* az = (LAS unsigned*)(lds + L_ATT); for (int i = tid; i < 64 * TS / 4; i += 512) az[i] = 0u; }
    __syncthreads();
    const float s0 = sums[k], s1 = sums[128 + k], s2 = sums[256 + k];
    const float myP = ti == 0 ? 0.f : ti == 1 ? s0 : ti == 2 ? (s0 + s1) : (s0 + s1 + s2);
#pragma unroll
    for (int s = 0; s < 16; ++s) {
        const int t = 16 * ti + s;
        *(LAS bf16*)(lds + L_Q + t * KS + k * 2) = (bf16)f2bf(qv[s] * __expf(myP + c[s]));
        *(LAS bf16*)(lds + L_QR + t * KS + k * 2) = (bf16)f2bf(qv[s] * __expf(c[s]));
    }
#pragma unroll
    for (int tp = 0; tp < 4; ++tp) {
        if (tp >= ti) {
            const float dP = (tp == ti) ? 0.f : (tp == ti + 1) ? (ti == 0 ? s0 : ti == 1 ? s1 : s2) : (tp == ti + 2) ? (ti == 0 ? (s0 + s1) : (s1 + s2)) : (s0 + s1 + s2);
            LAS unsigned char* kt = lds + L_KT + (tp * (tp + 1) / 2 + ti) * (16 * KS);
#pragma unroll
            for (int s = 0; s < 16; ++s) *(LAS bf16*)(kt + s * KS + k * 2) = (bf16)f2bf((1.f - fv[s]) * __expf(fminf(dP - c[s], 60.f)));
        }
    }
    __syncthreads();
#pragma unroll
    for (int rep = 0; rep < 2; ++rep) {
        const int q = w + 8 * rep;
        if (q < 10) {
            const int tq = q < 1 ? 0 : q < 3 ? 1 : q < 6 ? 2 : 3, sj = q - tq * (tq + 1) / 2;
            f32x4 acc = (f32x4){0.f, 0.f, 0.f, 0.f};
#pragma unroll
            for (int st = 0; st < 4; ++st) {
                const bf16x8_t af = *(const LAS bf16x8_t*)(lds + L_QR + (16 * tq + r) * KS + (32 * st + 8 * g) * 2);
                const bf16x8_t bfr = *(const LAS bf16x8_t*)(lds + L_KT + q * (16 * KS) + r * KS + (32 * st + 8 * g) * 2);
                acc = __builtin_amdgcn_mfma_f32_16x16x32_bf16(af, bfr, acc, 0, 0, 0);
            }
#pragma unroll
            for (int i = 0; i < 4; ++i) { const int t = 16 * tq + 4 * g + i, s = 16 * sj + r; *(LAS bf16*)(lds + L_ATT + t * TS + s * 2) = (bf16)f2bf(s <= t ? acc[i] : 0.f); }
        }
    }
    __syncthreads();
    f32x4 o[4];
#pragma unroll
    for (int tt = 0; tt < 4; ++tt) {
        f32x4 acc = (f32x4){0.f, 0.f, 0.f, 0.f};
#pragma unroll
        for (int st = 0; st < 4; ++st) { const bf16x8_t af = *(const LAS bf16x8_t*)(lds + L_Q + (16 * tt + r) * KS + (32 * st + 8 * g) * 2);
            acc = __builtin_amdgcn_mfma_f32_16x16x32_bf16(af, sfr[st], acc, 0, 0, 0); }
#pragma unroll
        for (int st = 0; st < 2; ++st) if (st == 0 || tt >= 2) {
            const bf16x8_t af = *(const LAS bf16x8_t*)(lds + L_ATT + (16 * tt + r) * TS + (32 * st + 8 * g) * 2);
            const bf16x8_t bfr = *(const LAS bf16x8_t*)(lds + L_VT + (16 * w + r) * TS + (32 * st + 8 * g) * 2);
            acc = __builtin_amdgcn_mfma_f32_16x16x32_bf16(af, bfr, acc, 0, 0, 0); }
        o[tt] = acc;
    }
    LAS float* ssq = (LAS float*)(lds + L_SSQ); LAS float* rr = (LAS float*)(lds + L_RR);
#pragma unroll
    for (int tt = 0; tt < 4; ++tt)
#pragma unroll
        for (int i = 0; i < 4; ++i) { float p = o[tt][i] * o[tt][i]; p += __shfl_xor(p, 1); p += __shfl_xor(p, 2); p += __shfl_xor(p, 4); p += __shfl_xor(p, 8);
            if (r == 0) ssq[(16 * tt + 4 * g + i) * 8 + w] = p; }
    __syncthreads();
    if (tid < 64) { float s = 0.f;
#pragma unroll
        for (int x = 0; x < 8; ++x) s += ssq[tid * 8 + x];
        rr[tid] = 1.f / sqrtf(s * (1.f / HV) + EPS); }
    __syncthreads();
    bf16* cp = (bf16*)(a.ws + WS_CAT) + (size_t)row0 * DM + 1024 + h * HV + 16 * w + r;
#pragma unroll
    for (int tt = 0; tt < 4; ++tt)
#pragma unroll
        for (int i = 0; i < 4; ++i) { const int t = 16 * tt + 4 * g + i; cp[(size_t)t * DM] = (bf16)f2bf(o[tt][i] * rr[t] * gn * silu(gz[tt * 4 + i])); }
    __syncthreads();
}
constexpr int S5ITEMS = S5G * 40, S5IPG = 40;
constexpr size_t WS_S5K = WS_END2, WS_S5P = WS_S5K + 2 * MiB, WS_S5Q = WS_S5P + 16 * MiB, WS_S5A = WS_S5Q + 16 * MiB, WS_S5T = WS_S5A + 1 * MiB, WS_END3 = WS_S5T + 1 * MiB;
constexpr int L5_K = 0, L5_U = 8192, L5_XL = 16384, L5_XIN = L5_XL + 128 * 17 * 4, L5_END = L5_XIN + 16 * 272;
constexpr int LP_AP = 0, LP_BB = LP_AP + 17 * 64 * 8, LP_C = LP_BB + 64 * 16 * 8, LP_END = LP_C + 16 * 64 * 8;

__device__ __forceinline__ f32x2 cmul(f32x2 x, f32x2 y) { return (f32x2){x[0] * y[0] - x[1] * y[1], x[0] * y[1] + x[1] * y[0]}; }

__device__ __forceinline__ void s5_tables_item(const Args& a, int lg, LAS unsigned char* lds, int tid) {
    LAS f32x2* ap = (LAS f32x2*)(lds + LP_AP); LAS f32x2* bbl = (LAS f32x2*)(lds + LP_BB); LAS f32x2* cl = (LAS f32x2*)(lds + LP_C);
    const float dt = expf(a.in[17][lg]);
#pragma unroll 1
    for (int idx = tid; idx < 17 * 64; idx += 512) { const int tau = idx >> 6, n = idx & 63; const float lr = a.in[15][lg * 64 + n], li = a.in[16][lg * 64 + n];
        const float mag = expf(lr * dt * (float)tau), ang = li * dt * (float)tau; ap[idx] = (f32x2){mag * cosf(ang), mag * sinf(ang)}; }
#pragma unroll 1
    for (int idx = tid; idx < 64 * 16; idx += 512) { const int n = idx >> 4; const float lr = a.in[15][lg * 64 + n], li = a.in[16][lg * 64 + n];
        const float mag = expf(lr * dt), ang = li * dt; const float are = mag * cosf(ang), aim = mag * sinf(ang);
        const float p = are - 1.f, q = aim, den = lr * lr + li * li; const float zre = (p * lr + q * li) / den, zim = (q * lr - p * li) / den;
        const float br = a.in[18][(size_t)lg * 1024 + idx], bi = a.in[19][(size_t)lg * 1024 + idx];
        bbl[idx] = (f32x2){zre * br - zim * bi, zre * bi + zim * br};
        cl[idx] = (f32x2){a.in[20][(size_t)lg * 1024 + idx], a.in[21][(size_t)lg * 1024 + idx]}; }
    if (tid < 64) { const float lr = a.in[15][lg * 64 + tid], li = a.in[16][lg * 64 + tid];
        const float m16 = expf(lr * dt * 16.f), g16 = li * dt * 16.f, m8 = expf(-lr * dt * 8.f), g8 = -li * dt * 8.f;
        f32x2* A = (f32x2*)(a.ws + WS_S5A); A[lg * 64 + tid] = (f32x2){m16 * cosf(g16), m16 * sinf(g16)}; A[16384 + lg * 64 + tid] = (f32x2){m8 * cosf(g8), m8 * sinf(g8)}; }
    __syncthreads();
    bf16* Kt = (bf16*)(a.ws + WS_S5K) + (size_t)lg * 4096; bf16* Pt = (bf16*)(a.ws + WS_S5P) + (size_t)lg * 32768; bf16* Qt = (bf16*)(a.ws + WS_S5Q) + (size_t)lg * 32768;
#pragma unroll 1
    for (int idx = tid; idx < 4096; idx += 512) { const int tau = idx >> 8, c = (idx >> 4) & 15, cp = idx & 15; float s = 0.f;
#pragma unroll 4
        for (int n = 0; n < 64; ++n) { const f32x2 w = cmul(ap[tau * 64 + n], bbl[n * 16 + cp]); const f32x2 cc = cl[c * 64 + n]; s += cc[0] * w[0] - cc[1] * w[1]; }
        Kt[idx] = (bf16)f2bf(s); }
#pragma unroll 2
    for (int idx = tid; idx < 32768; idx += 512) { const int row = idx >> 7, np = idx & 127, k = row >> 4, c = row & 15, n = np & 63;
        const f32x2 A = ap[(k + 1) * 64 + n], cc = cl[c * 64 + n];
        Pt[idx] = (bf16)f2bf(np < 64 ? (cc[0] * A[0] - cc[1] * A[1]) : -(cc[0] * A[1] + cc[1] * A[0])); }
#pragma unroll 2
    for (int idx = tid; idx < 32768; idx += 512) { const int np = idx >> 8, col = idx & 255, s = col >> 4, cp = col & 15, n = np & 63;
        const f32x2 w = cmul(ap[(15 - s) * 64 + n], bbl[n * 16 + cp]);
        Qt[idx] = (bf16)f2bf(np < 64 ? w[0] : w[1]); }
    __syncthreads();
}

struct S5Ctx { int g; };

template <int PASS>
__device__ __forceinline__ void s5_item(const Args& a, int l, int item, S5Ctx& cx, LAS unsigned char* lds, int tid) {
    const int lane = tid & 63, w = __builtin_amdgcn_readfirstlane(tid >> 6), r = lane & 15, g8 = lane >> 4;
    const int g = item / S5IPG, idx = item - g * S5IPG; const bool sample = idx >= 32;
    if (PASS == 1 && sample) return;
    const int lg = l * S5G + g;
    if (g != cx.g) {
        cx.g = g;
        __syncthreads();
        { const v4u* src = (const v4u*)((const bf16*)(a.ws + WS_S5K) + (size_t)lg * 4096); ((LAS v4u*)(lds + L5_K))[tid] = src[tid]; }
        __syncthreads();
    }
    bf16x8_t qf[8];
    { const bf16* Qt = (const bf16*)(a.ws + WS_S5Q) + (size_t)lg * 32768 + (size_t)(16 * w + r) * 256 + 8 * g8;
#pragma unroll
      for (int st = 0; st < 8; ++st) qf[st] = *(const bf16x8_t*)(Qt + 32 * st); }
    const int b = idx >> 3, tile = idx & 7;
    const int stile = idx - 32;
    const float* Z = (const float*)(a.ws + WS_Z);
    {
        const int s = 2 * w + (g8 >> 1);
        v4u fr = (v4u){0u, 0u, 0u, 0u};
        if (!sample || s >= 8) {
            const size_t row = sample ? (size_t)(MP + (stile * 16 + r) * DSQ + (s - 8)) : (size_t)(b * SEQ + tile * 256 + r * 16 + s);
            const f32x4 u0 = *(const f32x4*)(Z + row * INW + 16 * g + 8 * (g8 & 1)), u1 = *(const f32x4*)(Z + row * INW + 16 * g + 8 * (g8 & 1) + 4);
            fr.x = pk2(u0[0], u0[1]); fr.y = pk2(u0[2], u0[3]); fr.z = pk2(u1[0], u1[1]); fr.w = pk2(u1[2], u1[3]);
        }
        ((LAS v4u*)(lds + L5_U))[w * 64 + lane] = fr;
    }
    __syncthreads();
    bf16x8_t uf[8];
#pragma unroll
    for (int st = 0; st < 8; ++st) uf[st] = ((const LAS bf16x8_t*)(lds + L5_U))[st * 64 + lane];
    {
        f32x4 acc = (f32x4){0.f, 0.f, 0.f, 0.f};
#pragma unroll
        for (int st = 0; st < 8; ++st) acc = __builtin_amdgcn_mfma_f32_16x16x32_bf16(qf[st], uf[st], acc, 0, 0, 0);
        LAS float* XL = (LAS float*)(lds + L5_XL);
#pragma unroll
        for (int i = 0; i < 4; ++i) XL[(16 * w + 4 * g8 + i) * 17 + r] = acc[i];
    }
    __syncthreads();
    if (w == 0) {
        const LAS float* XL = (const LAS float*)(lds + L5_XL);
        const f32x2 a16 = ((const f32x2*)(a.ws + WS_S5A))[lg * 64 + lane];
        if (!sample) {
            f32x2 X = (f32x2){0.f, 0.f};
            f32x2* E = (f32x2*)(a.ws + WS_S5T) + (size_t)((b * S5G + g) * 8) * 64 + lane;
            if (PASS == 2) { f32x2 a256 = a16;
#pragma unroll
                for (int q = 0; q < 4; ++q) a256 = cmul(a256, a256);
                for (int tt = 0; tt < tile; ++tt) { const f32x2 e = E[tt * 64]; X = cmul(a256, X) + e; } }
#pragma unroll
            for (int c = 0; c < 16; ++c) {
                if (PASS == 2) { *(LAS bf16*)(lds + L5_XIN + c * 272 + lane * 2) = (bf16)f2bf(X[0]); *(LAS bf16*)(lds + L5_XIN + c * 272 + (64 + lane) * 2) = (bf16)f2bf(X[1]); }
                X = cmul(a16, X) + (f32x2){XL[lane * 17 + c], XL[(64 + lane) * 17 + c]};
            }
            if (PASS == 1) E[tile * 64] = X;
            else if (tile == 7) { const size_t so = (size_t)((l * NB + b) * S5G + g) * S5N + lane; a.out[O_REP + so] = X[0]; a.out[O_IMP + so] = X[1]; }
        } else if (PASS == 2) {
            const f32x2 am8 = ((const f32x2*)(a.ws + WS_S5A))[16384 + lg * 64 + lane];
#pragma unroll
            for (int c = 0; c < 16; ++c) {
                const size_t si = (size_t)((l * DB + stile * 16 + c) * S5G + g) * S5N + lane;
                const f32x2 xv = cmul(am8, (f32x2){a.in[2][si], a.in[3][si]});
                *(LAS bf16*)(lds + L5_XIN + c * 272 + lane * 2) = (bf16)f2bf(xv[0]); *(LAS bf16*)(lds + L5_XIN + c * 272 + (64 + lane) * 2) = (bf16)f2bf(xv[1]);
                const f32x2 xo = cmul(a16, xv) + (f32x2){XL[lane * 17 + c], XL[(64 + lane) * 17 + c]};
                a.out[O_RES + si] = xo[0]; a.out[O_IMS + si] = xo[1];
            }
        }
    }
    if (PASS == 2) {
        __syncthreads();
        bf16x8_t xf[4];
#pragma unroll
        for (int st = 0; st < 4; ++st) xf[st] = *(const LAS bf16x8_t*)(lds + L5_XIN + r * 272 + (32 * st + 8 * g8) * 2);
        const f32x4 dv = *(const f32x4*)(a.in[22] + (size_t)l * S5W + 16 * g + 4 * g8);
#pragma unroll
        for (int x = 0; x < 2; ++x) {
            const int k = x ? 15 - w : w;
            if (!sample || k >= 8) {
                f32x4 acc = (f32x4){0.f, 0.f, 0.f, 0.f};
                const int nst = (k >> 1) + 1;
#pragma unroll
                for (int st = 0; st < 8; ++st) if (st < nst) {
                    const int tau = k - 2 * st - (g8 >> 1);
                    bf16x8_t kf = (bf16x8_t){0, 0, 0, 0, 0, 0, 0, 0};
                    if (tau >= 0) kf = *(const LAS bf16x8_t*)(lds + L5_K + tau * 512 + r * 32 + (g8 & 1) * 16);
                    acc = __builtin_amdgcn_mfma_f32_16x16x32_bf16(kf, uf[st], acc, 0, 0, 0);
                }
                { const bf16* Pt = (const bf16*)(a.ws + WS_S5P) + (size_t)lg * 32768 + (size_t)(16 * k + r) * 128 + 8 * g8;
#pragma unroll
                  for (int st = 0; st < 4; ++st) { const bf16x8_t pf = *(const bf16x8_t*)(Pt + 32 * st); acc = __builtin_amdgcn_mfma_f32_16x16x32_bf16(pf, xf[st], acc, 0, 0, 0); } }
                const size_t row = sample ? (size_t)(MP + (stile * 16 + r) * DSQ + (k - 8)) : (size_t)(b * SEQ + tile * 256 + r * 16 + k);
                const f32x4 uu = *(const f32x4*)(Z + row * INW + 16 * g + 4 * g8);
                v2u o; o.x = pk2(gelu_tanh(acc[0] + dv[0] * uu[0]), gelu_tanh(acc[1] + dv[1] * uu[1])); o.y = pk2(gelu_tanh(acc[2] + dv[2] * uu[2]), gelu_tanh(acc[3] + dv[3] * uu[3]));
                *(v2u*)((bf16*)(a.ws + WS_YSG) + row * S5W + 16 * g + 4 * g8) = o;
            }
        }
    }
    __syncthreads();
}

constexpr int PH_PER_LAYER = 13, N_PHASES = 1 + DEPTH * PH_PER_LAYER;
#ifndef PROBE_DUP
#define PROBE_DUP 0
#endif
#ifndef MK_PER_PHASE
#define MK_PER_PHASE 0
#endif

__global__ void __launch_bounds__(512, 2) mega(Args args) {
    extern __shared__ __attribute__((aligned(16))) unsigned char lds_raw[];
    LAS unsigned char* lds = (LAS unsigned char*)lds_raw;
    const int tid = threadIdx.x, lane = tid & 63, wave = __builtin_amdgcn_readfirstlane(tid >> 6);
    const int G = gridDim.x, bid = blockIdx.x;
    volatile LAS unsigned* MISC = (volatile LAS unsigned*)(lds + LDSCTL_OFF);
    if (tid < 64) MISC[tid] = 0u;
    __syncthreads();
    const int lo = args.ph_lo, hi = args.ph_hi;
    XcdBarrier bar; bar.bar = (unsigned*)(args.ws + WS_CTL) + 4096; bar.x = 0; bar.st = nullptr;
    if (hi - lo > 1) bar = xcd_barrier_post((unsigned*)(args.ws + WS_CTL) + 4096, MISC + 8);
#define IN(k) (lo <= (k) && (k) < hi)
#define TIDL() int tidl = tid; asm volatile("" : "+v"(tidl)); const int lanel = tidl & 63, wavel = __builtin_amdgcn_readfirstlane(tidl >> 6); (void)lanel; (void)wavel
#define SEAM(k) do { if (IN((k) + 1)) xcd_barrier(bar); } while (0)

    if (IN(0)) { for (int rep = 0; rep < ((PROBE_DUP & 16) ? 2 : 1); ++rep) { TIDL(); p0_prologue(args, lds, G, bid, tidl); } SEAM(0); }

    for (int l = 0; l < DEPTH; ++l) {
        const int pb = 1 + l * PH_PER_LAYER;
        unsigned char* wl = args.ws + WS_W + (size_t)l * LW_END;
        const bf16* HB = (const bf16*)(args.ws + WS_HB); bf16* HID = (bf16*)(args.ws + WS_HID); float* A = (float*)(args.ws + WS_A); float* Z = (float*)(args.ws + WS_Z);
        const float* RS = (const float*)(args.ws + WS_RS);
#define FFN_PHASES(f) do { const int p0 = pb + ((f) ? 10 : 0); \
            if (IN(p0)) { pg8::Gemm g{HB, (const bf16*)(wl + ((f) ? LW_GU2 : LW_GU1)), MT, 2 * FF, DM}; pg8::StaticOrder S; S.init(MT, 2 * FF, G, bid); \
                EpiGU E{HID, RS}; pg8::gemm_phase<EpiGU, pg8::StaticOrder, true, true>(lds, g, S, E); if (PROBE_DUP & 4) pg8::gemm_phase<EpiGU, pg8::StaticOrder, true, true>(lds, g, S, E); SEAM(p0); } \
            if (IN(p0 + 1)) { pg8::Gemm g{HID, (const bf16*)(wl + ((f) ? LW_D2 : LW_D1)), MT, DM, FF}; pg8::StaticOrder S; S.init(MT, DM, G, bid); \
                EpiF32 E{A, DM}; pg8::gemm_phase<EpiF32, pg8::StaticOrder, true, true>(lds, g, S, E); if (PROBE_DUP & 8) pg8::gemm_phase<EpiF32, pg8::StaticOrder, true, true>(lds, g, S, E); SEAM(p0 + 1); } \
            if (IN(p0 + 2)) { TIDL(); norm_res_phase(args, args.in[6] + (size_t)(l * 3 + ((f) ? 2 : 0)) * DM, 0.5f, G, bid, tidl); SEAM(p0 + 2); } } while (0)
        FFN_PHASES(0);
        if (IN(pb + 3)) { pg8::Gemm g{HB, (const bf16*)(wl + LW_IN), MT, INW, DM}; pg8::StaticOrder S; S.init(MT, INW, G, bid);
            EpiWin E{Z, RS, (const float*)(args.ws + WS_LB) + (size_t)l * HW}; pg8::gemm_phase<EpiWin, pg8::StaticOrder, true, true>(lds, g, S, E); SEAM(pb + 3); }
        if (IN(pb + 4)) {
            for (int rep = 0; rep < ((PROBE_DUP & 1) ? 2 : 1); ++rep) {
            TIDL();
            for (int it = bid; it < GITEMS; it += G) gla_a_item(args, it, lds, tidl);
            for (int it = bid; it < DB * HH; it += G) hgrn_sample_item(args, l, it, lds, tidl);
            { S5Ctx cx; cx.g = -1; const int ipb = (S5ITEMS + G - 1) / G; const int i1 = (bid + 1) * ipb < S5ITEMS ? (bid + 1) * ipb : S5ITEMS;
              for (int it = bid * ipb; it < i1; ++it) s5_item<1>(args, l, it, cx, lds, tidl); }
            }
            SEAM(pb + 4); }
        if (IN(pb + 5)) { TIDL(); gla_b_phase(args, l, G, bid, tidl); SEAM(pb + 5); }
        if (IN(pb + 6)) {
            for (int rep = 0; rep < ((PROBE_DUP & 2) ? 2 : 1); ++rep) {
            TIDL(); const int npost = MS * HH;
            for (int it = bid; it < GITEMS; it += G) gla_c_item(args, l, it, lds, tidl);
            { S5Ctx cx; cx.g = -1; const int ipb = (S5ITEMS + G - 1) / G; const int i1 = (bid + 1) * ipb < S5ITEMS ? (bid + 1) * ipb : S5ITEMS;
              for (int it = bid * ipb; it < i1; ++it) s5_item<2>(args, l, it, cx, lds, tidl); }
            for (int it = bid * 8 + wavel; it < npost; it += G * 8) hgrn_post_item(args, l, it + MP * HH, lanel);
            }
            SEAM(pb + 6); }
        if (IN(pb + 7)) { pg8::Gemm g{(const bf16*)(args.ws + WS_YSG), (const bf16*)(wl + LW_GLU), MT, S5W, S5W}; pg8::StaticOrder S; S.init(MT, S5W, G, bid);
            EpiGlu E{(bf16*)(args.ws + WS_CAT), (const bf16*)(args.ws + WS_YSG), args.in[24] + (size_t)l * S5W}; pg8::gemm_phase<EpiGlu, pg8::StaticOrder, true, true>(lds, g, S, E); SEAM(pb + 7); }
        if (IN(pb + 8)) { pg8::Gemm g{(const bf16*)(args.ws + WS_CAT), (const bf16*)(wl + LW_OUT), MT, DM, DM}; pg8::StaticOrder S; S.init(MT, DM, G, bid);
            EpiF32 E{A, DM}; pg8::gemm_phase<EpiF32, pg8::StaticOrder, true, true>(lds, g, S, E); SEAM(pb + 8); }
        if (IN(pb + 9)) { TIDL(); norm_res_phase(args, args.in[6] + (size_t)(l * 3 + 1) * DM, 1.0f, G, bid, tidl); SEAM(pb + 9); }
        FFN_PHASES(1);
    }
#undef IN
#undef SEAM
}

extern "C" void kernel_launch(void* const* d_in, const int* in_sizes, int n_in, void* d_out, int out_size, void* d_ws, size_t ws_size, hipStream_t stream) {
    static int grid = 0;
    if (grid == 0) {
        if (n_in != 27 || out_size != (int)O_END || ws_size < WS_END3) { fprintf(stderr, "kernel_launch: unexpected shapes: n_in %d out %d ws %zu (need %zu)\n", n_in, out_size, ws_size, (size_t)WS_END3); grid = -1; return; }
        int dev = 0, cus = 0, per_cu = 0;
        if (hipGetDevice(&dev) != hipSuccess || hipDeviceGetAttribute(&cus, hipDeviceAttributeMultiprocessorCount, dev) != hipSuccess) { grid = -1; return; }
        if (hipFuncSetAttribute((const void*)mega, hipFuncAttributeMaxDynamicSharedMemorySize, LDS_BYTES) != hipSuccess) { fprintf(stderr, "kernel_launch: hipFuncSetAttribute failed\n"); grid = -1; return; }
        if (hipOccupancyMaxActiveBlocksPerMultiprocessor(&per_cu, (const void*)mega, 512, LDS_BYTES) != hipSuccess || per_cu < 1) fprintf(stderr, "kernel_launch: occupancy query reports %d\n", per_cu);
        (void)hipGetLastError();
        grid = cus;
    }
    if (grid < 0) return;
    (void)hipMemsetAsync((char*)d_ws + WS_CTL, 0, CTL_ZERO_BYTES, stream);
    Args a{};
    for (int i = 0; i < 27; ++i) a.in[i] = (const float*)d_in[i];
    a.out = (float*)d_out; a.ws = (unsigned char*)d_ws;
#if MK_PER_PHASE
    for (int p = 0; p < N_PHASES; ++p) { a.ph_lo = p; a.ph_hi = p + 1; hipLaunchKernelGGL(mega, dim3(grid), dim3(512), LDS_BYTES, stream, a); }
#else
    a.ph_lo = 0; a.ph_hi = N_PHASES; hipLaunchKernelGGL(mega, dim3(grid), dim3(512), LDS_BYTES, stream, a);
#endif
}
```

```cpp
#include <hip/hip_runtime.h>
#include <cstdio>
#include <cstdint>
namespace pg8 {
#define PG8_LAS __attribute__((address_space(3)))
typedef unsigned short bf16_t;
typedef short bf16x8 __attribute__((ext_vector_type(8)));
typedef float f32x4 __attribute__((ext_vector_type(4)));
typedef unsigned u32x4 __attribute__((ext_vector_type(4)));
constexpr int BM = 256, BK = 64, HALF = 128, HTB = HALF * BK * 2  , STAGE_BYTES = 8 * HTB, NXCD = 8, WGM = 8;

__host__ __device__ __forceinline__ int lds_byte(int r, int c) { const int st = (r >> 4) * 2 + (c >> 5), rr = r & 15, cc = c & 31, ob = rr * 64 + cc * 2; return st * 1024 + (ob ^ (((ob >> 9) & 1) << 5)); }
__host__ __device__ __forceinline__ void stage_rc(int b, int& R, int& C) { const int st = b / 1024, sb = b % 1024, swz = sb ^ (((sb >> 9) & 1) << 5); R = (st >> 1) * 16 + swz / 64; C = (st & 1) * 32 + (swz % 64) / 2; }
__host__ __device__ __forceinline__ int perm32(int rho) { const int n = rho >> 4, i = rho & 15; return 8 * (i >> 2) + 4 * n + (i & 3); }

struct Unit { int pm, pn; };
struct Gemm { const bf16_t* A; const bf16_t* Bt; int M, N, K; };

struct StaticOrder {
    int nM, nN, nwg, G, c;
    __host__ __device__ void init(int M, int N, int G_, int c_) { nM = M / BM; nN = N / BM; nwg = nM * nN; G = G_; c = c_; }
    __host__ __device__ bool next(int i, Unit& u) const {
        const long L = (long)i * G + c; if (L >= nwg) return false;
        int wgid = (int)L; { const int q = nwg / NXCD, r = nwg % NXCD, xcd = wgid % NXCD, off = wgid / NXCD; wgid = (xcd < r ? xcd * (q + 1) : r * (q + 1) + (xcd - r) * q) + off; }
        const int nig = WGM * nN, gid = wgid / nig, fm = gid * WGM, gsz = (nM - fm) < WGM ? (nM - fm) : WGM;
        u.pm = fm + ((wgid % nig) % gsz); u.pn = (wgid % nig) / gsz; return true;
    }
    __device__ __forceinline__ void a_ready(const Unit&) const {}
    __device__ __forceinline__ void done(const Unit&) const {}
};

__device__ __forceinline__ unsigned cvt_pk_bf16(float lo, float hi) { unsigned r; asm volatile("v_cvt_pk_bf16_f32 %0, %1, %2" : "=v"(r) : "v"(lo), "v"(hi)); return r; }
typedef float f32x2 __attribute__((ext_vector_type(2)));
template <class Epi, class Sched, bool ALIGN_EPI = false, bool SP2 = false>
__device__ __forceinline__ void gemm_phase(PG8_LAS unsigned char* lds, const Gemm g, const Sched& S, const Epi& E) {
    int tid_l = threadIdx.x; asm volatile("" : "+v"(tid_l));
    const int tid = tid_l, wid = __builtin_amdgcn_readfirstlane(tid >> 6), lane = tid & 63, wr = wid >> 2, wc = wid & 3, fr = lane & 15, fq = lane >> 4;
    const int K = g.K, nt = K / BK;
    unsigned voffA[2], voffB[2];
#pragma unroll
    for (int i = 0; i < 2; ++i) { int R, C; stage_rc(tid * 16 + i * 8192, R, C); const int Rb = Epi::PERM ? ((R & ~31) + perm32(R & 31)) : R;
        voffA[i] = (unsigned)(R * K + C) * 2u; voffB[i] = (unsigned)(Rb * K + C) * 2u; }
    const size_t kstep = (size_t)(BK * 2);
    const size_t hstep = (size_t)HALF * K * 2;
    const size_t tstep = 2 * hstep;
    const unsigned ldsw = (unsigned)wid * 1024u;
    const int aoff = lds_byte(wr * 64 + fr, fq * 8), boff = lds_byte(wc * 32 + fr, fq * 8);
#define PG8_SA(b, h) (((b) * 2 + (h)) * HTB)
#define PG8_SB(b, h) ((4 + (b) * 2 + (h)) * HTB)
#define PG8_STAGE(bufoff, gbase, voff) do { _Pragma("unroll") for (int _i = 0; _i < 2; ++_i) \
        __builtin_amdgcn_global_load_lds((const unsigned*)((const char*)(gbase) + (voff)[_i]), (PG8_LAS unsigned*)(lds + (bufoff) + ldsw + _i * 8192), 16, 0, 0); } while (0)
#define PG8_LDA(dst, b, h) do { _Pragma("unroll") for (int m = 0; m < 4; ++m) _Pragma("unroll") for (int k = 0; k < 2; ++k) dst[m][k] = *(const PG8_LAS bf16x8*)(lds + PG8_SA(b, h) + aoff + m * 2048 + k * 1024); } while (0)
#define PG8_LDB(dst, b, h) do { _Pragma("unroll") for (int n = 0; n < 2; ++n) _Pragma("unroll") for (int k = 0; k < 2; ++k) dst[n][k] = *(const PG8_LAS bf16x8*)(lds + PG8_SB(b, h) + boff + n * 2048 + k * 1024); } while (0)
#define PG8_MMA(ai, bj, At, Bt) do { __builtin_amdgcn_s_setprio(1); _Pragma("unroll") for (int m = 0; m < 4; ++m) _Pragma("unroll") for (int n = 0; n < 2; ++n) _Pragma("unroll") for (int k = 0; k < 2; ++k) \
        acc[ai][bj][m][n] = __builtin_amdgcn_mfma_f32_16x16x32_bf16(Bt[n][k], At[m][k], acc[ai][bj][m][n], 0, 0, 0); __builtin_amdgcn_s_setprio(0); } while (0)
#define PG8_WAIT_V(n) asm volatile("s_waitcnt vmcnt(" #n ")" ::: "memory")
#define PG8_WAIT_L(n) asm volatile("s_waitcnt lgkmcnt(" #n ")" ::: "memory")
#define PG8_BAR __builtin_amdgcn_s_barrier()
#define PG8_SCHED __builtin_amdgcn_sched_barrier(0)
    Unit cur, nxt; int ui = 0;
    if (!S.next(0, cur)) return;
    f32x4 acc[2][2][4][2];
#pragma unroll
    for (int a = 0; a < 2; ++a)
#pragma unroll
        for (int b = 0; b < 2; ++b)
#pragma unroll
            for (int m = 0; m < 4; ++m)
#pragma unroll
                for (int n = 0; n < 2; ++n) acc[a][b][m][n] = (f32x4){0.f, 0.f, 0.f, 0.f};
    bf16x8 At[4][2], B0[2][2], B1[2][2];
    const char* cA = (const char*)g.A + (size_t)cur.pm * tstep; const char* cB = (const char*)g.Bt + (size_t)cur.pn * tstep;
    S.a_ready(cur);
    if constexpr (SP2) {
        PG8_STAGE(PG8_SB(0, 0), cB, voffB); PG8_STAGE(PG8_SB(0, 1), cB + hstep, voffB); PG8_STAGE(PG8_SA(0, 0), cA, voffA); PG8_STAGE(PG8_SA(0, 1), cA + hstep, voffA);
        if (wr == 1) PG8_BAR;
        PG8_WAIT_V(2); PG8_BAR;
        PG8_STAGE(PG8_SB(1, 0), cB + kstep, voffB); PG8_STAGE(PG8_SA(1, 0), cA + kstep, voffA); PG8_STAGE(PG8_SB(1, 1), cB + hstep + kstep, voffB);
        PG8_WAIT_V(6); PG8_BAR;
    } else {
        PG8_STAGE(PG8_SB(0, 0), cB, voffB); PG8_STAGE(PG8_SA(0, 0), cA, voffA); PG8_STAGE(PG8_SB(0, 1), cB + hstep, voffB); PG8_STAGE(PG8_SA(0, 1), cA + hstep, voffA);
        if (wr == 1) PG8_BAR;
        PG8_WAIT_V(4); PG8_BAR;
        PG8_STAGE(PG8_SB(1, 0), cB + kstep, voffB); PG8_STAGE(PG8_SA(1, 0), cA + kstep, voffA); PG8_STAGE(PG8_SB(1, 1), cB + hstep + kstep, voffB);
        PG8_WAIT_V(6); PG8_BAR;
    }
    for (;;) {
        const bool has_next = S.next(ui + 1, nxt);
        const char* nA = has_next ? (const char*)g.A + (size_t)nxt.pm * tstep : cA; const char* nB = has_next ? (const char*)g.Bt + (size_t)nxt.pn * tstep : cB;
        for (int t = 0; t < nt; t += 2) {
            const bool last = (t == nt - 2);
            const char* a1 = cA + (size_t)(t + 1) * kstep;
            const char* a2 = last ? nA : cA + (size_t)(t + 2) * kstep; const char* b2 = last ? nB : cB + (size_t)(t + 2) * kstep;
            const char* a3 = a2 + kstep; const char* b3 = b2 + kstep;
            if (last && has_next) S.a_ready(nxt);
            if constexpr (SP2) {
            PG8_LDB(B0, 0, 0); PG8_LDB(B1, 0, 1); PG8_SCHED; PG8_LDA(At, 0, 0); PG8_STAGE(PG8_SA(1, 1), a1 + hstep, voffA);
            PG8_WAIT_V(8); PG8_WAIT_L(0); PG8_BAR; PG8_MMA(0, 0, At, B0); PG8_MMA(0, 1, At, B1); PG8_BAR; PG8_SCHED;
            PG8_LDA(At, 0, 1); PG8_STAGE(PG8_SB(0, 0), b2, voffB); PG8_STAGE(PG8_SB(0, 1), b2 + hstep, voffB); PG8_STAGE(PG8_SA(0, 0), a2, voffA);
            PG8_WAIT_V(8); PG8_WAIT_L(0); PG8_BAR; PG8_MMA(1, 0, At, B0); PG8_MMA(1, 1, At, B1); PG8_BAR; PG8_SCHED;
            PG8_LDB(B0, 1, 0); PG8_LDB(B1, 1, 1); PG8_SCHED; PG8_LDA(At, 1, 0); PG8_STAGE(PG8_SA(0, 1), a2 + hstep, voffA);
            PG8_WAIT_V(8); PG8_WAIT_L(0); PG8_BAR; PG8_MMA(0, 0, At, B0); PG8_MMA(0, 1, At, B1); PG8_BAR; PG8_SCHED;
            PG8_LDA(At, 1, 1); PG8_STAGE(PG8_SB(1, 0), b3, voffB); PG8_STAGE(PG8_SB(1, 1), b3 + hstep, voffB); PG8_STAGE(PG8_SA(1, 0), a3, voffA);
            PG8_WAIT_V(8); PG8_WAIT_L(0); PG8_BAR; PG8_MMA(1, 0, At, B0); PG8_MMA(1, 1, At, B1); PG8_BAR; PG8_SCHED;
            } else {
            PG8_LDB(B0, 0, 0); PG8_SCHED; PG8_LDA(At, 0, 0); PG8_STAGE(PG8_SA(1, 1), a1 + hstep, voffA);
            PG8_WAIT_L(8); PG8_BAR; PG8_WAIT_L(0); PG8_MMA(0, 0, At, B0); PG8_BAR; PG8_SCHED;
            PG8_LDB(B1, 0, 1); PG8_STAGE(PG8_SB(0, 0), b2, voffB);
            PG8_BAR; PG8_WAIT_L(0); PG8_MMA(0, 1, At, B1); PG8_BAR;
            PG8_LDA(At, 0, 1); PG8_STAGE(PG8_SA(0, 0), a2, voffA);
            PG8_BAR; PG8_WAIT_L(0); PG8_MMA(1, 0, At, B0); PG8_BAR; PG8_SCHED;
            PG8_STAGE(PG8_SB(0, 1), b2 + hstep, voffB);
            PG8_WAIT_V(6); PG8_BAR; PG8_MMA(1, 1, At, B1); PG8_BAR;
            PG8_LDB(B0, 1, 0); PG8_SCHED; PG8_LDA(At, 1, 0); PG8_STAGE(PG8_SA(0, 1), a2 + hstep, voffA);
            PG8_WAIT_L(8); PG8_BAR; PG8_WAIT_L(0); PG8_MMA(0, 0, At, B0); PG8_BAR; PG8_SCHED;
            PG8_LDB(B1, 1, 1); PG8_STAGE(PG8_SB(1, 0), b3, voffB);
            PG8_BAR; PG8_WAIT_L(0); PG8_MMA(0, 1, At, B1); PG8_BAR;
            PG8_LDA(At, 1, 1); PG8_STAGE(PG8_SA(1, 0), a3, voffA);
            PG8_BAR; PG8_WAIT_L(0); PG8_MMA(1, 0, At, B0); PG8_BAR; PG8_SCHED;
            PG8_STAGE(PG8_SB(1, 1), b3 + hstep, voffB);
            PG8_WAIT_V(6); PG8_BAR; PG8_MMA(1, 1, At, B1); PG8_BAR;
            }
        }
        if constexpr (ALIGN_EPI) { if (wr == 0) PG8_BAR; }
        if constexpr (!Epi::AFTER_DRAIN) { E(acc, cur, wr, wc, fr, fq); S.done(cur); }
        if (!has_next) break;
#pragma unroll
        for (int a = 0; a < 2; ++a)
#pragma unroll
            for (int b = 0; b < 2; ++b)
#pragma unroll
                for (int m = 0; m < 4; ++m)
#pragma unroll
                    for (int n = 0; n < 2; ++n) acc[a][b][m][n] = (f32x4){0.f, 0.f, 0.f, 0.f};
        cur = nxt; cA = nA; cB = nB; ++ui;
        if constexpr (ALIGN_EPI) { if (wr == 1) PG8_BAR; }
    }
    PG8_WAIT_V(0);
    if constexpr (!ALIGN_EPI) { if (wr == 0) PG8_BAR; }
    PG8_BAR;
    if constexpr (Epi::AFTER_DRAIN) { E.fused(acc, cur, wr, wc, fr, fq, lds, wid, lane); S.done(cur); }
#undef PG8_SA
#undef PG8_SB
#undef PG8_STAGE
#undef PG8_LDA
#undef PG8_LDB
#undef PG8_MMA
#undef PG8_WAIT_V
#undef PG8_WAIT_L
#undef PG8_BAR
#undef PG8_SCHED
}
}
#define XB_TMO      128
#define XB_XCNT(j)  (256  + 64 * (j))
#define XB_XSUB(j)  (1280 + 64 * (j))
#define XB_XGEN(j)  (2304 + 64 * (j))
#define XB_TOP      3328
#define XB_TOPGEN   3392
#define XCD_BAR_WORDS 3456
#define XB_SPIN_CAP (1u << 18)
#define LAS __attribute__((address_space(3)))

__device__ __forceinline__ unsigned xb_ld(unsigned* p)              { return __hip_atomic_load(p, __ATOMIC_RELAXED, __HIP_MEMORY_SCOPE_AGENT); }
__device__ __forceinline__ unsigned xb_add(unsigned* p, unsigned v) { return __hip_atomic_fetch_add(p, v, __ATOMIC_RELAXED, __HIP_MEMORY_SCOPE_AGENT); }
__device__ __forceinline__ unsigned xb_xcc_id() { return (unsigned)__builtin_amdgcn_s_getreg((3 << 11) | 20) & 0xFu; }
#define XB_SPIN(cond, bar) do { unsigned _sp = 0; while (cond) { __builtin_amdgcn_s_sleep(1); \
    if ((++_sp & 255u) == 0u) { if (xb_ld(&(bar)[XB_TMO])) break; if (_sp > XB_SPIN_CAP) { atomicAdd(&(bar)[XB_TMO], 1u); break; } } } } while (0)

struct XcdBarrier {
    unsigned* bar; unsigned x;
    volatile LAS unsigned* st;
};

__device__ __forceinline__ XcdBarrier xcd_barrier_post(unsigned* bar, volatile LAS unsigned* st) {
    XcdBarrier b; b.bar = bar; b.x = xb_xcc_id(); b.st = st;
    if (threadIdx.x == 0) (void)xb_add(&bar[XB_XCNT(b.x)], 1u);
    return b;
}
__device__ __forceinline__ void xcd_barrier_complete(unsigned* bar, unsigned x, unsigned& nloc, unsigned& nx) {
    const unsigned G = gridDim.x * gridDim.y * gridDim.z;
    unsigned sum, cnt, mine, sp = 0u;
    for (;;) {
        sum = 0u; cnt = 0u; mine = 0u;
#pragma unroll
        for (unsigned j = 0; j < 16; ++j) { const unsigned c = xb_ld(&bar[XB_XCNT(j)]); sum += c; cnt += (c > 0u) ? 1u : 0u; mine = (j == x) ? c : mine; }
        if (sum == G) break;
        __builtin_amdgcn_s_sleep(1);
        if ((++sp & 255u) == 0u) { if (xb_ld(&bar[XB_TMO])) break; if (sp > XB_SPIN_CAP) { atomicAdd(&bar[XB_TMO], 1u); break; } }
    }
    nloc = mine > 0u ? mine : 1u; nx = cnt > 0u ? cnt : 1u;
}

__device__ __forceinline__ void xcd_barrier(const XcdBarrier& b) {
    asm volatile("s_waitcnt vmcnt(0)" ::: "memory");
    __syncthreads();
    if (threadIdx.x == 0) {
        unsigned* bar = b.bar;
        __builtin_amdgcn_s_waitcnt(0);
        unsigned nloc = b.st[0], nx = b.st[1];
        if (nloc == 0u) { xcd_barrier_complete(bar, b.x, nloc, nx); b.st[0] = nloc; b.st[1] = nx; }
        const unsigned old = xb_add(&bar[XB_XSUB(b.x)], 1u);
        const unsigned gen = old / nloc;
        if (old + 1u == (gen + 1u) * nloc) {
            __builtin_amdgcn_fence(__ATOMIC_RELEASE, "agent");
            asm volatile("s_waitcnt vmcnt(0)" ::: "memory");
            const unsigned og = xb_add(&bar[XB_TOP], 1u);
            const unsigned tg = og / nx;
            if (og + 1u == (tg + 1u) * nx) xb_add(&bar[XB_TOPGEN], 1u);
            else XB_SPIN(xb_ld(&bar[XB_TOPGEN]) == tg, bar);
            __builtin_amdgcn_fence(__ATOMIC_ACQUIRE, "agent");
            xb_add(&bar[XB_XGEN(b.x)], 1u);
            asm volatile("s_waitcnt vmcnt(0)" ::: "memory");
        } else {
            XB_SPIN(xb_ld(&bar[XB_XGEN(b.x)]) == gen, bar);
            __builtin_amdgcn_fence(__ATOMIC_ACQUIRE, "agent");
            asm volatile("s_waitcnt vmcnt(0)" ::: "memory");
        }
    }
    __syncthreads();
}

constexpr int DM = 2048, NB = 4, SEQ = 2048, DEPTH = 4, DB = 128, DSQ = 8;
constexpr int MP = NB * SEQ, MS = DB * DSQ, MT = MP + MS;
constexpr int S5W = 1024, S5G = 64, S5N = 64, S5C = 16;
constexpr int HW = 1024, HH = 8, HK = 128, HV = 128;
constexpr int FF = 5504, INW = 5120;
constexpr float EPS = 1e-6f;
constexpr int S5CH = 16, S5CL = SEQ / S5CH;

constexpr size_t O_Y = 0, O_REP = (size_t)MT * DM, O_IMP = O_REP + (size_t)DEPTH * NB * S5G * S5N, O_HP = O_IMP + (size_t)DEPTH * NB * S5G * S5N,
                 O_RES = O_HP + (size_t)DEPTH * NB * HH * HK * HV, O_IMS = O_RES + (size_t)DEPTH * DB * S5G * S5N, O_HS = O_IMS + (size_t)DEPTH * DB * S5G * S5N,
                 O_END = O_HS + (size_t)DEPTH * DB * HH * HK * HV;
static_assert(O_END == 92405760, "output size");

constexpr size_t MiB = 1u << 20;
constexpr size_t WS_CTL = 0, CTL_ZERO_BYTES = 1 * MiB;
constexpr size_t WS_AB = 1 * MiB;
constexpr size_t WS_BBR = WS_AB + 256 * 1024;
constexpr size_t WS_BBI = WS_BBR + 1 * MiB;
constexpr size_t WS_LB = WS_BBI + 1 * MiB;
constexpr size_t WS_RS = WS_LB + 64 * 1024;
constexpr size_t WS_S5E = WS_RS + 64 * 1024;
constexpr size_t WS_W = 16 * MiB;
constexpr size_t LW_GU1 = 0, LW_D1 = LW_GU1 + (size_t)2 * FF * DM * 2, LW_GU2 = LW_D1 + (size_t)DM * FF * 2, LW_D2 = LW_GU2 + (size_t)2 * FF * DM * 2,
                 LW_IN = LW_D2 + (size_t)DM * FF * 2, LW_GLU = LW_IN + (size_t)INW * DM * 2, LW_OUT = LW_GLU + (size_t)S5W * S5W * 2, LW_END = LW_OUT + (size_t)DM * DM * 2;
static_assert(LW_END == 166723584 && (LW_D1 % 256) == 0 && (LW_GLU % 256) == 0, "weight map");
constexpr size_t WS_HB = 656 * MiB;
constexpr size_t WS_HID = WS_HB + 36 * MiB;
constexpr size_t WS_A = WS_HID + 97 * MiB;
constexpr size_t WS_Z = WS_A + 72 * MiB;
constexpr size_t WS_CAT = WS_Z + 180 * MiB;
constexpr size_t WS_YSG = WS_CAT + 36 * MiB;
constexpr size_t WS_O = WS_YSG + 18 * MiB;
constexpr size_t WS_END = WS_O + 36 * MiB;
static_assert(WS_W + 4 * LW_END <= WS_HB && WS_S5E + 2 * MiB <= WS_W, "ws map");

constexpr int RING_BYTES = 131072, LDSCTL_OFF = RING_BYTES, LDS_BYTES = RING_BYTES + 1024;

#define GAS __attribute__((address_space(1)))
#define LAS __attribute__((address_space(3)))
typedef unsigned short bf16;
typedef float f32x4 __attribute__((ext_vector_type(4)));
typedef float f32x2 __attribute__((ext_vector_type(2)));
typedef unsigned v4u __attribute__((ext_vector_type(4)));
typedef unsigned v2u __attribute__((ext_vector_type(2)));
#define LDS_WAIT() asm volatile("s_waitcnt lgkmcnt(0)" ::: "memory")

__device__ __forceinline__ unsigned f2bf(float f) { unsigned u = __builtin_bit_cast(unsigned, f); return (u + 0x7fffu + ((u >> 16) & 1u)) >> 16; }
__device__ __forceinline__ unsigned pk2(float lo, float hi) { return f2bf(lo) | (f2bf(hi) << 16); }
__device__ __forceinline__ float bflo(unsigned w) { return __builtin_bit_cast(float, w << 16); }
__device__ __forceinline__ float bfhi(unsigned w) { return __builtin_bit_cast(float, w & 0xffff0000u); }
__device__ __forceinline__ float wave_sum(float v) {
#pragma unroll
    for (int o = 1; o < 64; o <<= 1) v += __shfl_xor(v, o);
    return v;
}
__device__ __forceinline__ float sigm(float x) { return 1.f / (1.f + __expf(-x)); }
__device__ __forceinline__ float silu(float x) { return x / (1.f + __expf(-x)); }
__device__ __forceinline__ float gelu_tanh(float v) { const float a = 0.7978845608f * (v + 0.044715f * v * v * v); const float th = 1.f - 2.f / (__expf(2.f * a) + 1.f); return 0.5f * v * (1.f + th); }

struct Args { const float* in[27]; float* out; unsigned char* ws; int ph_lo, ph_hi; };

struct EpiGU {
    static constexpr bool PERM = true, AFTER_DRAIN = false;
    bf16* O; const float* rs;
    __device__ __forceinline__ void operator()(const pg8::f32x4 (&acc)[2][2][4][2], const pg8::Unit& u, int wr, int wc, int fr, int fq) const {
        const int row0 = u.pm * 256 + wr * 64 + fr, col0 = u.pn * 128 + wc * 32 + 8 * fq;
#pragma unroll
        for (int ai = 0; ai < 2; ++ai)
#pragma unroll
            for (int m = 0; m < 4; ++m) {
                const int row = row0 + ai * 128 + m * 16; const float r = rs[row];
                float o[8];
#pragma unroll
                for (int n = 0; n < 2; ++n)
#pragma unroll
                    for (int j = 0; j < 4; ++j) { const float g = acc[ai][0][m][n][j] * r, uu = acc[ai][1][m][n][j] * r; o[4 * n + j] = silu(g) * uu; }
                v4u w; w.x = pk2(o[0], o[1]); w.y = pk2(o[2], o[3]); w.z = pk2(o[4], o[5]); w.w = pk2(o[6], o[7]);
                *(v4u*)(O + (size_t)row * FF + col0) = w;
            }
    }
};
struct EpiF32 {
    static constexpr bool PERM = false, AFTER_DRAIN = false;
    float* C; int ldc;
    __device__ __forceinline__ void operator()(const pg8::f32x4 (&acc)[2][2][4][2], const pg8::Unit& u, int wr, int wc, int fr, int fq) const {
        const int row0 = u.pm * 256 + wr * 64 + fr, col0 = u.pn * 256 + wc * 32 + 4 * fq;
#pragma unroll
        for (int ai = 0; ai < 2; ++ai)
#pragma unroll
            for (int m = 0; m < 4; ++m) { float* rowp = C + (size_t)(row0 + ai * 128 + m * 16) * ldc + col0;
#pragma unroll
                for (int bj = 0; bj < 2; ++bj)
#pragma unroll
                    for (int n = 0; n < 2; ++n) *(f32x4*)(rowp + bj * 128 + n * 16) = acc[ai][bj][m][n]; }
    }
};
struct EpiWin {
    static constexpr bool PERM = false, AFTER_DRAIN = false;
    float* Z; const float* rs; const float* lb;
    __device__ __forceinline__ void operator()(const pg8::f32x4 (&acc)[2][2][4][2], const pg8::Unit& u, int wr, int wc, int fr, int fq) const {
        const int row0 = u.pm * 256 + wr * 64 + fr, col0 = u.pn * 256 + wc * 32 + 4 * fq; const int kind = u.pn >> 2;
#pragma unroll
        for (int ai = 0; ai < 2; ++ai)
#pragma unroll
            for (int m = 0; m < 4; ++m) { const int row = row0 + ai * 128 + m * 16; const float r = rs[row]; float* rowp = Z + (size_t)row * INW + col0;
#pragma unroll
                for (int bj = 0; bj < 2; ++bj)
#pragma unroll
                    for (int n = 0; n < 2; ++n) { f32x4 v = acc[ai][bj][m][n] * r;
                        if (kind == 1) { v[0] = silu(v[0]); v[1] = silu(v[1]); v[2] = silu(v[2]); v[3] = silu(v[3]); }
                        else if (kind == 2) { const f32x4 l4 = *(const f32x4*)(lb + (col0 + bj * 128 + n * 16 - 2048));
#pragma unroll
                            for (int j = 0; j < 4; ++j) v[j] = l4[j] + (1.f - l4[j]) * sigm(v[j]); }
                        *(f32x4*)(rowp + bj * 128 + n * 16) = v; } }
    }
};
struct EpiGlu {
    static constexpr bool PERM = true, AFTER_DRAIN = false;
    bf16* CAT; const bf16* YSG; const float* bias;
    __device__ __forceinline__ void operator()(const pg8::f32x4 (&acc)[2][2][4][2], const pg8::Unit& u, int wr, int wc, int fr, int fq) const {
        const int row0 = u.pm * 256 + wr * 64 + fr, col0 = u.pn * 256 + wc * 32 + 8 * fq;
        f32x4 bv[2][2];
#pragma unroll
        for (int bj = 0; bj < 2; ++bj)
#pragma unroll
            for (int n = 0; n < 2; ++n) bv[bj][n] = *(const f32x4*)(bias + col0 + bj * 128 + 4 * n);
#pragma unroll
        for (int ai = 0; ai < 2; ++ai)
#pragma unroll
            for (int m = 0; m < 4; ++m) { const int row = row0 + ai * 128 + m * 16;
#pragma unroll
                for (int bj = 0; bj < 2; ++bj) { const int col = col0 + bj * 128;
                    const v4u y = *(const v4u*)(YSG + (size_t)row * S5W + col);
                    const f32x4 t0 = acc[ai][bj][m][0] + bv[bj][0], t1 = acc[ai][bj][m][1] + bv[bj][1];
                    v4u w; w.x = pk2(bflo(y.x) * sigm(t0[0]), bfhi(y.x) * sigm(t0[1])); w.y = pk2(bflo(y.y) * sigm(t0[2]), bfhi(y.y) * sigm(t0[3]));
                    w.z = pk2(bflo(y.z) * sigm(t1[0]), bfhi(y.z) * sigm(t1[1])); w.w = pk2(bflo(y.w) * sigm(t1[2]), bfhi(y.w) * sigm(t1[3]));
                    *(v4u*)(CAT + (size_t)row * DM + col) = w; } }
    }
};

__device__ __forceinline__ void s5_tables_item(const Args& a, int lg, LAS unsigned char* lds, int tid);
constexpr int I_GU = 32 * 344, I_D = 86 * 64, I_IN = 32 * 160, I_GLU = 16 * 32, I_OUT = 32 * 64;
constexpr int OI_GU1 = 0, OI_D1 = OI_GU1 + I_GU, OI_IN = OI_D1 + I_D, OI_GLU = OI_IN + I_IN, OI_OUT = OI_GLU + I_GLU, OI_GU2 = OI_OUT + I_OUT, OI_D2 = OI_GU2 + I_GU, I_L = OI_D2 + I_D;
static_assert(I_L == 40704, "items per layer");
struct TrDesc { const float* src; const float* gain; bf16* dst; int ldw, K; };
__device__ __forceinline__ TrDesc tr_decode(const Args& a, int it) {
    const int l = it / I_L; int r = it - l * I_L; TrDesc d;
    unsigned char* wl = a.ws + WS_W + (size_t)l * LW_END;
    if (r >= OI_GU2 && r < OI_D2 || r < OI_D1) { const int f = r >= OI_GU2; r -= f ? OI_GU2 : 0; const int kb = r / 344, nb = r % 344, pn = nb >> 3, rr = nb & 7;
        d.src = (rr < 4 ? a.in[f ? 10 : 7] : a.in[f ? 11 : 8]) + (size_t)l * DM * FF + (size_t)(64 * kb) * FF + 128 * pn + 32 * (rr & 3); d.ldw = FF;
        d.gain = a.in[5] + (size_t)(l * 3 + (f ? 2 : 0)) * DM + 64 * kb; d.dst = (bf16*)(wl + (f ? LW_GU2 : LW_GU1)) + (size_t)(32 * nb) * DM + 64 * kb; d.K = DM; return d; }
    if (r >= OI_D2 || r < OI_IN) { const int f = r >= OI_D2; r -= f ? OI_D2 : OI_D1; const int kb = r / 64, nb = r % 64;
        d.src = a.in[f ? 12 : 9] + (size_t)l * FF * DM + (size_t)(64 * kb) * DM + 32 * nb; d.ldw = DM; d.gain = nullptr; d.dst = (bf16*)(wl + (f ? LW_D2 : LW_D1)) + (size_t)(32 * nb) * FF + 64 * kb; d.K = FF; return d; }
    if (r < OI_GLU) { r -= OI_IN; const int kb = r / 160, nb = r % 160;
        d.src = a.in[13] + (size_t)l * DM * INW + (size_t)(64 * kb) * INW + 32 * nb; d.ldw = INW; d.gain = a.in[5] + (size_t)(l * 3 + 1) * DM + 64 * kb; d.dst = (bf16*)(wl + LW_IN) + (size_t)(32 * nb) * DM + 64 * kb; d.K = DM; return d; }
    if (r < OI_OUT) { r -= OI_GLU; const int kb = r / 32, nb = r % 32;
        d.src = a.in[23] + (size_t)l * S5W * S5W + (size_t)(64 * kb) * S5W + 32 * nb; d.ldw = S5W; d.gain = nullptr; d.dst = (bf16*)(wl + LW_GLU) + (size_t)(32 * nb) * S5W + 64 * kb; d.K = S5W; return d; }
    { r -= OI_OUT; const int kb = r / 64, nb = r % 64;
        d.src = a.in[14] + (size_t)l * DM * DM + (size_t)(64 * kb) * DM + 32 * nb; d.ldw = DM; d.gain = nullptr; d.dst = (bf16*)(wl + LW_OUT) + (size_t)(32 * nb) * DM + 64 * kb; d.K = DM; return d; }
}
__device__ __forceinline__ void tr_load(const TrDesc& d, float (&v)[32], int lane) {
    const float* p = d.src + (size_t)(lane >> 5) * d.ldw + (lane & 31);
#pragma unroll
    for (int i = 0; i < 32; ++i) v[i] = __builtin_nontemporal_load(p + (size_t)(2 * i) * d.ldw);
}
__device__ __forceinline__ void tr_store(const TrDesc& d, const float (&v)[32], LAS float* scr, int lane) {
    if (d.gain) {
#pragma unroll
        for (int i = 0; i < 32; ++i) scr[(2 * i + (lane >> 5)) * 33 + (lane & 31)] = v[i] * d.gain[2 * i + (lane >> 5)];
    } else {
#pragma unroll
        for (int i = 0; i < 32; ++i) scr[(2 * i + (lane >> 5)) * 33 + (lane & 31)] = v[i];
    }
    LDS_WAIT(); asm volatile("" ::: "memory");
    const int c = lane & 7;
#pragma unroll
    for (int j = 0; j < 4; ++j) { const int n = (lane >> 3) + 8 * j; const LAS float* s = scr + (8 * c) * 33 + n;
        v4u o; o.x = pk2(s[0 * 33], s[1 * 33]); o.y = pk2(s[2 * 33], s[3 * 33]); o.z = pk2(s[4 * 33], s[5 * 33]); o.w = pk2(s[6 * 33], s[7 * 33]);
        *(v4u*)(d.dst + (size_t)n * d.K + 8 * c) = o; }
    LDS_WAIT(); asm volatile("" ::: "memory");
}
__device__ __forceinline__ void convert_queue(const Args& a, unsigned* ctr, int begin, int end, LAS unsigned char* lds, int tid) {
    const int wave = __builtin_amdgcn_readfirstlane(tid >> 6), lane = tid & 63;
    LAS float* scr = (LAS float*)(lds + wave * 16384);
    for (;;) {
        unsigned c = 0; if (lane == 0) c = __hip_atomic_fetch_add(ctr, 8u, __ATOMIC_RELAXED, __HIP_MEMORY_SCOPE_AGENT);
        const int ib = begin + (int)__builtin_amdgcn_readfirstlane(c);
        if (ib >= end) break;
        for (int i0 = ib; i0 < ib + 8 && i0 < end; i0 += 2) {
            const TrDesc d0 = tr_decode(a, i0); float v0[32]; tr_load(d0, v0, lane);
            if (i0 + 1 < end) { const TrDesc d1 = tr_decode(a, i0 + 1); float v1[32]; tr_load(d1, v1, lane); tr_store(d0, v0, scr, lane); tr_store(d1, v1, scr, lane); }
            else tr_store(d0, v0, scr, lane);
        }
    }
}
constexpr int CW_Q = 32768;
__device__ __forceinline__ void p0_prologue(const Args& a, LAS unsigned char* lds, int G, int bid, int tid) {
    const int wave = __builtin_amdgcn_readfirstlane(tid >> 6), lane = tid & 63;
    const int gw = bid * 8 + wave, NGW = G * 8;
    convert_queue(a, (unsigned*)(a.ws + WS_CTL) + CW_Q, 0, OI_D1, lds, tid);
    __syncthreads();
    for (int lg = bid; lg < DEPTH * S5G; lg += G) s5_tables_item(a, lg, lds, tid);
    for (int idx = bid * 512 + tid; idx < HW; idx += G * 512) {
        const float x0 = a.in[25][idx], x1 = a.in[25][HW + idx], x2 = a.in[25][2 * HW + idx], x3 = a.in[25][3 * HW + idx];
        const float mx = fmaxf(fmaxf(x0, x1), fmaxf(x2, x3));
        const float e0 = expf(x0 - mx), e1 = expf(x1 - mx), e2 = expf(x2 - mx), e3 = expf(x3 - mx), inv = 1.f / (e0 + e1 + e2 + e3);
        float* lb = (float*)(a.ws + WS_LB);
        lb[idx] = 0.f; lb[HW + idx] = e1 * inv; lb[2 * HW + idx] = (e1 + e2) * inv; lb[3 * HW + idx] = (e1 + e2 + e3) * inv;
    }
    for (int row = gw; row < MT; row += NGW) {
        const float* xr = row < MP ? a.in[0] + (size_t)row * DM : a.in[1] + (size_t)(row - MP) * DM;
        float* hr = a.out + O_Y + (size_t)row * DM; bf16* hb = (bf16*)(a.ws + WS_HB) + (size_t)row * DM;
        float ss = 0.f;
#pragma unroll
        for (int j = 0; j < 8; ++j) { const f32x4 v = *(const f32x4*)(xr + 4 * lane + 256 * j); ss += (v[0] * v[0] + v[1] * v[1]) + (v[2] * v[2] + v[3] * v[3]);
            *(f32x4*)(hr + 4 * lane + 256 * j) = v; v2u w; w.x = pk2(v[0], v[1]); w.y = pk2(v[2], v[3]); *(v2u*)(hb + 4 * lane + 256 * j) = w; }
        ss = wave_sum(ss);
        if (lane == 0) ((float*)(a.ws + WS_RS))[row] = 1.f / sqrtf(ss * (1.f / DM) + EPS);
    }
}

__device__ __forceinline__ void norm_res_phase(const Args& a, const float* gain, float coef, int G, int bid, int tid) {
    const int wave = __builtin_amdgcn_readfirstlane(tid >> 6), lane = tid & 63;
    const int gw = bid * 8 + wave, NGW = G * 8;
    f32x4 gv[8];
#pragma unroll
    for (int j = 0; j < 8; ++j) gv[j] = *(const f32x4*)(gain + 4 * lane + 256 * j) * coef;
    for (int row = gw; row < MT; row += NGW) {
        const float* ar = (const float*)(a.ws + WS_A) + (size_t)row * DM; float* hr = a.out + O_Y + (size_t)row * DM; bf16* hb = (bf16*)(a.ws + WS_HB) + (size_t)row * DM;
        f32x4 av[8], hv[8]; float ss = 0.f;
#pragma unroll
        for (int j = 0; j < 8; ++j) { av[j] = *(const f32x4*)(ar + 4 * lane + 256 * j); hv[j] = *(const f32x4*)(hr + 4 * lane + 256 * j);
            ss += (av[j][0] * av[j][0] + av[j][1] * av[j][1]) + (av[j][2] * av[j][2] + av[j][3] * av[j][3]); }
        ss = wave_sum(ss);
        const float ra = 1.f / sqrtf(ss * (1.f / DM) + EPS);
        float s2 = 0.f;
#pragma unroll
        for (int j = 0; j < 8; ++j) { const f32x4 v = hv[j] + av[j] * gv[j] * ra; s2 += (v[0] * v[0] + v[1] * v[1]) + (v[2] * v[2] + v[3] * v[3]);
            *(f32x4*)(hr + 4 * lane + 256 * j) = v; v2u w; w.x = pk2(v[0], v[1]); w.y = pk2(v[2], v[3]); *(v2u*)(hb + 4 * lane + 256 * j) = w; }
        s2 = wave_sum(s2);
        if (lane == 0) ((float*)(a.ws + WS_RS))[row] = 1.f / sqrtf(s2 * (1.f / DM) + EPS);
    }
}

__device__ __forceinline__ void hgrn_sample_item(const Args& a, int l, int item, LAS unsigned char* lds, int tid) {
    const int h = item & 7, b = item >> 3, kq = tid >> 5, v4 = tid & 31;
    LAS float* red = (LAS float*)lds;
    const float* s0 = a.in[4] + ((size_t)((l * DB + b) * HH + h) * HK + kq * 8) * HV + 4 * v4;
    float* s1 = a.out + O_HS + ((size_t)((l * DB + b) * HH + h) * HK + kq * 8) * HV + 4 * v4;
    f32x4 S[8];
#pragma unroll
    for (int i = 0; i < 8; ++i) S[i] = *(const f32x4*)(s0 + (size_t)i * HV);
    const float* zb = (const float*)(a.ws + WS_Z) + (size_t)(MP + b * DSQ) * INW + h * HK;
#pragma unroll
    for (int t = 0; t < DSQ; ++t) {
        const float* zr = zb + (size_t)t * INW;
        const f32x4 q0 = *(const f32x4*)(zr + 1024 + kq * 8), q1 = *(const f32x4*)(zr + 1024 + kq * 8 + 4);
        const f32x4 f0 = *(const f32x4*)(zr + 2048 + kq * 8), f1 = *(const f32x4*)(zr + 2048 + kq * 8 + 4);
        const f32x4 vv = *(const f32x4*)(zr + 3072 + 4 * v4);
        f32x4 acc = (f32x4){0.f, 0.f, 0.f, 0.f};
#pragma unroll
        for (int i = 0; i < 8; ++i) { const float f = i < 4 ? f0[i & 3] : f1[i & 3], q = i < 4 ? q0[i & 3] : q1[i & 3]; S[i] = S[i] * f + vv * (1.f - f); acc += S[i] * q; }
        *(LAS f32x4*)(red + (t * 16 + kq) * 128 + 4 * v4) = acc;
    }
#pragma unroll
    for (int i = 0; i < 8; ++i) *(f32x4*)(s1 + (size_t)i * HV) = S[i];
    __syncthreads();
#pragma unroll
    for (int e = 0; e < 2; ++e) { const int idx = tid + 512 * e, t = idx >> 7, v = idx & 127; float s = 0.f;
#pragma unroll
        for (int k = 0; k < 16; ++k) s += red[(t * 16 + k) * 128 + v];
        ((float*)(a.ws + WS_O))[(size_t)(MP + b * DSQ + t) * HW + h * HV + v] = s; }
    __syncthreads();
}
__device__ __forceinline__ void hgrn_post_item(const Args& a, int l, int item, int lane) {
    const int h = item & 7, row = item >> 3;
    const f32x2 o = *(const f32x2*)((const float*)(a.ws + WS_O) + (size_t)row * HW + h * HV + 2 * lane);
    const float ss = wave_sum(o[0] * o[0] + o[1] * o[1]);
    const float r = 1.f / sqrtf(ss * (1.f / HV) + EPS);
    const f32x2 gg = *(const f32x2*)((const float*)(a.ws + WS_Z) + (size_t)row * INW + 4096 + h * HV + 2 * lane);
    const f32x2 gn = *(const f32x2*)(a.in[26] + (size_t)l * HW + h * HV + 2 * lane);
    *(unsigned*)((bf16*)(a.ws + WS_CAT) + (size_t)row * DM + 1024 + h * HV + 2 * lane) = pk2(o[0] * r * gn[0] * silu(gg[0]), o[1] * r * gn[1] * silu(gg[1]));
}

typedef short bf16x8_t __attribute__((ext_vector_type(8)));
constexpr int GC = 64, GNCH = SEQ / GC, GITEMS = NB * HH * GNCH;
constexpr int KS = 272, TS = 144;
constexpr int L_SUM = 0, L_VT = 2048, L_KD = L_VT + 128 * TS;
constexpr int L_Q = L_VT + 128 * TS, L_QR = L_Q + 64 * KS, L_KT = L_QR + 64 * KS, L_ATT = L_KT + 10 * 16 * KS, L_SSQ = L_ATT + 64 * TS, L_RR = L_SSQ + 64 * 8 * 4, L_GEND = L_RR + 256;
static_assert(L_GEND <= RING_BYTES, "GLA LDS map");
constexpr size_t WS_SLOC = WS_END, WS_SIN = WS_SLOC + 64 * MiB, WS_DEC = WS_SIN + 32 * MiB, WS_END2 = WS_DEC + 1 * MiB;

__device__ __forceinline__ v4u pack8(const float (&x)[16], int o) { v4u w; w.x = pk2(x[o], x[o + 1]); w.y = pk2(x[o + 2], x[o + 3]); w.z = pk2(x[o + 4], x[o + 5]); w.w = pk2(x[o + 6], x[o + 7]); return w; }

__device__ __forceinline__ void gla_a_item(const Args& a, int item, LAS unsigned char* lds, int tid) {
    const int j = item & 31, h = (item >> 5) & 7, b = item >> 8;
    const int k = tid & 127, ti = __builtin_amdgcn_readfirstlane(tid >> 7), lane = tid & 63, w = __builtin_amdgcn_readfirstlane(tid >> 6);
    const float* zr = (const float*)(a.ws + WS_Z) + (size_t)(b * SEQ + j * GC + ti * 16) * INW + h * HK + k;
    float fv[16], vv[16];
#pragma unroll
    for (int s = 0; s < 16; ++s) { fv[s] = zr[(size_t)s * INW + 2048]; vv[s] = zr[(size_t)s * INW + 3072]; }
    float c[16]; float run = 0.f;
#pragma unroll
    for (int s = 0; s < 16; ++s) { run += __logf(fv[s]); c[s] = run; }
    LAS float* sums = (LAS float*)(lds + L_SUM);
    sums[ti * 128 + k] = run;
    *(LAS v4u*)(lds + L_VT + k * TS + ti * 32) = pack8(vv, 0); *(LAS v4u*)(lds + L_VT + k * TS + ti * 32 + 16) = pack8(vv, 8);
    __syncthreads();
    const float s0 = sums[k], s1 = sums[128 + k], s2 = sums[256 + k], s3 = sums[384 + k];
    const float P4 = (s0 + s1) + (s2 + s3);
    const float rest = ti == 0 ? (s1 + s2 + s3) : ti == 1 ? (s2 + s3) : ti == 2 ? s3 : 0.f;
    float kd[16];
#pragma unroll
    for (int s = 0; s < 16; ++s) kd[s] = (1.f - fv[s]) * __expf(rest + (run - c[s]));
    *(LAS v4u*)(lds + L_KD + k * TS + ti * 32) = pack8(kd, 0); *(LAS v4u*)(lds + L_KD + k * TS + ti * 32 + 16) = pack8(kd, 8);
    if (ti == 0) ((float*)(a.ws + WS_DEC))[(size_t)item * 128 + k] = __expf(P4);
    __syncthreads();
    const int r = lane & 15, g = lane >> 4;
    bf16x8_t af[2];
#pragma unroll
    for (int st = 0; st < 2; ++st) af[st] = *(const LAS bf16x8_t*)(lds + L_KD + (16 * w + r) * TS + (32 * st + 8 * g) * 2);
    float* out = (float*)(a.ws + WS_SLOC) + (size_t)item * 16384;
#pragma unroll
    for (int vt = 0; vt < 8; ++vt) {
        f32x4 acc = (f32x4){0.f, 0.f, 0.f, 0.f};
#pragma unroll
        for (int st = 0; st < 2; ++st) { const bf16x8_t bfr = *(const LAS bf16x8_t*)(lds + L_VT + (16 * vt + r) * TS + (32 * st + 8 * g) * 2);
            acc = __builtin_amdgcn_mfma_f32_16x16x32_bf16(af[st], bfr, acc, 0, 0, 0); }
        *(f32x4*)(out + (size_t)(16 * vt + r) * 128 + 16 * w + 4 * g) = acc;
    }
    __syncthreads();
}

__device__ __forceinline__ void gla_b_phase(const Args& a, int l, int G, int bid, int tid) {
    for (int gid = bid * 512 + tid; gid < NB * HH * 4096; gid += G * 512) {
        const int bh = gid >> 12, rem = gid & 4095, v = rem >> 5, k4 = (rem & 31) * 4;
        f32x4 S = (f32x4){0.f, 0.f, 0.f, 0.f};
        const float* sl = (const float*)(a.ws + WS_SLOC) + (size_t)(bh * GNCH) * 16384 + v * 128 + k4;
        const float* dc = (const float*)(a.ws + WS_DEC) + (size_t)(bh * GNCH) * 128 + k4;
        bf16* si = (bf16*)(a.ws + WS_SIN) + (size_t)(bh * GNCH) * 16384 + v * 128 + k4;
#pragma unroll 8
        for (int j = 0; j < GNCH; ++j) {
            v2u wv; wv.x = pk2(S[0], S[1]); wv.y = pk2(S[2], S[3]); *(v2u*)(si + (size_t)j * 16384) = wv;
            const f32x4 x = *(const f32x4*)(sl + (size_t)j * 16384), d = *(const f32x4*)(dc + (size_t)j * 128);
            S = d * S + x;
        }
        float* sp = a.out + O_HP + ((size_t)(l * NB * HH + bh) * HK + k4) * HV + v;
#pragma unroll
        for (int i = 0; i < 4; ++i) sp[(size_t)i * HV] = S[i];
    }
}

__device__ __forceinline__ void gla_c_item(const Args& a, int l, int item, LAS unsigned char* lds, int tid) {
    const int j = item & 31, h = (item >> 5) & 7, b = item >> 8;
    const int k = tid & 127, ti = __builtin_amdgcn_readfirstlane(tid >> 7), lane = tid & 63, w = __builtin_amdgcn_readfirstlane(tid >> 6);
    const int r = lane & 15, g = lane >> 4;
    const int row0 = b * SEQ + j * GC;
    const float* zr = (const float*)(a.ws + WS_Z) + (size_t)(row0 + ti * 16) * INW + h * HK + k;
    float fv[16], vv[16], qv[16];
#pragma unroll
    for (int s = 0; s < 16; ++s) { fv[s] = zr[(size_t)s * INW + 2048]; vv[s] = zr[(size_t)s * INW + 3072]; qv[s] = zr[(size_t)s * INW + 1024]; }
    bf16x8_t sfr[4];
    { const bf16* si = (const bf16*)(a.ws + WS_SIN) + (size_t)item * 16384 + (size_t)(16 * w + r) * 128 + 8 * g;
#pragma unroll
      for (int st = 0; st < 4; ++st) sfr[st] = *(const bf16x8_t*)(si + 32 * st); }
    float gz[16];
    { const float* zg = (const float*)(a.ws + WS_Z) + (size_t)row0 * INW + 4096 + h * HV + 16 * w + r;
#pragma unroll
      for (int tt = 0; tt < 4; ++tt)
#pragma unroll
        for (int i = 0; i < 4; ++i) gz[tt * 4 + i] = zg[(size_t)(16 * tt + 4 * g + i) * INW]; }
    const float gn = a.in[26][(size_t)l * HW + h * HV + 16 * w + r];
    float c[16]; float run = 0.f;
#pragma unroll
    for (int s = 0; s < 16; ++s) { run += __logf(fv[s]); c[s] = run; }
    LAS float* sums = (LAS float*)(lds + L_SUM);
    sums[ti * 128 + k] = run;
    *(LAS v4u*)(lds + L_VT + k * TS + ti * 32) = pack8(vv, 0); *(LAS v4u*)(lds + L_VT + k * TS + ti * 32 + 16) = pack8(vv, 8);
    { LAS unsigned* az = (LAS unsigned*)(lds + L_ATT); for (int i = tid; i < 64 * TS / 4; i += 512) az[i] = 0u; }
    __syncthreads();
    const float s0 = sums[k], s1 = sums[128 + k], s2 = sums[256 + k];
    const float myP = ti == 0 ? 0.f : ti == 1 ? s0 : ti == 2 ? (s0 + s1) : (s0 + s1 + s2);
#pragma unroll
    for (int s = 0; s < 16; ++s) {
        const int t = 16 * ti + s;
        *(LAS bf16*)(lds + L_Q + t * KS + k * 2) = (bf16)f2bf(qv[s] * __expf(myP + c[s]));
        *(LAS bf16*)(lds + L_QR + t * KS + k * 2) = (bf16)f2bf(qv[s] * __expf(c[s]));
    }
#pragma unroll
    for (int tp = 0; tp < 4; ++tp) {
        if (tp >= ti) {
            const float dP = (tp == ti) ? 0.f : (tp == ti + 1) ? (ti == 0 ? s0 : ti == 1 ? s1 : s2) : (tp == ti + 2) ? (ti == 0 ? (s0 + s1) : (s1 + s2)) : (s0 + s1 + s2);
            LAS unsigned char* kt = lds + L_KT + (tp * (tp + 1) / 2 + ti) * (16 * KS);
#pragma unroll
            for (int s = 0; s < 16; ++s) *(LAS bf16*)(kt + s * KS + k * 2) = (bf16)f2bf((1.f - fv[s]) * __expf(fminf(dP - c[s], 60.f)));
        }
    }
    __syncthreads();
#pragma unroll
    for (int rep = 0; rep < 2; ++rep) {
        const int q = w + 8 * rep;
        if (q < 10) {
            const int tq = q < 1 ? 0 : q < 3 ? 1 : q < 6 ? 2 : 3, sj = q - tq * (tq + 1) / 2;
            f32x4 acc = (f32x4){0.f, 0.f, 0.f, 0.f};
#pragma unroll
            for (int st = 0; st < 4; ++st) {
                const bf16x8_t af = *(const LAS bf16x8_t*)(lds + L_QR + (16 * tq + r) * KS + (32 * st + 8 * g) * 2);
                const bf16x8_t bfr = *(const LAS bf16x8_t*)(lds + L_KT + q * (16 * KS) + r * KS + (32 * st + 8 * g) * 2);
                acc = __builtin_amdgcn_mfma_f32_16x16x32_bf16(af, bfr, acc, 0, 0, 0);
            }
#pragma unroll
            for (int i = 0; i < 4; ++i) { const int t = 16 * tq + 4 * g + i, s = 16 * sj + r; *(LAS bf16*)(lds + L_ATT + t * TS + s * 2) = (bf16)f2bf(s <= t ? acc[i] : 0.f); }
        }
    }
    __syncthreads();
    f32x4 o[4];
#pragma unroll
    for (int tt = 0; tt < 4; ++tt) {
        f32x4 acc = (f32x4){0.f, 0.f, 0.f, 0.f};
#pragma unroll
        for (int st = 0; st < 4; ++st) { const bf16x8_t af = *(const LAS bf16x8_t*)(lds + L_Q + (16 * tt + r) * KS + (32 * st + 8 * g) * 2);
            acc = __builtin_amdgcn_mfma_f32_16x16x32_bf16(af, sfr[st], acc, 0, 0, 0); }
#pragma unroll
        for (int st = 0; st < 2; ++st) if (st == 0 || tt >= 2) {
            const bf16x8_t af = *(const LAS bf16x8_t*)(lds + L_ATT + (16 * tt + r) * TS + (32 * st + 8 * g) * 2);
            const bf16x8_t bfr = *(const LAS bf16x8_t*)(lds + L_VT + (16 * w + r) * TS + (32 * st + 8 * g) * 2);
            acc = __builtin_amdgcn_mfma_f32_16x16x32_bf16(af, bfr, acc, 0, 0, 0); }
        o[tt] = acc;
    }
    LAS float* ssq = (LAS float*)(lds + L_SSQ); LAS float* rr = (LAS float*)(lds + L_RR);
#pragma unroll
    for (int tt = 0; tt < 4; ++tt)
#pragma unroll
        for (int i = 0; i < 4; ++i) { float p = o[tt][i] * o[tt][i]; p += __shfl_xor(p, 1); p += __shfl_xor(p, 2); p += __shfl_xor(p, 4); p += __shfl_xor(p, 8);
            if (r == 0) ssq[(16 * tt + 4 * g + i) * 8 + w] = p; }
    __syncthreads();
    if (tid < 64) { float s = 0.f;
#pragma unroll
        for (int x = 0; x < 8; ++x) s += ssq[tid * 8 + x];
        rr[tid] = 1.f / sqrtf(s * (1.f / HV) + EPS); }
    __syncthreads();
    bf16* cp = (bf16*)(a.ws + WS_CAT) + (size_t)row0 * DM + 1024 + h * HV + 16 * w + r;
#pragma unroll
    for (int tt = 0; tt < 4; ++tt)
#pragma unroll
        for (int i = 0; i < 4; ++i) { const int t = 16 * tt + 4 * g + i; cp[(size_t)t * DM] = (bf16)f2bf(o[tt][i] * rr[t] * gn * silu(gz[tt * 4 + i])); }
    __syncthreads();
}
constexpr int S5ITEMS = S5G * 40, S5IPG = 40;
constexpr size_t WS_S5K = WS_END2, WS_S5P = WS_S5K + 2 * MiB, WS_S5Q = WS_S5P + 16 * MiB, WS_S5A = WS_S5Q + 16 * MiB, WS_S5T = WS_S5A + 1 * MiB, WS_END3 = WS_S5T + 1 * MiB;
constexpr int L5_K = 0, L5_U = 8192, L5_XL = 16384, L5_XIN = L5_XL + 128 * 17 * 4, L5_END = L5_XIN + 16 * 272;
constexpr int LP_AP = 0, LP_BB = LP_AP + 17 * 64 * 8, LP_C = LP_BB + 64 * 16 * 8, LP_END = LP_C + 16 * 64 * 8;

__device__ __forceinline__ f32x2 cmul(f32x2 x, f32x2 y) { return (f32x2){x[0] * y[0] - x[1] * y[1], x[0] * y[1] + x[1] * y[0]}; }

__device__ __forceinline__ void s5_tables_item(const Args& a, int lg, LAS unsigned char* lds, int tid) {
    LAS f32x2* ap = (LAS f32x2*)(lds + LP_AP); LAS f32x2* bbl = (LAS f32x2*)(lds + LP_BB); LAS f32x2* cl = (LAS f32x2*)(lds + LP_C);
    const float dt = expf(a.in[17][lg]);
#pragma unroll 1
    for (int idx = tid; idx < 17 * 64; idx += 512) { const int tau = idx >> 6, n = idx & 63; const float lr = a.in[15][lg * 64 + n], li = a.in[16][lg * 64 + n];
        const float mag = expf(lr * dt * (float)tau), ang = li * dt * (float)tau; ap[idx] = (f32x2){mag * cosf(ang), mag * sinf(ang)}; }
#pragma unroll 1
    for (int idx = tid; idx < 64 * 16; idx += 512) { const int n = idx >> 4; const float lr = a.in[15][lg * 64 + n], li = a.in[16][lg * 64 + n];
        const float mag = expf(lr * dt), ang = li * dt; const float are = mag * cosf(ang), aim = mag * sinf(ang);
        const float p = are - 1.f, q = aim, den = lr * lr + li * li; const float zre = (p * lr + q * li) / den, zim = (q * lr - p * li) / den;
        const float br = a.in[18][(size_t)lg * 1024 + idx], bi = a.in[19][(size_t)lg * 1024 + idx];
        bbl[idx] = (f32x2){zre * br - zim * bi, zre * bi + zim * br};
        cl[idx] = (f32x2){a.in[20][(size_t)lg * 1024 + idx], a.in[21][(size_t)lg * 1024 + idx]}; }
    if (tid < 64) { const float lr = a.in[15][lg * 64 + tid], li = a.in[16][lg * 64 + tid];
        const float m16 = expf(lr * dt * 16.f), g16 = li * dt * 16.f, m8 = expf(-lr * dt * 8.f), g8 = -li * dt * 8.f;
        f32x2* A = (f32x2*)(a.ws + WS_S5A); A[lg * 64 + tid] = (f32x2){m16 * cosf(g16), m16 * sinf(g16)}; A[16384 + lg * 64 + tid] = (f32x2){m8 * cosf(g8), m8 * sinf(g8)}; }
    __syncthreads();
    bf16* Kt = (bf16*)(a.ws + WS_S5K) + (size_t)lg * 4096; bf16* Pt = (bf16*)(a.ws + WS_S5P) + (size_t)lg * 32768; bf16* Qt = (bf16*)(a.ws + WS_S5Q) + (size_t)lg * 32768;
#pragma unroll 1
    for (int idx = tid; idx < 4096; idx += 512) { const int tau = idx >> 8, c = (idx >> 4) & 15, cp = idx & 15; float s = 0.f;
#pragma unroll 4
        for (int n = 0; n < 64; ++n) { const f32x2 w = cmul(ap[tau * 64 + n], bbl[n * 16 + cp]); const f32x2 cc = cl[c * 64 + n]; s += cc[0] * w[0] - cc[1] * w[1]; }
        Kt[idx] = (bf16)f2bf(s); }
#pragma unroll 2
    for (int idx = tid; idx < 32768; idx += 512) { const int row = idx >> 7, np = idx & 127, k = row >> 4, c = row & 15, n = np & 63;
        const f32x2 A = ap[(k + 1) * 64 + n], cc = cl[c * 64 + n];
        Pt[idx] = (bf16)f2bf(np < 64 ? (cc[0] * A[0] - cc[1] * A[1]) : -(cc[0] * A[1] + cc[1] * A[0])); }
#pragma unroll 2
    for (int idx = tid; idx < 32768; idx += 512) { const int np = idx >> 8, col = idx & 255, s = col >> 4, cp = col & 15, n = np & 63;
        const f32x2 w = cmul(ap[(15 - s) * 64 + n], bbl[n * 16 + cp]);
        Qt[idx] = (bf16)f2bf(np < 64 ? w[0] : w[1]); }
    __syncthreads();
}

struct S5Ctx { int g; };

template <int PASS>
__device__ __forceinline__ void s5_item(const Args& a, int l, int item, S5Ctx& cx, LAS unsigned char* lds, int tid) {
    const int lane = tid & 63, w = __builtin_amdgcn_readfirstlane(tid >> 6), r = lane & 15, g8 = lane >> 4;
    const int g = item / S5IPG, idx = item - g * S5IPG; const bool sample = idx >= 32;
    if (PASS == 1 && sample) return;
    const int lg = l * S5G + g;
    if (g != cx.g) {
        cx.g = g;
        __syncthreads();
        { const v4u* src = (const v4u*)((const bf16*)(a.ws + WS_S5K) + (size_t)lg * 4096); ((LAS v4u*)(lds + L5_K))[tid] = src[tid]; }
        __syncthreads();
    }
    bf16x8_t qf[8];
    { const bf16* Qt = (const bf16*)(a.ws + WS_S5Q) + (size_t)lg * 32768 + (size_t)(16 * w + r) * 256 + 8 * g8;
#pragma unroll
      for (int st = 0; st < 8; ++st) qf[st] = *(const bf16x8_t*)(Qt + 32 * st); }
    const int b = idx >> 3, tile = idx & 7;
    const int stile = idx - 32;
    const float* Z = (const float*)(a.ws + WS_Z);
    {
        const int s = 2 * w + (g8 >> 1);
        v4u fr = (v4u){0u, 0u, 0u, 0u};
        if (!sample || s >= 8) {
            const size_t row = sample ? (size_t)(MP + (stile * 16 + r) * DSQ + (s - 8)) : (size_t)(b * SEQ + tile * 256 + r * 16 + s);
            const f32x4 u0 = *(const f32x4*)(Z + row * INW + 16 * g + 8 * (g8 & 1)), u1 = *(const f32x4*)(Z + row * INW + 16 * g + 8 * (g8 & 1) + 4);
            fr.x = pk2(u0[0], u0[1]); fr.y = pk2(u0[2], u0[3]); fr.z = pk2(u1[0], u1[1]); fr.w = pk2(u1[2], u1[3]);
        }
        ((LAS v4u*)(lds + L5_U))[w * 64 + lane] = fr;
    }
    __syncthreads();
    bf16x8_t uf[8];
#pragma unroll
    for (int st = 0; st < 8; ++st) uf[st] = ((const LAS bf16x8_t*)(lds + L5_U))[st * 64 + lane];
    {
        f32x4 acc = (f32x4){0.f, 0.f, 0.f, 0.f};
#pragma unroll
        for (int st = 0; st < 8; ++st) acc = __builtin_amdgcn_mfma_f32_16x16x32_bf16(qf[st], uf[st], acc, 0, 0, 0);
        LAS float* XL = (LAS float*)(lds + L5_XL);
#pragma unroll
        for (int i = 0; i < 4; ++i) XL[(16 * w + 4 * g8 + i) * 17 + r] = acc[i];
    }
    __syncthreads();
    if (w == 0) {
        const LAS float* XL = (const LAS float*)(lds + L5_XL);
        const f32x2 a16 = ((const f32x2*)(a.ws + WS_S5A))[lg * 64 + lane];
        if (!sample) {
            f32x2 X = (f32x2){0.f, 0.f};
            f32x2* E = (f32x2*)(a.ws + WS_S5T) + (size_t)((b * S5G + g) * 8) * 64 + lane;
            if (PASS == 2) { f32x2 a256 = a16;
#pragma unroll
                for (int q = 0; q < 4; ++q) a256 = cmul(a256, a256);
                for (int tt = 0; tt < tile; ++tt) { const f32x2 e = E[tt * 64]; X = cmul(a256, X) + e; } }
#pragma unroll
            for (int c = 0; c < 16; ++c) {
                if (PASS == 2) { *(LAS bf16*)(lds + L5_XIN + c * 272 + lane * 2) = (bf16)f2bf(X[0]); *(LAS bf16*)(lds + L5_XIN + c * 272 + (64 + lane) * 2) = (bf16)f2bf(X[1]); }
                X = cmul(a16, X) + (f32x2){XL[lane * 17 + c], XL[(64 + lane) * 17 + c]};
            }
            if (PASS == 1) E[tile * 64] = X;
            else if (tile == 7) { const size_t so = (size_t)((l * NB + b) * S5G + g) * S5N + lane; a.out[O_REP + so] = X[0]; a.out[O_IMP + so] = X[1]; }
        } else if (PASS == 2) {
            const f32x2 am8 = ((const f32x2*)(a.ws + WS_S5A))[16384 + lg * 64 + lane];
#pragma unroll
            for (int c = 0; c < 16; ++c) {
                const size_t si = (size_t)((l * DB + stile * 16 + c) * S5G + g) * S5N + lane;
                const f32x2 xv = cmul(am8, (f32x2){a.in[2][si], a.in[3][si]});
                *(LAS bf16*)(lds + L5_XIN + c * 272 + lane * 2) = (bf16)f2bf(xv[0]); *(LAS bf16*)(lds + L5_XIN + c * 272 + (64 + lane) * 2) = (bf16)f2bf(xv[1]);
                const f32x2 xo = cmul(a16, xv) + (f32x2){XL[lane * 17 + c], XL[(64 + lane) * 17 + c]};
                a.out[O_RES + si] = xo[0]; a.out[O_IMS + si] = xo[1];
            }
        }
    }
    if (PASS == 2) {
        __syncthreads();
        bf16x8_t xf[4];
#pragma unroll
        for (int st = 0; st < 4; ++st) xf[st] = *(const LAS bf16x8_t*)(lds + L5_XIN + r * 272 + (32 * st + 8 * g8) * 2);
        const f32x4 dv = *(const f32x4*)(a.in[22] + (size_t)l * S5W + 16 * g + 4 * g8);
#pragma unroll
        for (int x = 0; x < 2; ++x) {
            const int k = x ? 15 - w : w;
            if (!sample || k >= 8) {
                f32x4 acc = (f32x4){0.f, 0.f, 0.f, 0.f};
                const int nst = (k >> 1) + 1;
#pragma unroll
                for (int st = 0; st < 8; ++st) if (st < nst) {
                    const int tau = k - 2 * st - (g8 >> 1);
                    bf16x8_t kf = (bf16x8_t){0, 0, 0, 0, 0, 0, 0, 0};
                    if (tau >= 0) kf = *(const LAS bf16x8_t*)(lds + L5_K + tau * 512 + r * 32 + (g8 & 1) * 16);
                    acc = __builtin_amdgcn_mfma_f32_16x16x32_bf16(kf, uf[st], acc, 0, 0, 0);
                }
                { const bf16* Pt = (const bf16*)(a.ws + WS_S5P) + (size_t)lg * 32768 + (size_t)(16 * k + r) * 128 + 8 * g8;
#pragma unroll
                  for (int st = 0; st < 4; ++st) { const bf16x8_t pf = *(const bf16x8_t*)(Pt + 32 * st); acc = __builtin_amdgcn_mfma_f32_16x16x32_bf16(pf, xf[st], acc, 0, 0, 0); } }
                const size_t row = sample ? (size_t)(MP + (stile * 16 + r) * DSQ + (k - 8)) : (size_t)(b * SEQ + tile * 256 + r * 16 + k);
                const f32x4 uu = *(const f32x4*)(Z + row * INW + 16 * g + 4 * g8);
                v2u o; o.x = pk2(gelu_tanh(acc[0] + dv[0] * uu[0]), gelu_tanh(acc[1] + dv[1] * uu[1])); o.y = pk2(gelu_tanh(acc[2] + dv[2] * uu[2]), gelu_tanh(acc[3] + dv[3] * uu[3]));
                *(v2u*)((bf16*)(a.ws + WS_YSG) + row * S5W + 16 * g + 4 * g8) = o;
            }
        }
    }
    __syncthreads();
}

constexpr int PH_PER_LAYER = 13, N_PHASES = 1 + DEPTH * PH_PER_LAYER;
#ifndef PROBE_DUP
#define PROBE_DUP 0
#endif
#ifndef MK_PER_PHASE
#define MK_PER_PHASE 0
#endif

__global__ void __launch_bounds__(512, 2) mega(Args args) {
    extern __shared__ __attribute__((aligned(16))) unsigned char lds_raw[];
    LAS unsigned char* lds = (LAS unsigned char*)lds_raw;
    const int tid = threadIdx.x, lane = tid & 63, wave = __builtin_amdgcn_readfirstlane(tid >> 6);
    const int G = gridDim.x, bid = blockIdx.x;
    volatile LAS unsigned* MISC = (volatile LAS unsigned*)(lds + LDSCTL_OFF);
    if (tid < 64) MISC[tid] = 0u;
    __syncthreads();
    const int lo = args.ph_lo, hi = args.ph_hi;
    XcdBarrier bar; bar.bar = (unsigned*)(args.ws + WS_CTL) + 4096; bar.x = 0; bar.st = nullptr;
    if (hi - lo > 1) bar = xcd_barrier_post((unsigned*)(args.ws + WS_CTL) + 4096, MISC + 8);
#define IN(k) (lo <= (k) && (k) < hi)
#define CONVQ(q, b, e) do { if (l < 2) { int tq_ = tid; asm volatile("" : "+v"(tq_)); convert_queue(args, (unsigned*)(args.ws + WS_CTL) + CW_Q + 64 * (q), (b), (e), lds, tq_); } } while (0)
#define TIDL() int tidl = tid; asm volatile("" : "+v"(tidl)); const int lanel = tidl & 63, wavel = __builtin_amdgcn_readfirstlane(tidl >> 6); (void)lanel; (void)wavel
#define SEAM(k) do { if (IN((k) + 1)) xcd_barrier(bar); } while (0)

    if (IN(0)) { for (int rep = 0; rep < ((PROBE_DUP & 16) ? 2 : 1); ++rep) { TIDL(); p0_prologue(args, lds, G, bid, tidl); } SEAM(0); }

    for (int l = 0; l < DEPTH; ++l) {
        const int pb = 1 + l * PH_PER_LAYER;
        unsigned char* wl = args.ws + WS_W + (size_t)l * LW_END;
        const bf16* HB = (const bf16*)(args.ws + WS_HB); bf16* HID = (bf16*)(args.ws + WS_HID); float* A = (float*)(args.ws + WS_A); float* Z = (float*)(args.ws + WS_Z);
        const float* RS = (const float*)(args.ws + WS_RS);
#define FFN_PHASES(f) do { const int p0 = pb + ((f) ? 10 : 0); \
            if (IN(p0)) { pg8::Gemm g{HB, (const bf16*)(wl + ((f) ? LW_GU2 : LW_GU1)), MT, 2 * FF, DM}; pg8::StaticOrder S; S.init(MT, 2 * FF, G, bid); \
                EpiGU E{HID, RS}; pg8::gemm_phase<EpiGU, pg8::StaticOrder, true, true>(lds, g, S, E); \
                if (f) CONVQ(1 + 5 * l + 3, (2 * l + 1) * I_L + OI_D1, (2 * l + 1) * I_L + OI_GU2); else CONVQ(1 + 5 * l + 0, 2 * l * I_L + OI_D1, 2 * l * I_L + OI_IN); SEAM(p0); } \
            if (IN(p0 + 1)) { pg8::Gemm g{HID, (const bf16*)(wl + ((f) ? LW_D2 : LW_D1)), MT, DM, FF}; pg8::StaticOrder S; S.init(MT, DM, G, bid); \
                EpiF32 E{A, DM}; pg8::gemm_phase<EpiF32, pg8::StaticOrder, true, true>(lds, g, S, E); \
                if (f) CONVQ(1 + 5 * l + 4, (2 * l + 1) * I_L + OI_GU2, (2 * l + 2) * I_L + (l == 0 ? OI_D1 : 0)); else CONVQ(1 + 5 * l + 1, 2 * l * I_L + OI_IN, (2 * l + 1) * I_L); SEAM(p0 + 1); } \
            if (IN(p0 + 2)) { TIDL(); norm_res_phase(args, args.in[6] + (size_t)(l * 3 + ((f) ? 2 : 0)) * DM, 0.5f, G, bid, tidl); SEAM(p0 + 2); } } while (0)
        FFN_PHASES(0);
        if (IN(pb + 3)) { pg8::Gemm g{HB, (const bf16*)(wl + LW_IN), MT, INW, DM}; pg8::StaticOrder S; S.init(MT, INW, G, bid);
            EpiWin E{Z, RS, (const float*)(args.ws + WS_LB) + (size_t)l * HW}; pg8::gemm_phase<EpiWin, pg8::StaticOrder, true, true>(lds, g, S, E); SEAM(pb + 3); }
        if (IN(pb + 4)) {
            for (int rep = 0; rep < ((PROBE_DUP & 1) ? 2 : 1); ++rep) {
            TIDL();
            for (int it = bid; it < GITEMS; it += G) gla_a_item(args, it, lds, tidl);
            for (int it = bid; it < DB * HH; it += G) hgrn_sample_item(args, l, it, lds, tidl);
            { S5Ctx cx; cx.g = -1; const int ipb = (S5ITEMS + G - 1) / G; const int i1 = (bid + 1) * ipb < S5ITEMS ? (bid + 1) * ipb : S5ITEMS;
              for (int it = bid * ipb; it < i1; ++it) s5_item<1>(args, l, it, cx, lds, tidl); }
            }
            SEAM(pb + 4); }
        if (IN(pb + 5)) { TIDL(); gla_b_phase(args, l, G, bid, tidl); SEAM(pb + 5); }
        if (IN(pb + 6)) {
            for (int rep = 0; rep < ((PROBE_DUP & 2) ? 2 : 1); ++rep) {
            TIDL(); const int npost = MS * HH;
            for (int it = bid; it < GITEMS; it += G) gla_c_item(args, l, it, lds, tidl);
            { S5Ctx cx; cx.g = -1; const int ipb = (S5ITEMS + G - 1) / G; const int i1 = (bid + 1) * ipb < S5ITEMS ? (bid + 1) * ipb : S5ITEMS;
              for (int it = bid * ipb; it < i1; ++it) s5_item<2>(args, l, it, cx, lds, tidl); }
            for (int it = bid * 8 + wavel; it < npost; it += G * 8) hgrn_post_item(args, l, it + MP * HH, lanel);
            }
            SEAM(pb + 6); }
        if (IN(pb + 7)) { pg8::Gemm g{(const bf16*)(args.ws + WS_YSG), (const bf16*)(wl + LW_GLU), MT, S5W, S5W}; pg8::StaticOrder S; S.init(MT, S5W, G, bid);
            EpiGlu E{(bf16*)(args.ws + WS_CAT), (const bf16*)(args.ws + WS_YSG), args.in[24] + (size_t)l * S5W}; pg8::gemm_phase<EpiGlu, pg8::StaticOrder, true, true>(lds, g, S, E); SEAM(pb + 7); }
        if (IN(pb + 8)) { pg8::Gemm g{(const bf16*)(args.ws + WS_CAT), (const bf16*)(wl + LW_OUT), MT, DM, DM}; pg8::StaticOrder S; S.init(MT, DM, G, bid);
            EpiF32 E{A, DM}; pg8::gemm_phase<EpiF32, pg8::StaticOrder, true, true>(lds, g, S, E); CONVQ(1 + 5 * l + 2, (2 * l + 1) * I_L, (2 * l + 1) * I_L + OI_D1); SEAM(pb + 8); }
        if (IN(pb + 9)) { TIDL(); norm_res_phase(args, args.in[6] + (size_t)(l * 3 + 1) * DM, 1.0f, G, bid, tidl); SEAM(pb + 9); }
        FFN_PHASES(1);
    }
#undef IN
#undef SEAM
}

extern "C" void kernel_launch(void* const* d_in, const int* in_sizes, int n_in, void* d_out, int out_size, void* d_ws, size_t ws_size, hipStream_t stream) {
    static int grid = 0;
    if (grid == 0) {
        if (n_in != 27 || out_size != (int)O_END || ws_size < WS_END3) { fprintf(stderr, "kernel_launch: unexpected shapes: n_in %d out %d ws %zu (need %zu)\n", n_in, out_size, ws_size, (size_t)WS_END3); grid = -1; return; }
        int dev = 0, cus = 0, per_cu = 0;
        if (hipGetDevice(&dev) != hipSuccess || hipDeviceGetAttribute(&cus, hipDeviceAttributeMultiprocessorCount, dev) != hipSuccess) { grid = -1; return; }
        if (hipFuncSetAttribute((const void*)mega, hipFuncAttributeMaxDynamicSharedMemorySize, LDS_BYTES) != hipSuccess) { fprintf(stderr, "kernel_launch: hipFuncSetAttribute failed\n"); grid = -1; return; }
        if (hipOccupancyMaxActiveBlocksPerMultiprocessor(&per_cu, (const void*)mega, 512, LDS_BYTES) != hipSuccess || per_cu < 1) fprintf(stderr, "kernel_launch: occupancy query reports %d\n", per_cu);
        (void)hipGetLastError();
        grid = cus;
    }
    if (grid < 0) return;
    (void)hipMemsetAsync((char*)d_ws + WS_CTL, 0, CTL_ZERO_BYTES, stream);
    Args a{};
    for (int i = 0; i < 27; ++i) a.in[i] = (const float*)d_in[i];
    a.out = (float*)d_out; a.ws = (unsigned char*)d_ws;
#if MK_PER_PHASE
    for (int p = 0; p < N_PHASES; ++p) { a.ph_lo = p; a.ph_hi = p + 1; hipLaunchKernelGGL(mega, dim3(grid), dim3(512), LDS_BYTES, stream, a); }
#else
    a.ph_lo = 0; a.ph_hi = N_PHASES; hipLaunchKernelGGL(mega, dim3(grid), dim3(512), LDS_BYTES, stream, a);
#endif
}
```

```cpp
#include <hip/hip_runtime.h>
#include <cstdio>
#include <cstdint>
namespace pg8 {
#define PG8_LAS __attribute__((address_space(3)))
typedef unsigned short bf16_t;
typedef short bf16x8 __attribute__((ext_vector_type(8)));
typedef float f32x4 __attribute__((ext_vector_type(4)));
typedef unsigned u32x4 __attribute__((ext_vector_type(4)));
constexpr int BM = 256, BK = 64, HALF = 128, HTB = HALF * BK * 2  , STAGE_BYTES = 8 * HTB, NXCD = 8, WGM = 8;

__host__ __device__ __forceinline__ int lds_byte(int r, int c) { const int st = (r >> 4) * 2 + (c >> 5), rr = r & 15, cc = c & 31, ob = rr * 64 + cc * 2; return st * 1024 + (ob ^ (((ob >> 9) & 1) << 5)); }
__host__ __device__ __forceinline__ void stage_rc(int b, int& R, int& C) { const int st = b / 1024, sb = b % 1024, swz = sb ^ (((sb >> 9) & 1) << 5); R = (st >> 1) * 16 + swz / 64; C = (st & 1) * 32 + (swz % 64) / 2; }
__host__ __device__ __forceinline__ int perm32(int rho) { const int n = rho >> 4, i = rho & 15; return 8 * (i >> 2) + 4 * n + (i & 3); }

struct Unit { int pm, pn, kb, nk, sp; };
struct Gemm { const bf16_t* A; const bf16_t* Bt; int M, N, K; };

struct StaticOrder {
    int nM, nN, nwg, G, c, nkt;
    __host__ __device__ void init(int M, int N, int K, int G_, int c_) { nM = M / BM; nN = N / BM; nwg = nM * nN; G = G_; c = c_; nkt = K / BK; }
    __host__ __device__ bool next(int i, Unit& u) const {
        const long L = (long)i * G + c; if (L >= nwg) return false;
        int wgid = (int)L; { const int q = nwg / NXCD, r = nwg % NXCD, xcd = wgid % NXCD, off = wgid / NXCD; wgid = (xcd < r ? xcd * (q + 1) : r * (q + 1) + (xcd - r) * q) + off; }
        const int nig = WGM * nN, gid = wgid / nig, fm = gid * WGM, gsz = (nM - fm) < WGM ? (nM - fm) : WGM;
        u.pm = fm + ((wgid % nig) % gsz); u.pn = (wgid % nig) / gsz; u.kb = 0; u.nk = nkt; u.sp = -1; return true;
    }
    __device__ __forceinline__ void a_ready(const Unit&) const {}
    __device__ __forceinline__ void done(const Unit&) const {}
};

struct SplitOrder {
    int c, nkt;
    __host__ __device__ void init(int K, int c_) { c = c_; nkt = K / BK; }
    __host__ __device__ bool next(int i, Unit& u) const {
        if (i == 0) { const int wgid = (c & 7) * 32 + (c >> 3), gid = wgid >> 6; u.pm = gid * 8 + ((wgid & 63) & 7); u.pn = (wgid & 63) >> 3; u.kb = 0; u.nk = nkt; u.sp = -1; return true; }
        if (i == 1) { const int s = c & 7, unit = c >> 3, P = nkt / 2, base = P / 8, rem = P % 8; u.pm = 32 + (unit >> 3); u.pn = unit & 7;
            u.kb = 2 * (s * base + (s < rem ? s : rem)); u.nk = 2 * (base + (s < rem ? 1 : 0)); u.sp = s; return true; }
        return false;
    }
    __device__ __forceinline__ void a_ready(const Unit&) const {}
    __device__ __forceinline__ void done(const Unit&) const {}
};

__device__ __forceinline__ unsigned cvt_pk_bf16(float lo, float hi) { unsigned r; asm volatile("v_cvt_pk_bf16_f32 %0, %1, %2" : "=v"(r) : "v"(lo), "v"(hi)); return r; }
typedef float f32x2 __attribute__((ext_vector_type(2)));
template <class Epi, class Sched, bool ALIGN_EPI = false, bool SP2 = false>
__device__ __forceinline__ void gemm_phase(PG8_LAS unsigned char* lds, const Gemm g, const Sched& S, const Epi& E) {
    int tid_l = threadIdx.x; asm volatile("" : "+v"(tid_l));
    const int tid = tid_l, wid = __builtin_amdgcn_readfirstlane(tid >> 6), lane = tid & 63, wr = wid >> 2, wc = wid & 3, fr = lane & 15, fq = lane >> 4;
    const int K = g.K;
    unsigned voffA[2], voffB[2];
#pragma unroll
    for (int i = 0; i < 2; ++i) { int R, C; stage_rc(tid * 16 + i * 8192, R, C); const int Rb = Epi::PERM ? ((R & ~31) + perm32(R & 31)) : R;
        voffA[i] = (unsigned)(R * K + C) * 2u; voffB[i] = (unsigned)(Rb * K + C) * 2u; }
    const size_t kstep = (size_t)(BK * 2);
    const size_t hstep = (size_t)HALF * K * 2;
    const size_t tstep = 2 * hstep;
    const unsigned ldsw = (unsigned)wid * 1024u;
    const int aoff = lds_byte(wr * 64 + fr, fq * 8), boff = lds_byte(wc * 32 + fr, fq * 8);
#define PG8_SA(b, h) (((b) * 2 + (h)) * HTB)
#define PG8_SB(b, h) ((4 + (b) * 2 + (h)) * HTB)
#define PG8_STAGE(bufoff, gbase, voff) do { _Pragma("unroll") for (int _i = 0; _i < 2; ++_i) \
        __builtin_amdgcn_global_load_lds((const unsigned*)((const char*)(gbase) + (voff)[_i]), (PG8_LAS unsigned*)(lds + (bufoff) + ldsw + _i * 8192), 16, 0, 0); } while (0)
#define PG8_LDA(dst, b, h) do { _Pragma("unroll") for (int m = 0; m < 4; ++m) _Pragma("unroll") for (int k = 0; k < 2; ++k) dst[m][k] = *(const PG8_LAS bf16x8*)(lds + PG8_SA(b, h) + aoff + m * 2048 + k * 1024); } while (0)
#define PG8_LDB(dst, b, h) do { _Pragma("unroll") for (int n = 0; n < 2; ++n) _Pragma("unroll") for (int k = 0; k < 2; ++k) dst[n][k] = *(const PG8_LAS bf16x8*)(lds + PG8_SB(b, h) + boff + n * 2048 + k * 1024); } while (0)
#define PG8_MMA(ai, bj, At, Bt) do { __builtin_amdgcn_s_setprio(1); _Pragma("unroll") for (int m = 0; m < 4; ++m) _Pragma("unroll") for (int n = 0; n < 2; ++n) _Pragma("unroll") for (int k = 0; k < 2; ++k) \
        acc[ai][bj][m][n] = __builtin_amdgcn_mfma_f32_16x16x32_bf16(Bt[n][k], At[m][k], acc[ai][bj][m][n], 0, 0, 0); __builtin_amdgcn_s_setprio(0); } while (0)
#define PG8_WAIT_V(n) asm volatile("s_waitcnt vmcnt(" #n ")" ::: "memory")
#define PG8_WAIT_L(n) asm volatile("s_waitcnt lgkmcnt(" #n ")" ::: "memory")
#define PG8_BAR __builtin_amdgcn_s_barrier()
#define PG8_SCHED __builtin_amdgcn_sched_barrier(0)
    Unit cur, nxt; int ui = 0;
    if (!S.next(0, cur)) return;
    f32x4 acc[2][2][4][2];
#pragma unroll
    for (int a = 0; a < 2; ++a)
#pragma unroll
        for (int b = 0; b < 2; ++b)
#pragma unroll
            for (int m = 0; m < 4; ++m)
#pragma unroll
                for (int n = 0; n < 2; ++n) acc[a][b][m][n] = (f32x4){0.f, 0.f, 0.f, 0.f};
    bf16x8 At[4][2], B0[2][2], B1[2][2];
    const char* cA = (const char*)g.A + (size_t)cur.pm * tstep + (size_t)cur.kb * kstep; const char* cB = (const char*)g.Bt + (size_t)cur.pn * tstep + (size_t)cur.kb * kstep;
    S.a_ready(cur);
    if constexpr (SP2) {
        PG8_STAGE(PG8_SB(0, 0), cB, voffB); PG8_STAGE(PG8_SB(0, 1), cB + hstep, voffB); PG8_STAGE(PG8_SA(0, 0), cA, voffA); PG8_STAGE(PG8_SA(0, 1), cA + hstep, voffA);
        if (wr == 1) PG8_BAR;
        PG8_WAIT_V(2); PG8_BAR;
        PG8_STAGE(PG8_SB(1, 0), cB + kstep, voffB); PG8_STAGE(PG8_SA(1, 0), cA + kstep, voffA); PG8_STAGE(PG8_SB(1, 1), cB + hstep + kstep, voffB);
        PG8_WAIT_V(6); PG8_BAR;
    } else {
        PG8_STAGE(PG8_SB(0, 0), cB, voffB); PG8_STAGE(PG8_SA(0, 0), cA, voffA); PG8_STAGE(PG8_SB(0, 1), cB + hstep, voffB); PG8_STAGE(PG8_SA(0, 1), cA + hstep, voffA);
        if (wr == 1) PG8_BAR;
        PG8_WAIT_V(4); PG8_BAR;
        PG8_STAGE(PG8_SB(1, 0), cB + kstep, voffB); PG8_STAGE(PG8_SA(1, 0), cA + kstep, voffA); PG8_STAGE(PG8_SB(1, 1), cB + hstep + kstep, voffB);
        PG8_WAIT_V(6); PG8_BAR;
    }
    for (;;) {
        const bool has_next = S.next(ui + 1, nxt);
        const char* nA = has_next ? (const char*)g.A + (size_t)nxt.pm * tstep + (size_t)nxt.kb * kstep : cA; const char* nB = has_next ? (const char*)g.Bt + (size_t)nxt.pn * tstep + (size_t)nxt.kb * kstep : cB;
        const int nt = cur.nk;
        for (int t = 0; t < nt; t += 2) {
            const bool last = (t == nt - 2);
            const char* a1 = cA + (size_t)(t + 1) * kstep;
            const char* a2 = last ? nA : cA + (size_t)(t + 2) * kstep; const char* b2 = last ? nB : cB + (size_t)(t + 2) * kstep;
            const char* a3 = a2 + kstep; const char* b3 = b2 + kstep;
            if (last && has_next) S.a_ready(nxt);
            if constexpr (SP2) {
            PG8_LDB(B0, 0, 0); PG8_LDB(B1, 0, 1); PG8_SCHED; PG8_LDA(At, 0, 0); PG8_STAGE(PG8_SA(1, 1), a1 + hstep, voffA);
            PG8_WAIT_V(8); PG8_WAIT_L(0); PG8_BAR; PG8_MMA(0, 0, At, B0); PG8_MMA(0, 1, At, B1); PG8_BAR; PG8_SCHED;
            PG8_LDA(At, 0, 1); PG8_STAGE(PG8_SB(0, 0), b2, voffB); PG8_STAGE(PG8_SB(0, 1), b2 + hstep, voffB); PG8_STAGE(PG8_SA(0, 0), a2, voffA);
            PG8_WAIT_V(8); PG8_WAIT_L(0); PG8_BAR; PG8_MMA(1, 0, At, B0); PG8_MMA(1, 1, At, B1); PG8_BAR; PG8_SCHED;
            PG8_LDB(B0, 1, 0); PG8_LDB(B1, 1, 1); PG8_SCHED; PG8_LDA(At, 1, 0); PG8_STAGE(PG8_SA(0, 1), a2 + hstep, voffA);
            PG8_WAIT_V(8); PG8_WAIT_L(0); PG8_BAR; PG8_MMA(0, 0, At, B0); PG8_MMA(0, 1, At, B1); PG8_BAR; PG8_SCHED;
            PG8_LDA(At, 1, 1); PG8_STAGE(PG8_SB(1, 0), b3, voffB); PG8_STAGE(PG8_SB(1, 1), b3 + hstep, voffB); PG8_STAGE(PG8_SA(1, 0), a3, voffA);
            PG8_WAIT_V(8); PG8_WAIT_L(0); PG8_BAR; PG8_MMA(1, 0, At, B0); PG8_MMA(1, 1, At, B1); PG8_BAR; PG8_SCHED;
            } else {
            PG8_LDB(B0, 0, 0); PG8_SCHED; PG8_LDA(At, 0, 0); PG8_STAGE(PG8_SA(1, 1), a1 + hstep, voffA);
            PG8_WAIT_L(8); PG8_BAR; PG8_WAIT_L(0); PG8_MMA(0, 0, At, B0); PG8_BAR; PG8_SCHED;
            PG8_LDB(B1, 0, 1); PG8_STAGE(PG8_SB(0, 0), b2, voffB);
            PG8_BAR; PG8_WAIT_L(0); PG8_MMA(0, 1, At, B1); PG8_BAR;
            PG8_LDA(At, 0, 1); PG8_STAGE(PG8_SA(0, 0), a2, voffA);
            PG8_BAR; PG8_WAIT_L(0); PG8_MMA(1, 0, At, B0); PG8_BAR; PG8_SCHED;
            PG8_STAGE(PG8_SB(0, 1), b2 + hstep, voffB);
            PG8_WAIT_V(6); PG8_BAR; PG8_MMA(1, 1, At, B1); PG8_BAR;
            PG8_LDB(B0, 1, 0); PG8_SCHED; PG8_LDA(At, 1, 0); PG8_STAGE(PG8_SA(0, 1), a2 + hstep, voffA);
            PG8_WAIT_L(8); PG8_BAR; PG8_WAIT_L(0); PG8_MMA(0, 0, At, B0); PG8_BAR; PG8_SCHED;
            PG8_LDB(B1, 1, 1); PG8_STAGE(PG8_SB(1, 0), b3, voffB);
            PG8_BAR; PG8_WAIT_L(0); PG8_MMA(0, 1, At, B1); PG8_BAR;
            PG8_LDA(At, 1, 1); PG8_STAGE(PG8_SA(1, 0), a3, voffA);
            PG8_BAR; PG8_WAIT_L(0); PG8_MMA(1, 0, At, B0); PG8_BAR; PG8_SCHED;
            PG8_STAGE(PG8_SB(1, 1), b3 + hstep, voffB);
            PG8_WAIT_V(6); PG8_BAR; PG8_MMA(1, 1, At, B1); PG8_BAR;
            }
        }
        if constexpr (ALIGN_EPI) { if (wr == 0) PG8_BAR; }
        if constexpr (!Epi::AFTER_DRAIN) { E(acc, cur, wr, wc, fr, fq); S.done(cur); }
        if (!has_next) break;
#pragma unroll
        for (int a = 0; a < 2; ++a)
#pragma unroll
            for (int b = 0; b < 2; ++b)
#pragma unroll
                for (int m = 0; m < 4; ++m)
#pragma unroll
                    for (int n = 0; n < 2; ++n) acc[a][b][m][n] = (f32x4){0.f, 0.f, 0.f, 0.f};
        cur = nxt; cA = nA; cB = nB; ++ui;
        if constexpr (ALIGN_EPI) { if (wr == 1) PG8_BAR; }
    }
    PG8_WAIT_V(0);
    if constexpr (!ALIGN_EPI) { if (wr == 0) PG8_BAR; }
    PG8_BAR;
    if constexpr (Epi::AFTER_DRAIN) { E.fused(acc, cur, wr, wc, fr, fq, lds, wid, lane); S.done(cur); }
#undef PG8_SA
#undef PG8_SB
#undef PG8_STAGE
#undef PG8_LDA
#undef PG8_LDB
#undef PG8_MMA
#undef PG8_WAIT_V
#undef PG8_WAIT_L
#undef PG8_BAR
#undef PG8_SCHED
}
}
#define XB_TMO      128
#define XB_XCNT(j)  (256  + 64 * (j))
#define XB_XSUB(j)  (1280 + 64 * (j))
#define XB_XGEN(j)  (2304 + 64 * (j))
#define XB_TOP      3328
#define XB_TOPGEN   3392
#define XCD_BAR_WORDS 3456
#define XB_SPIN_CAP (1u << 18)
#define LAS __attribute__((address_space(3)))

__device__ __forceinline__ unsigned xb_ld(unsigned* p)              { return __hip_atomic_load(p, __ATOMIC_RELAXED, __HIP_MEMORY_SCOPE_AGENT); }
__device__ __forceinline__ unsigned xb_add(unsigned* p, unsigned v) { return __hip_atomic_fetch_add(p, v, __ATOMIC_RELAXED, __HIP_MEMORY_SCOPE_AGENT); }
__device__ __forceinline__ unsigned xb_xcc_id() { return (unsigned)__builtin_amdgcn_s_getreg((3 << 11) | 20) & 0xFu; }
#define XB_SPIN(cond, bar) do { unsigned _sp = 0; while (cond) { __builtin_amdgcn_s_sleep(1); \
    if ((++_sp & 255u) == 0u) { if (xb_ld(&(bar)[XB_TMO])) break; if (_sp > XB_SPIN_CAP) { atomicAdd(&(bar)[XB_TMO], 1u); break; } } } } while (0)

struct XcdBarrier {
    unsigned* bar; unsigned x;
    volatile LAS unsigned* st;
};

__device__ __forceinline__ XcdBarrier xcd_barrier_post(unsigned* bar, volatile LAS unsigned* st) {
    XcdBarrier b; b.bar = bar; b.x = xb_xcc_id(); b.st = st;
    if (threadIdx.x == 0) (void)xb_add(&bar[XB_XCNT(b.x)], 1u);
    return b;
}
__device__ __forceinline__ void xcd_barrier_complete(unsigned* bar, unsigned x, unsigned& nloc, unsigned& nx) {
    const unsigned G = gridDim.x * gridDim.y * gridDim.z;
    unsigned sum, cnt, mine, sp = 0u;
    for (;;) {
        sum = 0u; cnt = 0u; mine = 0u;
#pragma unroll
        for (unsigned j = 0; j < 16; ++j) { const unsigned c = xb_ld(&bar[XB_XCNT(j)]); sum += c; cnt += (c > 0u) ? 1u : 0u; mine = (j == x) ? c : mine; }
        if (sum == G) break;
        __builtin_amdgcn_s_sleep(1);
        if ((++sp & 255u) == 0u) { if (xb_ld(&bar[XB_TMO])) break; if (sp > XB_SPIN_CAP) { atomicAdd(&bar[XB_TMO], 1u); break; } }
    }
    nloc = mine > 0u ? mine : 1u; nx = cnt > 0u ? cnt : 1u;
}

__device__ __forceinline__ void xcd_barrier(const XcdBarrier& b) {
    asm volatile("s_waitcnt vmcnt(0)" ::: "memory");
    __syncthreads();
    if (threadIdx.x == 0) {
        unsigned* bar = b.bar;
        __builtin_amdgcn_s_waitcnt(0);
        unsigned nloc = b.st[0], nx = b.st[1];
        if (nloc == 0u) { xcd_barrier_complete(bar, b.x, nloc, nx); b.st[0] = nloc; b.st[1] = nx; }
        const unsigned old = xb_add(&bar[XB_XSUB(b.x)], 1u);
        const unsigned gen = old / nloc;
        if (old + 1u == (gen + 1u) * nloc) {
            __builtin_amdgcn_fence(__ATOMIC_RELEASE, "agent");
            asm volatile("s_waitcnt vmcnt(0)" ::: "memory");
            const unsigned og = xb_add(&bar[XB_TOP], 1u);
            const unsigned tg = og / nx;
            if (og + 1u == (tg + 1u) * nx) xb_add(&bar[XB_TOPGEN], 1u);
            else XB_SPIN(xb_ld(&bar[XB_TOPGEN]) == tg, bar);
            __builtin_amdgcn_fence(__ATOMIC_ACQUIRE, "agent");
            xb_add(&bar[XB_XGEN(b.x)], 1u);
            asm volatile("s_waitcnt vmcnt(0)" ::: "memory");
        } else {
            XB_SPIN(xb_ld(&bar[XB_XGEN(b.x)]) == gen, bar);
            __builtin_amdgcn_fence(__ATOMIC_ACQUIRE, "agent");
            asm volatile("s_waitcnt vmcnt(0)" ::: "memory");
        }
    }
    __syncthreads();
}

constexpr int DM = 2048, NB = 4, SEQ = 2048, DEPTH = 4, DB = 128, DSQ = 8;
constexpr int MP = NB * SEQ, MS = DB * DSQ, MT = MP + MS;
constexpr int S5W = 1024, S5G = 64, S5N = 64, S5C = 16;
constexpr int HW = 1024, HH = 8, HK = 128, HV = 128;
constexpr int FF = 5504, INW = 5120;
constexpr float EPS = 1e-6f;
constexpr int S5CH = 16, S5CL = SEQ / S5CH;

constexpr size_t O_Y = 0, O_REP = (size_t)MT * DM, O_IMP = O_REP + (size_t)DEPTH * NB * S5G * S5N, O_HP = O_IMP + (size_t)DEPTH * NB * S5G * S5N,
                 O_RES = O_HP + (size_t)DEPTH * NB * HH * HK * HV, O_IMS = O_RES + (size_t)DEPTH * DB * S5G * S5N, O_HS = O_IMS + (size_t)DEPTH * DB * S5G * S5N,
                 O_END = O_HS + (size_t)DEPTH * DB * HH * HK * HV;
static_assert(O_END == 92405760, "output size");

constexpr size_t MiB = 1u << 20;
constexpr size_t WS_CTL = 0, CTL_ZERO_BYTES = 1 * MiB;
constexpr size_t WS_AB = 1 * MiB;
constexpr size_t WS_BBR = WS_AB + 256 * 1024;
constexpr size_t WS_BBI = WS_BBR + 1 * MiB;
constexpr size_t WS_LB = WS_BBI + 1 * MiB;
constexpr size_t WS_RS = WS_LB + 64 * 1024;
constexpr size_t WS_S5E = WS_RS + 64 * 1024;
constexpr size_t WS_W = 16 * MiB;
constexpr size_t LW_GU1 = 0, LW_D1 = LW_GU1 + (size_t)2 * FF * DM * 2, LW_GU2 = LW_D1 + (size_t)DM * FF * 2, LW_D2 = LW_GU2 + (size_t)2 * FF * DM * 2,
                 LW_IN = LW_D2 + (size_t)DM * FF * 2, LW_GLU = LW_IN + (size_t)INW * DM * 2, LW_OUT = LW_GLU + (size_t)S5W * S5W * 2, LW_END = LW_OUT + (size_t)DM * DM * 2;
static_assert(LW_END == 166723584 && (LW_D1 % 256) == 0 && (LW_GLU % 256) == 0, "weight map");
constexpr size_t WS_HB = 656 * MiB;
constexpr size_t WS_HID = WS_HB + 36 * MiB;
constexpr size_t WS_A = WS_HID + 97 * MiB;
constexpr size_t WS_Z = WS_A + 72 * MiB;
constexpr size_t WS_CAT = WS_Z + 180 * MiB;
constexpr size_t WS_YSG = WS_CAT + 36 * MiB;
constexpr size_t WS_O = WS_YSG + 18 * MiB;
constexpr size_t WS_PART = WS_O + 36 * MiB;
constexpr size_t WS_END = WS_PART + 64 * MiB;
static_assert(WS_W + 4 * LW_END <= WS_HB && WS_S5E + 2 * MiB <= WS_W, "ws map");

constexpr int RING_BYTES = 131072, LDSCTL_OFF = RING_BYTES, LDS_BYTES = RING_BYTES + 1024;

#define GAS __attribute__((address_space(1)))
#define LAS __attribute__((address_space(3)))
typedef unsigned short bf16;
typedef float f32x4 __attribute__((ext_vector_type(4)));
typedef float f32x2 __attribute__((ext_vector_type(2)));
typedef unsigned v4u __attribute__((ext_vector_type(4)));
typedef unsigned v2u __attribute__((ext_vector_type(2)));
#define LDS_WAIT() asm volatile("s_waitcnt lgkmcnt(0)" ::: "memory")

__device__ __forceinline__ unsigned f2bf(float f) { unsigned u = __builtin_bit_cast(unsigned, f); return (u + 0x7fffu + ((u >> 16) & 1u)) >> 16; }
__device__ __forceinline__ unsigned pk2(float lo, float hi) { return f2bf(lo) | (f2bf(hi) << 16); }
__device__ __forceinline__ float bflo(unsigned w) { return __builtin_bit_cast(float, w << 16); }
__device__ __forceinline__ float bfhi(unsigned w) { return __builtin_bit_cast(float, w & 0xffff0000u); }
__device__ __forceinline__ float wave_sum(float v) {
#pragma unroll
    for (int o = 1; o < 64; o <<= 1) v += __shfl_xor(v, o);
    return v;
}
__device__ __forceinline__ float sigm(float x) { return 1.f / (1.f + __expf(-x)); }
__device__ __forceinline__ float silu(float x) { return x / (1.f + __expf(-x)); }
__device__ __forceinline__ float gelu_tanh(float v) { const float a = 0.7978845608f * (v + 0.044715f * v * v * v); const float th = 1.f - 2.f / (__expf(2.f * a) + 1.f); return 0.5f * v * (1.f + th); }

struct Args { const float* in[27]; float* out; unsigned char* ws; int ph_lo, ph_hi; };

struct EpiGU {
    static constexpr bool PERM = true, AFTER_DRAIN = false;
    bf16* O; const float* rs;
    __device__ __forceinline__ void operator()(const pg8::f32x4 (&acc)[2][2][4][2], const pg8::Unit& u, int wr, int wc, int fr, int fq) const {
        const int row0 = u.pm * 256 + wr * 64 + fr, col0 = u.pn * 128 + wc * 32 + 8 * fq;
#pragma unroll
        for (int ai = 0; ai < 2; ++ai)
#pragma unroll
            for (int m = 0; m < 4; ++m) {
                const int row = row0 + ai * 128 + m * 16; const float r = rs[row];
                float o[8];
#pragma unroll
                for (int n = 0; n < 2; ++n)
#pragma unroll
                    for (int j = 0; j < 4; ++j) { const float g = acc[ai][0][m][n][j] * r, uu = acc[ai][1][m][n][j] * r; o[4 * n + j] = silu(g) * uu; }
                v4u w; w.x = pk2(o[0], o[1]); w.y = pk2(o[2], o[3]); w.z = pk2(o[4], o[5]); w.w = pk2(o[6], o[7]);
                *(v4u*)(O + (size_t)row * FF + col0) = w;
            }
    }
};
struct MixOrder {
    bool split; pg8::StaticOrder so; pg8::SplitOrder sp;
    __device__ __forceinline__ bool next(int i, pg8::Unit& u) const { return split ? sp.next(i, u) : so.next(i, u); }
    __device__ __forceinline__ void a_ready(const pg8::Unit&) const {}
    __device__ __forceinline__ void done(const pg8::Unit&) const {}
};
struct EpiF32 {
    static constexpr bool PERM = false, AFTER_DRAIN = false;
    float* C; int ldc; float* P;
    __device__ __forceinline__ void operator()(const pg8::f32x4 (&acc)[2][2][4][2], const pg8::Unit& u, int wr, int wc, int fr, int fq) const {
        const int row0 = u.pm * 256 + wr * 64 + fr, col0 = u.pn * 256 + wc * 32 + 4 * fq;
        float* base = u.sp < 0 ? C : P + ((size_t)u.sp * MS - MP) * ldc;
#pragma unroll
        for (int ai = 0; ai < 2; ++ai)
#pragma unroll
            for (int m = 0; m < 4; ++m) { float* rowp = base + (size_t)(row0 + ai * 128 + m * 16) * ldc + col0;
#pragma unroll
                for (int bj = 0; bj < 2; ++bj)
#pragma unroll
                    for (int n = 0; n < 2; ++n) *(f32x4*)(rowp + bj * 128 + n * 16) = acc[ai][bj][m][n]; }
    }
};
struct EpiWin {
    static constexpr bool PERM = false, AFTER_DRAIN = false;
    float* Z; const float* rs; const float* lb;
    __device__ __forceinline__ void operator()(const pg8::f32x4 (&acc)[2][2][4][2], const pg8::Unit& u, int wr, int wc, int fr, int fq) const {
        const int row0 = u.pm * 256 + wr * 64 + fr, col0 = u.pn * 256 + wc * 32 + 4 * fq; const int kind = u.pn >> 2;
#pragma unroll
        for (int ai = 0; ai < 2; ++ai)
#pragma unroll
            for (int m = 0; m < 4; ++m) { const int row = row0 + ai * 128 + m * 16; const float r = rs[row]; float* rowp = Z + (size_t)row * INW + col0;
#pragma unroll
                for (int bj = 0; bj < 2; ++bj)
#pragma unroll
                    for (int n = 0; n < 2; ++n) { f32x4 v = acc[ai][bj][m][n] * r;
                        if (kind == 1) { v[0] = silu(v[0]); v[1] = silu(v[1]); v[2] = silu(v[2]); v[3] = silu(v[3]); }
                        else if (kind == 2) { const f32x4 l4 = *(const f32x4*)(lb + (col0 + bj * 128 + n * 16 - 2048));
#pragma unroll
                            for (int j = 0; j < 4; ++j) v[j] = l4[j] + (1.f - l4[j]) * sigm(v[j]); }
                        *(f32x4*)(rowp + bj * 128 + n * 16) = v; } }
    }
};
struct EpiGlu {
    static constexpr bool PERM = true, AFTER_DRAIN = false;
    bf16* CAT; const bf16* YSG; const float* bias;
    __device__ __forceinline__ void operator()(const pg8::f32x4 (&acc)[2][2][4][2], const pg8::Unit& u, int wr, int wc, int fr, int fq) const {
        const int row0 = u.pm * 256 + wr * 64 + fr, col0 = u.pn * 256 + wc * 32 + 8 * fq;
        f32x4 bv[2][2];
#pragma unroll
        for (int bj = 0; bj < 2; ++bj)
#pragma unroll
            for (int n = 0; n < 2; ++n) bv[bj][n] = *(const f32x4*)(bias + col0 + bj * 128 + 4 * n);
#pragma unroll
        for (int ai = 0; ai < 2; ++ai)
#pragma unroll
            for (int m = 0; m < 4; ++m) { const int row = row0 + ai * 128 + m * 16;
#pragma unroll
                for (int bj = 0; bj < 2; ++bj) { const int col = col0 + bj * 128;
                    const v4u y = *(const v4u*)(YSG + (size_t)row * S5W + col);
                    const f32x4 t0 = acc[ai][bj][m][0] + bv[bj][0], t1 = acc[ai][bj][m][1] + bv[bj][1];
                    v4u w; w.x = pk2(bflo(y.x) * sigm(t0[0]), bfhi(y.x) * sigm(t0[1])); w.y = pk2(bflo(y.y) * sigm(t0[2]), bfhi(y.y) * sigm(t0[3]));
                    w.z = pk2(bflo(y.z) * sigm(t1[0]), bfhi(y.z) * sigm(t1[1])); w.w = pk2(bflo(y.w) * sigm(t1[2]), bfhi(y.w) * sigm(t1[3]));
                    *(v4u*)(CAT + (size_t)row * DM + col) = w; } }
    }
};

__device__ __forceinline__ void s5_tables_item(const Args& a, int lg, LAS unsigned char* lds, int tid);
constexpr int I_GU = 32 * 344, I_D = 86 * 64, I_IN = 32 * 160, I_GLU = 16 * 32, I_OUT = 32 * 64;
constexpr int OI_GU1 = 0, OI_D1 = OI_GU1 + I_GU, OI_IN = OI_D1 + I_D, OI_GLU = OI_IN + I_IN, OI_OUT = OI_GLU + I_GLU, OI_GU2 = OI_OUT + I_OUT, OI_D2 = OI_GU2 + I_GU, I_L = OI_D2 + I_D;
static_assert(I_L == 40704, "items per layer");
struct TrDesc { const float* src; const float* gain; bf16* dst; int ldw, K; };
__device__ __forceinline__ TrDesc tr_decode(const Args& a, int it) {
    const int l = it / I_L; int r = it - l * I_L; TrDesc d;
    unsigned char* wl = a.ws + WS_W + (size_t)l * LW_END;
    if (r >= OI_GU2 && r < OI_D2 || r < OI_D1) { const int f = r >= OI_GU2; r -= f ? OI_GU2 : 0; const int kb = r / 344, nb = r % 344, pn = nb >> 3, rr = nb & 7;
        d.src = (rr < 4 ? a.in[f ? 10 : 7] : a.in[f ? 11 : 8]) + (size_t)l * DM * FF + (size_t)(64 * kb) * FF + 128 * pn + 32 * (rr & 3); d.ldw = FF;
        d.gain = a.in[5] + (size_t)(l * 3 + (f ? 2 : 0)) * DM + 64 * kb; d.dst = (bf16*)(wl + (f ? LW_GU2 : LW_GU1)) + (size_t)(32 * nb) * DM + 64 * kb; d.K = DM; return d; }
    if (r >= OI_D2 || r < OI_IN) { const int f = r >= OI_D2; r -= f ? OI_D2 : OI_D1; const int kb = r / 64, nb = r % 64;
        d.src = a.in[f ? 12 : 9] + (size_t)l * FF * DM + (size_t)(64 * kb) * DM + 32 * nb; d.ldw = DM; d.gain = nullptr; d.dst = (bf16*)(wl + (f ? LW_D2 : LW_D1)) + (size_t)(32 * nb) * FF + 64 * kb; d.K = FF; return d; }
    if (r < OI_GLU) { r -= OI_IN; const int kb = r / 160, nb = r % 160;
        d.src = a.in[13] + (size_t)l * DM * INW + (size_t)(64 * kb) * INW + 32 * nb; d.ldw = INW; d.gain = a.in[5] + (size_t)(l * 3 + 1) * DM + 64 * kb; d.dst = (bf16*)(wl + LW_IN) + (size_t)(32 * nb) * DM + 64 * kb; d.K = DM; return d; }
    if (r < OI_OUT) { r -= OI_GLU; const int kb = r / 32, nb = r % 32;
        d.src = a.in[23] + (size_t)l * S5W * S5W + (size_t)(64 * kb) * S5W + 32 * nb; d.ldw = S5W; d.gain = nullptr; d.dst = (bf16*)(wl + LW_GLU) + (size_t)(32 * nb) * S5W + 64 * kb; d.K = S5W; return d; }
    { r -= OI_OUT; const int kb = r / 64, nb = r % 64;
        d.src = a.in[14] + (size_t)l * DM * DM + (size_t)(64 * kb) * DM + 32 * nb; d.ldw = DM; d.gain = nullptr; d.dst = (bf16*)(wl + LW_OUT) + (size_t)(32 * nb) * DM + 64 * kb; d.K = DM; return d; }
}
__device__ __forceinline__ void tr_load(const TrDesc& d, float (&v)[32], int lane) {
    const float* p = d.src + (size_t)(lane >> 5) * d.ldw + (lane & 31);
#pragma unroll
    for (int i = 0; i < 32; ++i) v[i] = __builtin_nontemporal_load(p + (size_t)(2 * i) * d.ldw);
}
__device__ __forceinline__ void tr_store(const TrDesc& d, const float (&v)[32], LAS float* scr, int lane) {
    if (d.gain) {
#pragma unroll
        for (int i = 0; i < 32; ++i) scr[(2 * i + (lane >> 5)) * 33 + (lane & 31)] = v[i] * d.gain[2 * i + (lane >> 5)];
    } else {
#pragma unroll
        for (int i = 0; i < 32; ++i) scr[(2 * i + (lane >> 5)) * 33 + (lane & 31)] = v[i];
    }
    LDS_WAIT(); asm volatile("" ::: "memory");
    const int c = lane & 7;
#pragma unroll
    for (int j = 0; j < 4; ++j) { const int n = (lane >> 3) + 8 * j; const LAS float* s = scr + (8 * c) * 33 + n;
        v4u o; o.x = pk2(s[0 * 33], s[1 * 33]); o.y = pk2(s[2 * 33], s[3 * 33]); o.z = pk2(s[4 * 33], s[5 * 33]); o.w = pk2(s[6 * 33], s[7 * 33]);
        *(v4u*)(d.dst + (size_t)n * d.K + 8 * c) = o; }
    LDS_WAIT(); asm volatile("" ::: "memory");
}
__device__ __forceinline__ void convert_queue(const Args& a, unsigned* ctr, int begin, int end, LAS unsigned char* lds, int tid) {
    const int wave = __builtin_amdgcn_readfirstlane(tid >> 6), lane = tid & 63;
    LAS float* scr = (LAS float*)(lds + wave * 16384);
    for (;;) {
        unsigned c = 0; if (lane == 0) c = __hip_atomic_fetch_add(ctr, 8u, __ATOMIC_RELAXED, __HIP_MEMORY_SCOPE_AGENT);
        const int ib = begin + (int)__builtin_amdgcn_readfirstlane(c);
        if (ib >= end) break;
        for (int i0 = ib; i0 < ib + 8 && i0 < end; i0 += 2) {
            const TrDesc d0 = tr_decode(a, i0); float v0[32]; tr_load(d0, v0, lane);
            if (i0 + 1 < end) { const TrDesc d1 = tr_decode(a, i0 + 1); float v1[32]; tr_load(d1, v1, lane); tr_store(d0, v0, scr, lane); tr_store(d1, v1, scr, lane); }
            else tr_store(d0, v0, scr, lane);
        }
    }
}
constexpr int CW_Q = 32768;
__device__ __forceinline__ void p0_prologue(const Args& a, LAS unsigned char* lds, int G, int bid, int tid) {
    const int wave = __builtin_amdgcn_readfirstlane(tid >> 6), lane = tid & 63;
    const int gw = bid * 8 + wave, NGW = G * 8;
    convert_queue(a, (unsigned*)(a.ws + WS_CTL) + CW_Q, 0, OI_D1, lds, tid);
    __syncthreads();
    for (int lg = bid; lg < DEPTH * S5G; lg += G) s5_tables_item(a, lg, lds, tid);
    for (int idx = bid * 512 + tid; idx < HW; idx += G * 512) {
        const float x0 = a.in[25][idx], x1 = a.in[25][HW + idx], x2 = a.in[25][2 * HW + idx], x3 = a.in[25][3 * HW + idx];
        const float mx = fmaxf(fmaxf(x0, x1), fmaxf(x2, x3));
        const float e0 = expf(x0 - mx), e1 = expf(x1 - mx), e2 = expf(x2 - mx), e3 = expf(x3 - mx), inv = 1.f / (e0 + e1 + e2 + e3);
        float* lb = (float*)(a.ws + WS_LB);
        lb[idx] = 0.f; lb[HW + idx] = e1 * inv; lb[2 * HW + idx] = (e1 + e2) * inv; lb[3 * HW + idx] = (e1 + e2 + e3) * inv;
    }
    for (int row = gw; row < MT; row += NGW) {
        const float* xr = row < MP ? a.in[0] + (size_t)row * DM : a.in[1] + (size_t)(row - MP) * DM;
        float* hr = a.out + O_Y + (size_t)row * DM; bf16* hb = (bf16*)(a.ws + WS_HB) + (size_t)row * DM;
        float ss = 0.f;
#pragma unroll
        for (int j = 0; j < 8; ++j) { const f32x4 v = *(const f32x4*)(xr + 4 * lane + 256 * j); ss += (v[0] * v[0] + v[1] * v[1]) + (v[2] * v[2] + v[3] * v[3]);
            *(f32x4*)(hr + 4 * lane + 256 * j) = v; v2u w; w.x = pk2(v[0], v[1]); w.y = pk2(v[2], v[3]); *(v2u*)(hb + 4 * lane + 256 * j) = w; }
        ss = wave_sum(ss);
        if (lane == 0) ((float*)(a.ws + WS_RS))[row] = 1.f / sqrtf(ss * (1.f / DM) + EPS);
    }
}

__device__ __forceinline__ void norm_res_phase(const Args& a, const float* gain, float coef, bool ksplit, int G, int bid, int tid) {
    const int wave = __builtin_amdgcn_readfirstlane(tid >> 6), lane = tid & 63;
    const int gw = bid * 8 + wave, NGW = G * 8;
    f32x4 gv[8];
#pragma unroll
    for (int j = 0; j < 8; ++j) gv[j] = *(const f32x4*)(gain + 4 * lane + 256 * j) * coef;
    for (int row = gw; row < MT; row += NGW) {
        const float* ar = (const float*)(a.ws + WS_A) + (size_t)row * DM; float* hr = a.out + O_Y + (size_t)row * DM; bf16* hb = (bf16*)(a.ws + WS_HB) + (size_t)row * DM;
        f32x4 av[8], hv[8]; float ss = 0.f;
        if (ksplit && row >= MP) {
            const float* pr = (const float*)(a.ws + WS_PART) + (size_t)(row - MP) * DM;
#pragma unroll
            for (int j = 0; j < 8; ++j) { f32x4 s = *(const f32x4*)(pr + 4 * lane + 256 * j);
#pragma unroll
                for (int q = 1; q < 8; ++q) s += *(const f32x4*)(pr + (size_t)q * MS * DM + 4 * lane + 256 * j);
                av[j] = s; }
        } else {
#pragma unroll
            for (int j = 0; j < 8; ++j) av[j] = *(const f32x4*)(ar + 4 * lane + 256 * j);
        }
#pragma unroll
        for (int j = 0; j < 8; ++j) { hv[j] = *(const f32x4*)(hr + 4 * lane + 256 * j);
            ss += (av[j][0] * av[j][0] + av[j][1] * av[j][1]) + (av[j][2] * av[j][2] + av[j][3] * av[j][3]); }
        ss = wave_sum(ss);
        const float ra = 1.f / sqrtf(ss * (1.f / DM) + EPS);
        float s2 = 0.f;
#pragma unroll
        for (int j = 0; j < 8; ++j) { const f32x4 v = hv[j] + av[j] * gv[j] * ra; s2 += (v[0] * v[0] + v[1] * v[1]) + (v[2] * v[2] + v[3] * v[3]);
            *(f32x4*)(hr + 4 * lane + 256 * j) = v; v2u w; w.x = pk2(v[0], v[1]); w.y = pk2(v[2], v[3]); *(v2u*)(hb + 4 * lane + 256 * j) = w; }
        s2 = wave_sum(s2);
        if (lane == 0) ((float*)(a.ws + WS_RS))[row] = 1.f / sqrtf(s2 * (1.f / DM) + EPS);
    }
}

__device__ __forceinline__ void hgrn_sample_item(const Args& a, int l, int item, LAS unsigned char* lds, int tid) {
    const int h = item & 7, b = item >> 3, kq = tid >> 5, v4 = tid & 31;
    LAS float* red = (LAS float*)lds;
    const float* s0 = a.in[4] + ((size_t)((l * DB + b) * HH + h) * HK + kq * 8) * HV + 4 * v4;
    float* s1 = a.out + O_HS + ((size_t)((l * DB + b) * HH + h) * HK + kq * 8) * HV + 4 * v4;
    f32x4 S[8];
#pragma unroll
    for (int i = 0; i < 8; ++i) S[i] = *(const f32x4*)(s0 + (size_t)i * HV);
    const float* zb = (const float*)(a.ws + WS_Z) + (size_t)(MP + b * DSQ) * INW + h * HK;
#pragma unroll
    for (int t = 0; t < DSQ; ++t) {
        const float* zr = zb + (size_t)t * INW;
        const f32x4 q0 = *(const f32x4*)(zr + 1024 + kq * 8), q1 = *(const f32x4*)(zr + 1024 + kq * 8 + 4);
        const f32x4 f0 = *(const f32x4*)(zr + 2048 + kq * 8), f1 = *(const f32x4*)(zr + 2048 + kq * 8 + 4);
        const f32x4 vv = *(const f32x4*)(zr + 3072 + 4 * v4);
        f32x4 acc = (f32x4){0.f, 0.f, 0.f, 0.f};
#pragma unroll
        for (int i = 0; i < 8; ++i) { const float f = i < 4 ? f0[i & 3] : f1[i & 3], q = i < 4 ? q0[i & 3] : q1[i & 3]; S[i] = S[i] * f + vv * (1.f - f); acc += S[i] * q; }
        *(LAS f32x4*)(red + (t * 16 + kq) * 128 + 4 * v4) = acc;
    }
#pragma unroll
    for (int i = 0; i < 8; ++i) *(f32x4*)(s1 + (size_t)i * HV) = S[i];
    __syncthreads();
#pragma unroll
    for (int e = 0; e < 2; ++e) { const int idx = tid + 512 * e, t = idx >> 7, v = idx & 127; float s = 0.f;
#pragma unroll
        for (int k = 0; k < 16; ++k) s += red[(t * 16 + k) * 128 + v];
        ((float*)(a.ws + WS_O))[(size_t)(MP + b * DSQ + t) * HW + h * HV + v] = s; }
    __syncthreads();
}
__device__ __forceinline__ void hgrn_post_item(const Args& a, int l, int item, int lane) {
    const int h = item & 7, row = item >> 3;
    const f32x2 o = *(const f32x2*)((const float*)(a.ws + WS_O) + (size_t)row * HW + h * HV + 2 * lane);
    const float ss = wave_sum(o[0] * o[0] + o[1] * o[1]);
    const float r = 1.f / sqrtf(ss * (1.f / HV) + EPS);
    const f32x2 gg = *(const f32x2*)((const float*)(a.ws + WS_Z) + (size_t)row * INW + 4096 + h * HV + 2 * lane);
    const f32x2 gn = *(const f32x2*)(a.in[26] + (size_t)l * HW + h * HV + 2 * lane);
    *(unsigned*)((bf16*)(a.ws + WS_CAT) + (size_t)row * DM + 1024 + h * HV + 2 * lane) = pk2(o[0] * r * gn[0] * silu(gg[0]), o[1] * r * gn[1] * silu(gg[1]));
}

typedef short bf16x8_t __attribute__((ext_vector_type(8)));
constexpr int GC = 64, GNCH = SEQ / GC, GITEMS = NB * HH * GNCH;
constexpr int KS = 272, TS = 144;
constexpr int L_SUM = 0, L_VT = 2048, L_KD = L_VT + 128 * TS;
constexpr int L_Q = L_VT + 128 * TS, L_QR = L_Q + 64 * KS, L_KT = L_QR + 64 * KS, L_ATT = L_KT + 10 * 16 * KS, L_SSQ = L_ATT + 64 * TS, L_RR = L_SSQ + 64 * 8 * 4, L_GEND = L_RR + 256;
static_assert(L_GEND <= RING_BYTES, "GLA LDS map");
constexpr size_t WS_SLOC = WS_END, WS_SIN = WS_SLOC + 64 * MiB, WS_DEC = WS_SIN + 32 * MiB, WS_END2 = WS_DEC + 1 * MiB;

__device__ __forceinline__ v4u pack8(const float (&x)[16], int o) { v4u w; w.x = pk2(x[o], x[o + 1]); w.y = pk2(x[o + 2], x[o + 3]); w.z = pk2(x[o + 4], x[o + 5]); w.w = pk2(x[o + 6], x[o + 7]); return w; }

__device__ __forceinline__ void gla_a_item(const Args& a, int item, LAS unsigned char* lds, int tid) {
    const int j = item & 31, h = (item >> 5) & 7, b = item >> 8;
    const int k = tid & 127, ti = __builtin_amdgcn_readfirstlane(tid >> 7), lane = tid & 63, w = __builtin_amdgcn_readfirstlane(tid >> 6);
    const float* zr = (const float*)(a.ws + WS_Z) + (size_t)(b * SEQ + j * GC + ti * 16) * INW + h * HK + k;
    float fv[16], vv[16];
#pragma unroll
    for (int s = 0; s < 16; ++s) { fv[s] = zr[(size_t)s * INW + 2048]; vv[s] = zr[(size_t)s * INW + 3072]; }
    float c[16]; float run = 0.f;
#pragma unroll
    for (int s = 0; s < 16; ++s) { run += __logf(fv[s]); c[s] = run; }
    LAS float* sums = (LAS float*)(lds + L_SUM);
    sums[ti * 128 + k] = run;
    *(LAS v4u*)(lds + L_VT + k * TS + ti * 32) = pack8(vv, 0); *(LAS v4u*)(lds + L_VT + k * TS + ti * 32 + 16) = pack8(vv, 8);
    __syncthreads();
    const float s0 = sums[k], s1 = sums[128 + k], s2 = sums[256 + k], s3 = sums[384 + k];
    const float P4 = (s0 + s1) + (s2 + s3);
    const float rest = ti == 0 ? (s1 + s2 + s3) : ti == 1 ? (s2 + s3) : ti == 2 ? s3 : 0.f;
    float kd[16];
#pragma unroll
    for (int s = 0; s < 16; ++s) kd[s] = (1.f - fv[s]) * __expf(rest + (run - c[s]));
    *(LAS v4u*)(lds + L_KD + k * TS + ti * 32) = pack8(kd, 0); *(LAS v4u*)(lds + L_KD + k * TS + ti * 32 + 16) = pack8(kd, 8);
    if (ti == 0) ((float*)(a.ws + WS_DEC))[(size_t)item * 128 + k] = __expf(P4);
    __syncthreads();
    const int r = lane & 15, g = lane >> 4;
    bf16x8_t af[2];
#pragma unroll
    for (int st = 0; st < 2; ++st) af[st] = *(const LAS bf16x8_t*)(lds + L_KD + (16 * w + r) * TS + (32 * st + 8 * g) * 2);
    float* out = (float*)(a.ws + WS_SLOC) + (size_t)item * 16384;
#pragma unroll
    for (int vt = 0; vt < 8; ++vt) {
        f32x4 acc = (f32x4){0.f, 0.f, 0.f, 0.f};
#pragma unroll
        for (int st = 0; st < 2; ++st) { const bf16x8_t bfr = *(const LAS bf16x8_t*)(lds + L_VT + (16 * vt + r) * TS + (32 * st + 8 * g) * 2);
            acc = __builtin_amdgcn_mfma_f32_16x16x32_bf16(af[st], bfr, acc, 0, 0, 0); }
        *(f32x4*)(out + (size_t)(16 * vt + r) * 128 + 16 * w + 4 * g) = acc;
    }
    __syncthreads();
}

__device__ __forceinline__ void gla_b_phase(const Args& a, int l, int G, int bid, int tid) {
    for (int gid = bid * 512 + tid; gid < NB * HH * 4096; gid += G * 512) {
        const int bh = gid >> 12, rem = gid & 4095, v = rem >> 5, k4 = (rem & 31) * 4;
        f32x4 S = (f32x4){0.f, 0.f, 0.f, 0.f};
        const float* sl = (const float*)(a.ws + WS_SLOC) + (size_t)(bh * GNCH) * 16384 + v * 128 + k4;
        const float* dc = (const float*)(a.ws + WS_DEC) + (size_t)(bh * GNCH) * 128 + k4;
        bf16* si = (bf16*)(a.ws + WS_SIN) + (size_t)(bh * GNCH) * 16384 + v * 128 + k4;
#pragma unroll 8
        for (int j = 0; j < GNCH; ++j) {
            v2u wv; wv.x = pk2(S[0], S[1]); wv.y = pk2(S[2], S[3]); *(v2u*)(si + (size_t)j * 16384) = wv;
            const f32x4 x = *(const f32x4*)(sl + (size_t)j * 16384), d = *(const f32x4*)(dc + (size_t)j * 128);
            S = d * S + x;
        }
        float* sp = a.out + O_HP + ((size_t)(l * NB * HH + bh) * HK + k4) * HV + v;
#pragma unroll
        for (int i = 0; i < 4; ++i) sp[(size_t)i * HV] = S[i];
    }
}

__device__ __forceinline__ void gla_c_item(const Args& a, int l, int item, LAS unsigned char* lds, int tid) {
    const int j = item & 31, h = (item >> 5) & 7, b = item >> 8;
    const int k = tid & 127, ti = __builtin_amdgcn_readfirstlane(tid >> 7), lane = tid & 63, w = __builtin_amdgcn_readfirstlane(tid >> 6);
    const int r = lane & 15, g = lane >> 4;
    const int row0 = b * SEQ + j * GC;
    const float* zr = (const float*)(a.ws + WS_Z) + (size_t)(row0 + ti * 16) * INW + h * HK + k;
    float fv[16], vv[16], qv[16];
#pragma unroll
    for (int s = 0; s < 16; ++s) { fv[s] = zr[(size_t)s * INW + 2048]; vv[s] = zr[(size_t)s * INW + 3072]; qv[s] = zr[(size_t)s * INW + 1024]; }
    bf16x8_t sfr[4];
    { const bf16* si = (const bf16*)(a.ws + WS_SIN) + (size_t)item * 16384 + (size_t)(16 * w + r) * 128 + 8 * g;
#pragma unroll
      for (int st = 0; st < 4; ++st) sfr[st] = *(const bf16x8_t*)(si + 32 * st); }
    float gz[16];
    { const float* zg = (const float*)(a.ws + WS_Z) + (size_t)row0 * INW + 4096 + h * HV + 16 * w + r;
#pragma unroll
      for (int tt = 0; tt < 4; ++tt)
#pragma unroll
        for (int i = 0; i < 4; ++i) gz[tt * 4 + i] = zg[(size_t)(16 * tt + 4 * g + i) * INW]; }
    const float gn = a.in[26][(size_t)l * HW + h * HV + 16 * w + r];
    float c[16]; float run = 0.f;
#pragma unroll
    for (int s = 0; s < 16; ++s) { run += __logf(fv[s]); c[s] = run; }
    LAS float* sums = (LAS float*)(lds + L_SUM);
    sums[ti * 128 + k] = run;
    *(LAS v4u*)(lds + L_VT + k * TS + ti * 32) = pack8(vv, 0); *(LAS v4u*)(lds + L_VT + k * TS + ti * 32 + 16) = pack8(vv, 8);
    { LAS unsigned* az = (LAS unsigned*)(lds + L_ATT); for (int i = tid; i < 64 * TS / 4; i += 512) az[i] = 0u; }
    __syncthreads();
    const float s0 = sums[k], s1 = sums[128 + k], s2 = sums[256 + k];
    const float myP = ti == 0 ? 0.f : ti == 1 ? s0 : ti == 2 ? (s0 + s1) : (s0 + s1 + s2);
#pragma unroll
    for (int s = 0; s < 16; ++s) {
        const int t = 16 * ti + s;
        *(LAS bf16*)(lds + L_Q + t * KS + k * 2) = (bf16)f2bf(qv[s] * __expf(myP + c[s]));
        *(LAS bf16*)(lds + L_QR + t * KS + k * 2) = (bf16)f2bf(qv[s] * __expf(c[s]));
    }
#pragma unroll
    for (int tp = 0; tp < 4; ++tp) {
        if (tp >= ti) {
            const float dP = (tp == ti) ? 0.f : (tp == ti + 1) ? (ti == 0 ? s0 : ti == 1 ? s1 : s2) : (tp == ti + 2) ? (ti == 0 ? (s0 + s1) : (s1 + s2)) : (s0 + s1 + s2);
            LAS unsigned char* kt = lds + L_KT + (tp * (tp + 1) / 2 + ti) * (16 * KS);
#pragma unroll
            for (int s = 0; s < 16; ++s) *(LAS bf16*)(kt + s * KS + k * 2) = (bf16)f2bf((1.f - fv[s]) * __expf(fminf(dP - c[s], 60.f)));
        }
    }
    __syncthreads();
#pragma unroll
    for (int rep = 0; rep < 2; ++rep) {
        const int q = w + 8 * rep;
        if (q < 10) {
            const int tq = q < 1 ? 0 : q < 3 ? 1 : q < 6 ? 2 : 3, sj = q - tq * (tq + 1) / 2;
            f32x4 acc = (f32x4){0.f, 0.f, 0.f, 0.f};
#pragma unroll
            for (int st = 0; st < 4; ++st) {
                const bf16x8_t af = *(const LAS bf16x8_t*)(lds + L_QR + (16 * tq + r) * KS + (32 * st + 8 * g) * 2);
                const bf16x8_t bfr = *(const LAS bf16x8_t*)(lds + L_KT + q * (16 * KS) + r * KS + (32 * st + 8 * g) * 2);
                acc = __builtin_amdgcn_mfma_f32_16x16x32_bf16(af, bfr, acc, 0, 0, 0);
            }
#pragma unroll
            for (int i = 0; i < 4; ++i) { const int t = 16 * tq + 4 * g + i, s = 16 * sj + r; *(LAS bf16*)(lds + L_ATT + t * TS + s * 2) = (bf16)f2bf(s <= t ? acc[i] : 0.f); }
        }
    }
    __syncthreads();
    f32x4 o[4];
#pragma unroll
    for (int tt = 0; tt < 4; ++tt) {
        f32x4 acc = (f32x4){0.f, 0.f, 0.f, 0.f};
#pragma unroll
        for (int st = 0; st < 4; ++st) { const bf16x8_t af = *(const LAS bf16x8_t*)(lds + L_Q + (16 * tt + r) * KS + (32 * st + 8 * g) * 2);
            acc = __builtin_amdgcn_mfma_f32_16x16x32_bf16(af, sfr[st], acc, 0, 0, 0); }
#pragma unroll
        for (int st = 0; st < 2; ++st) if (st == 0 || tt >= 2) {
            const bf16x8_t af = *(const LAS bf16x8_t*)(lds + L_ATT + (16 * tt + r) * TS + (32 * st + 8 * g) * 2);
            const bf16x8_t bfr = *(const LAS bf16x8_t*)(lds + L_VT + (16 * w + r) * TS + (32 * st + 8 * g) * 2);
            acc = __builtin_amdgcn_mfma_f32_16x16x32_bf16(af, bfr, acc, 0, 0, 0); }
        o[tt] = acc;
    }
    LAS float* ssq = (LAS float*)(lds + L_SSQ); LAS float* rr = (LAS float*)(lds + L_RR);
#pragma unroll
    for (int tt = 0; tt < 4; ++tt)
#pragma unroll
        for (int i = 0; i < 4; ++i) { float p = o[tt][i] * o[tt][i]; p += __shfl_xor(p, 1); p += __shfl_xor(p, 2); p += __shfl_xor(p, 4); p += __shfl_xor(p, 8);
            if (r == 0) ssq[(16 * tt + 4 * g + i) * 8 + w] = p; }
    __syncthreads();
    if (tid < 64) { float s = 0.f;
#pragma unroll
        for (int x = 0; x < 8; ++x) s += ssq[tid * 8 + x];
        rr[tid] = 1.f / sqrtf(s * (1.f / HV) + EPS); }
    __syncthreads();
    bf16* cp = (bf16*)(a.ws + WS_CAT) + (size_t)row0 * DM + 1024 + h * HV + 16 * w + r;
#pragma unroll
    for (int tt = 0; tt < 4; ++tt)
#pragma unroll
        for (int i = 0; i < 4; ++i) { const int t = 16 * tt + 4 * g + i; cp[(size_t)t * DM] = (bf16)f2bf(o[tt][i] * rr[t] * gn * silu(gz[tt * 4 + i])); }
    __syncthreads();
}
constexpr int S5ITEMS = S5G * 40, S5IPG = 40;
constexpr size_t WS_S5K = WS_END2, WS_S5P = WS_S5K + 2 * MiB, WS_S5Q = WS_S5P + 16 * MiB, WS_S5A = WS_S5Q + 16 * MiB, WS_S5T = WS_S5A + 1 * MiB, WS_END3 = WS_S5T + 1 * MiB;
constexpr int L5_K = 0, L5_U = 8192, L5_XL = 16384, L5_XIN = L5_XL + 128 * 17 * 4, L5_END = L5_XIN + 16 * 272;
constexpr int LP_AP = 0, LP_BB = LP_AP + 17 * 64 * 8, LP_C = LP_BB + 64 * 16 * 8, LP_END = LP_C + 16 * 64 * 8;

__device__ __forceinline__ f32x2 cmul(f32x2 x, f32x2 y) { return (f32x2){x[0] * y[0] - x[1] * y[1], x[0] * y[1] + x[1] * y[0]}; }

__device__ __forceinline__ void s5_tables_item(const Args& a, int lg, LAS unsigned char* lds, int tid) {
    LAS f32x2* ap = (LAS f32x2*)(lds + LP_AP); LAS f32x2* bbl = (LAS f32x2*)(lds + LP_BB); LAS f32x2* cl = (LAS f32x2*)(lds + LP_C);
    const float dt = expf(a.in[17][lg]);
#pragma unroll 1
    for (int idx = tid; idx < 17 * 64; idx += 512) { const int tau = idx >> 6, n = idx & 63; const float lr = a.in[15][lg * 64 + n], li = a.in[16][lg * 64 + n];
        const float mag = expf(lr * dt * (float)tau), ang = li * dt * (float)tau; ap[idx] = (f32x2){mag * cosf(ang), mag * sinf(ang)}; }
#pragma unroll 1
    for (int idx = tid; idx < 64 * 16; idx += 512) { const int n = idx >> 4; const float lr = a.in[15][lg * 64 + n], li = a.in[16][lg * 64 + n];
        const float mag = expf(lr * dt), ang = li * dt; const float are = mag * cosf(ang), aim = mag * sinf(ang);
        const float p = are - 1.f, q = aim, den = lr * lr + li * li; const float zre = (p * lr + q * li) / den, zim = (q * lr - p * li) / den;
        const float br = a.in[18][(size_t)lg * 1024 + idx], bi = a.in[19][(size_t)lg * 1024 + idx];
        bbl[idx] = (f32x2){zre * br - zim * bi, zre * bi + zim * br};
        cl[idx] = (f32x2){a.in[20][(size_t)lg * 1024 + idx], a.in[21][(size_t)lg * 1024 + idx]}; }
    if (tid < 64) { const float lr = a.in[15][lg * 64 + tid], li = a.in[16][lg * 64 + tid];
        const float m16 = expf(lr * dt * 16.f), g16 = li * dt * 16.f, m8 = expf(-lr * dt * 8.f), g8 = -li * dt * 8.f;
        f32x2* A = (f32x2*)(a.ws + WS_S5A); A[lg * 64 + tid] = (f32x2){m16 * cosf(g16), m16 * sinf(g16)}; A[16384 + lg * 64 + tid] = (f32x2){m8 * cosf(g8), m8 * sinf(g8)}; }
    __syncthreads();
    bf16* Kt = (bf16*)(a.ws + WS_S5K) + (size_t)lg * 4096; bf16* Pt = (bf16*)(a.ws + WS_S5P) + (size_t)lg * 32768; bf16* Qt = (bf16*)(a.ws + WS_S5Q) + (size_t)lg * 32768;
#pragma unroll 1
    for (int idx = tid; idx < 4096; idx += 512) { const int tau = idx >> 8, c = (idx >> 4) & 15, cp = idx & 15; float s = 0.f;
#pragma unroll 4
        for (int n = 0; n < 64; ++n) { const f32x2 w = cmul(ap[tau * 64 + n], bbl[n * 16 + cp]); const f32x2 cc = cl[c * 64 + n]; s += cc[0] * w[0] - cc[1] * w[1]; }
        Kt[idx] = (bf16)f2bf(s); }
#pragma unroll 2
    for (int idx = tid; idx < 32768; idx += 512) { const int row = idx >> 7, np = idx & 127, k = row >> 4, c = row & 15, n = np & 63;
        const f32x2 A = ap[(k + 1) * 64 + n], cc = cl[c * 64 + n];
        Pt[idx] = (bf16)f2bf(np < 64 ? (cc[0] * A[0] - cc[1] * A[1]) : -(cc[0] * A[1] + cc[1] * A[0])); }
#pragma unroll 2
    for (int idx = tid; idx < 32768; idx += 512) { const int np = idx >> 8, col = idx & 255, s = col >> 4, cp = col & 15, n = np & 63;
        const f32x2 w = cmul(ap[(15 - s) * 64 + n], bbl[n * 16 + cp]);
        Qt[idx] = (bf16)f2bf(np < 64 ? w[0] : w[1]); }
    __syncthreads();
}

struct S5Ctx { int g; };

template <int PASS>
__device__ __forceinline__ void s5_item(const Args& a, int l, int item, S5Ctx& cx, LAS unsigned char* lds, int tid) {
    const int lane = tid & 63, w = __builtin_amdgcn_readfirstlane(tid >> 6), r = lane & 15, g8 = lane >> 4;
    const int g = item / S5IPG, idx = item - g * S5IPG; const bool sample = idx >= 32;
    if (PASS == 1 && sample) return;
    const int lg = l * S5G + g;
    if (g != cx.g) {
        cx.g = g;
        __syncthreads();
        { const v4u* src = (const v4u*)((const bf16*)(a.ws + WS_S5K) + (size_t)lg * 4096); ((LAS v4u*)(lds + L5_K))[tid] = src[tid]; }
        __syncthreads();
    }
    bf16x8_t qf[8];
    { const bf16* Qt = (const bf16*)(a.ws + WS_S5Q) + (size_t)lg * 32768 + (size_t)(16 * w + r) * 256 + 8 * g8;
#pragma unroll
      for (int st = 0; st < 8; ++st) qf[st] = *(const bf16x8_t*)(Qt + 32 * st); }
    const int b = idx >> 3, tile = idx & 7;
    const int stile = idx - 32;
    const float* Z = (const float*)(a.ws + WS_Z);
    {
        const int s = 2 * w + (g8 >> 1);
        v4u fr = (v4u){0u, 0u, 0u, 0u};
        if (!sample || s >= 8) {
            const size_t row = sample ? (size_t)(MP + (stile * 16 + r) * DSQ + (s - 8)) : (size_t)(b * SEQ + tile * 256 + r * 16 + s);
            const f32x4 u0 = *(const f32x4*)(Z + row * INW + 16 * g + 8 * (g8 & 1)), u1 = *(const f32x4*)(Z + row * INW + 16 * g + 8 * (g8 & 1) + 4);
            fr.x = pk2(u0[0], u0[1]); fr.y = pk2(u0[2], u0[3]); fr.z = pk2(u1[0], u1[1]); fr.w = pk2(u1[2], u1[3]);
        }
        ((LAS v4u*)(lds + L5_U))[w * 64 + lane] = fr;
    }
    __syncthreads();
    bf16x8_t uf[8];
#pragma unroll
    for (int st = 0; st < 8; ++st) uf[st] = ((const LAS bf16x8_t*)(lds + L5_U))[st * 64 + lane];
    {
        f32x4 acc = (f32x4){0.f, 0.f, 0.f, 0.f};
#pragma unroll
        for (int st = 0; st < 8; ++st) acc = __builtin_amdgcn_mfma_f32_16x16x32_bf16(qf[st], uf[st], acc, 0, 0, 0);
        LAS float* XL = (LAS float*)(lds + L5_XL);
#pragma unroll
        for (int i = 0; i < 4; ++i) XL[(16 * w + 4 * g8 + i) * 17 + r] = acc[i];
    }
    __syncthreads();
    if (w == 0) {
        const LAS float* XL = (const LAS float*)(lds + L5_XL);
        const f32x2 a16 = ((const f32x2*)(a.ws + WS_S5A))[lg * 64 + lane];
        if (!sample) {
            f32x2 X = (f32x2){0.f, 0.f};
            f32x2* E = (f32x2*)(a.ws + WS_S5T) + (size_t)((b * S5G + g) * 8) * 64 + lane;
            if (PASS == 2) { f32x2 a256 = a16;
#pragma unroll
                for (int q = 0; q < 4; ++q) a256 = cmul(a256, a256);
                for (int tt = 0; tt < tile; ++tt) { const f32x2 e = E[tt * 64]; X = cmul(a256, X) + e; } }
#pragma unroll
            for (int c = 0; c < 16; ++c) {
                if (PASS == 2) { *(LAS bf16*)(lds + L5_XIN + c * 272 + lane * 2) = (bf16)f2bf(X[0]); *(LAS bf16*)(lds + L5_XIN + c * 272 + (64 + lane) * 2) = (bf16)f2bf(X[1]); }
                X = cmul(a16, X) + (f32x2){XL[lane * 17 + c], XL[(64 + lane) * 17 + c]};
            }
            if (PASS == 1) E[tile * 64] = X;
            else if (tile == 7) { const size_t so = (size_t)((l * NB + b) * S5G + g) * S5N + lane; a.out[O_REP + so] = X[0]; a.out[O_IMP + so] = X[1]; }
        } else if (PASS == 2) {
            const f32x2 am8 = ((const f32x2*)(a.ws + WS_S5A))[16384 + lg * 64 + lane];
#pragma unroll
            for (int c = 0; c < 16; ++c) {
                const size_t si = (size_t)((l * DB + stile * 16 + c) * S5G + g) * S5N + lane;
                const f32x2 xv = cmul(am8, (f32x2){a.in[2][si], a.in[3][si]});
                *(LAS bf16*)(lds + L5_XIN + c * 272 + lane * 2) = (bf16)f2bf(xv[0]); *(LAS bf16*)(lds + L5_XIN + c * 272 + (64 + lane) * 2) = (bf16)f2bf(xv[1]);
                const f32x2 xo = cmul(a16, xv) + (f32x2){XL[lane * 17 + c], XL[(64 + lane) * 17 + c]};
                a.out[O_RES + si] = xo[0]; a.out[O_IMS + si] = xo[1];
            }
        }
    }
    if (PASS == 2) {
        __syncthreads();
        bf16x8_t xf[4];
#pragma unroll
        for (int st = 0; st < 4; ++st) xf[st] = *(const LAS bf16x8_t*)(lds + L5_XIN + r * 272 + (32 * st + 8 * g8) * 2);
        const f32x4 dv = *(const f32x4*)(a.in[22] + (size_t)l * S5W + 16 * g + 4 * g8);
#pragma unroll
        for (int x = 0; x < 2; ++x) {
            const int k = x ? 15 - w : w;
            if (!sample || k >= 8) {
                f32x4 acc = (f32x4){0.f, 0.f, 0.f, 0.f};
                const int nst = (k >> 1) + 1;
#pragma unroll
                for (int st = 0; st < 8; ++st) if (st < nst) {
                    const int tau = k - 2 * st - (g8 >> 1);
                    bf16x8_t kf = (bf16x8_t){0, 0, 0, 0, 0, 0, 0, 0};
                    if (tau >= 0) kf = *(const LAS bf16x8_t*)(lds + L5_K + tau * 512 + r * 32 + (g8 & 1) * 16);
                    acc = __builtin_amdgcn_mfma_f32_16x16x32_bf16(kf, uf[st], acc, 0, 0, 0);
                }
                { const bf16* Pt = (const bf16*)(a.ws + WS_S5P) + (size_t)lg * 32768 + (size_t)(16 * k + r) * 128 + 8 * g8;
#pragma unroll
                  for (int st = 0; st < 4; ++st) { const bf16x8_t pf = *(const bf16x8_t*)(Pt + 32 * st); acc = __builtin_amdgcn_mfma_f32_16x16x32_bf16(pf, xf[st], acc, 0, 0, 0); } }
                const size_t row = sample ? (size_t)(MP + (stile * 16 + r) * DSQ + (k - 8)) : (size_t)(b * SEQ + tile * 256 + r * 16 + k);
                const f32x4 uu = *(const f32x4*)(Z + row * INW + 16 * g + 4 * g8);
                v2u o; o.x = pk2(gelu_tanh(acc[0] + dv[0] * uu[0]), gelu_tanh(acc[1] + dv[1] * uu[1])); o.y = pk2(gelu_tanh(acc[2] + dv[2] * uu[2]), gelu_tanh(acc[3] + dv[3] * uu[3]));
                *(v2u*)((bf16*)(a.ws + WS_YSG) + row * S5W + 16 * g + 4 * g8) = o;
            }
        }
    }
    __syncthreads();
}

constexpr int PH_PER_LAYER = 13, N_PHASES = 1 + DEPTH * PH_PER_LAYER;
#ifndef PROBE_DUP
#define PROBE_DUP 0
#endif
#ifndef KSPLIT_FROM
#define KSPLIT_FROM 2
#endif
#ifndef MK_PER_PHASE
#define MK_PER_PHASE 0
#endif

__global__ void __launch_bounds__(512, 2) mega(Args args) {
    extern __shared__ __attribute__((aligned(16))) unsigned char lds_raw[];
    LAS unsigned char* lds = (LAS unsigned char*)lds_raw;
    const int tid = threadIdx.x, lane = tid & 63, wave = __builtin_amdgcn_readfirstlane(tid >> 6);
    const int G = gridDim.x, bid = blockIdx.x;
    volatile LAS unsigned* MISC = (volatile LAS unsigned*)(lds + LDSCTL_OFF);
    if (tid < 64) MISC[tid] = 0u;
    __syncthreads();
    const int lo = args.ph_lo, hi = args.ph_hi;
    XcdBarrier bar; bar.bar = (unsigned*)(args.ws + WS_CTL) + 4096; bar.x = 0; bar.st = nullptr;
    if (hi - lo > 1) bar = xcd_barrier_post((unsigned*)(args.ws + WS_CTL) + 4096, MISC + 8);
#define IN(k) (lo <= (k) && (k) < hi)
#define CONVQ(q, b, e) do { if (l < 2) { int tq_ = tid; asm volatile("" : "+v"(tq_)); convert_queue(args, (unsigned*)(args.ws + WS_CTL) + CW_Q + 64 * (q), (b), (e), lds, tq_); } } while (0)
#define TIDL() int tidl = tid; asm volatile("" : "+v"(tidl)); const int lanel = tidl & 63, wavel = __builtin_amdgcn_readfirstlane(tidl >> 6); (void)lanel; (void)wavel
#define SEAM(k) do { if (IN((k) + 1)) xcd_barrier(bar); } while (0)

    if (IN(0)) { for (int rep = 0; rep < ((PROBE_DUP & 16) ? 2 : 1); ++rep) { TIDL(); p0_prologue(args, lds, G, bid, tidl); } SEAM(0); }

    for (int l = 0; l < DEPTH; ++l) {
        const int pb = 1 + l * PH_PER_LAYER;
        unsigned char* wl = args.ws + WS_W + (size_t)l * LW_END;
        const bf16* HB = (const bf16*)(args.ws + WS_HB); bf16* HID = (bf16*)(args.ws + WS_HID); float* A = (float*)(args.ws + WS_A); float* Z = (float*)(args.ws + WS_Z);
        const float* RS = (const float*)(args.ws + WS_RS);
        const bool ksplit = (l >= KSPLIT_FROM) && (G == 256);
#define FFN_PHASES(f) do { const int p0 = pb + ((f) ? 10 : 0); \
            if (IN(p0)) { pg8::Gemm g{HB, (const bf16*)(wl + ((f) ? LW_GU2 : LW_GU1)), MT, 2 * FF, DM}; pg8::StaticOrder S; S.init(MT, 2 * FF, DM, G, bid); \
                EpiGU E{HID, RS}; pg8::gemm_phase<EpiGU, pg8::StaticOrder, true, true>(lds, g, S, E); \
                if (f) CONVQ(1 + 5 * l + 3, (2 * l + 1) * I_L + OI_D1, (2 * l + 1) * I_L + OI_GU2); else CONVQ(1 + 5 * l + 0, 2 * l * I_L + OI_D1, 2 * l * I_L + OI_IN); SEAM(p0); } \
            if (IN(p0 + 1)) { pg8::Gemm g{HID, (const bf16*)(wl + ((f) ? LW_D2 : LW_D1)), MT, DM, FF}; MixOrder S; S.split = ksplit; S.so.init(MT, DM, FF, G, bid); S.sp.init(FF, bid); \
                EpiF32 E{A, DM, (float*)(args.ws + WS_PART)}; pg8::gemm_phase<EpiF32, MixOrder, true, true>(lds, g, S, E); \
                if (f) CONVQ(1 + 5 * l + 4, (2 * l + 1) * I_L + OI_GU2, (2 * l + 2) * I_L + (l == 0 ? OI_D1 : 0)); else CONVQ(1 + 5 * l + 1, 2 * l * I_L + OI_IN, (2 * l + 1) * I_L); SEAM(p0 + 1); } \
            if (IN(p0 + 2)) { TIDL(); norm_res_phase(args, args.in[6] + (size_t)(l * 3 + ((f) ? 2 : 0)) * DM, 0.5f, ksplit, G, bid, tidl); SEAM(p0 + 2); } } while (0)
        FFN_PHASES(0);
        if (IN(pb + 3)) { pg8::Gemm g{HB, (const bf16*)(wl + LW_IN), MT, INW, DM}; pg8::StaticOrder S; S.init(MT, INW, DM, G, bid);
            EpiWin E{Z, RS, (const float*)(args.ws + WS_LB) + (size_t)l * HW}; pg8::gemm_phase<EpiWin, pg8::StaticOrder, true, true>(lds, g, S, E); SEAM(pb + 3); }
        if (IN(pb + 4)) {
            for (int rep = 0; rep < ((PROBE_DUP & 1) ? 2 : 1); ++rep) {
            TIDL();
            for (int it = bid; it < GITEMS; it += G) gla_a_item(args, it, lds, tidl);
            for (int it = bid; it < DB * HH; it += G) hgrn_sample_item(args, l, it, lds, tidl);
            { S5Ctx cx; cx.g = -1; const int ipb = (S5ITEMS + G - 1) / G; const int i1 = (bid + 1) * ipb < S5ITEMS ? (bid + 1) * ipb : S5ITEMS;
              for (int it = bid * ipb; it < i1; ++it) s5_item<1>(args, l, it, cx, lds, tidl); }
            }
            SEAM(pb + 4); }
        if (IN(pb + 5)) { TIDL(); gla_b_phase(args, l, G, bid, tidl); SEAM(pb + 5); }
        if (IN(pb + 6)) {
            for (int rep = 0; rep < ((PROBE_DUP & 2) ? 2 : 1); ++rep) {
            TIDL(); const int npost = MS * HH;
            for (int it = bid; it < GITEMS; it += G) gla_c_item(args, l, it, lds, tidl);
            { S5Ctx cx; cx.g = -1; const int ipb = (S5ITEMS + G - 1) / G; const int i1 = (bid + 1) * ipb < S5ITEMS ? (bid + 1) * ipb : S5ITEMS;
              for (int it = bid * ipb; it < i1; ++it) s5_item<2>(args, l, it, cx, lds, tidl); }
            for (int it = bid * 8 + wavel; it < npost; it += G * 8) hgrn_post_item(args, l, it + MP * HH, lanel);
            }
            SEAM(pb + 6); }
        if (IN(pb + 7)) { pg8::Gemm g{(const bf16*)(args.ws + WS_YSG), (const bf16*)(wl + LW_GLU), MT, S5W, S5W}; pg8::StaticOrder S; S.init(MT, S5W, S5W, G, bid);
            EpiGlu E{(bf16*)(args.ws + WS_CAT), (const bf16*)(args.ws + WS_YSG), args.in[24] + (size_t)l * S5W}; pg8::gemm_phase<EpiGlu, pg8::StaticOrder, true, true>(lds, g, S, E); SEAM(pb + 7); }
        if (IN(pb + 8)) { pg8::Gemm g{(const bf16*)(args.ws + WS_CAT), (const bf16*)(wl + LW_OUT), MT, DM, DM}; MixOrder S; S.split = ksplit; S.so.init(MT, DM, DM, G, bid); S.sp.init(DM, bid);
            EpiF32 E{A, DM, (float*)(args.ws + WS_PART)}; pg8::gemm_phase<EpiF32, MixOrder, true, true>(lds, g, S, E); CONVQ(1 + 5 * l + 2, (2 * l + 1) * I_L, (2 * l + 1) * I_L + OI_D1); SEAM(pb + 8); }
        if (IN(pb + 9)) { TIDL(); norm_res_phase(args, args.in[6] + (size_t)(l * 3 + 1) * DM, 1.0f, ksplit, G, bid, tidl); SEAM(pb + 9); }
        FFN_PHASES(1);
    }
#undef IN
#undef SEAM
}

extern "C" void kernel_launch(void* const* d_in, const int* in_sizes, int n_in, void* d_out, int out_size, void* d_ws, size_t ws_size, hipStream_t stream) {
    static int grid = 0;
    if (grid == 0) {
        if (n_in != 27 || out_size != (int)O_END || ws_size < WS_END3) { fprintf(stderr, "kernel_launch: unexpected shapes: n_in %d out %d ws %zu (need %zu)\n", n_in, out_size, ws_size, (size_t)WS_END3); grid = -1; return; }
        int dev = 0, cus = 0, per_cu = 0;
        if (hipGetDevice(&dev) != hipSuccess || hipDeviceGetAttribute(&cus, hipDeviceAttributeMultiprocessorCount, dev) != hipSuccess) { grid = -1; return; }
        if (hipFuncSetAttribute((const void*)mega, hipFuncAttributeMaxDynamicSharedMemorySize, LDS_BYTES) != hipSuccess) { fprintf(stderr, "kernel_launch: hipFuncSetAttribute failed\n"); grid = -1; return; }
        if (hipOccupancyMaxActiveBlocksPerMultiprocessor(&per_cu, (const void*)mega, 512, LDS_BYTES) != hipSuccess || per_cu < 1) fprintf(stderr, "kernel_launch: occupancy query reports %d\n", per_cu);
        (void)hipGetLastError();
        grid = cus;
    }
    if (grid < 0) return;
    (void)hipMemsetAsync((char*)d_ws + WS_CTL, 0, CTL_ZERO_BYTES, stream);
    Args a{};
    for (int i = 0; i < 27; ++i) a.in[i] = (const float*)d_in[i];
    a.out = (float*)d_out; a.ws = (unsigned char*)d_ws;
#if MK_PER_PHASE
    for (int p = 0; p < N_PHASES; ++p) { a.ph_lo = p; a.ph_hi = p + 1; hipLaunchKernelGGL(mega, dim3(grid), dim3(512), LDS_BYTES, stream, a); }
#else
    a.ph_lo = 0; a.ph_hi = N_PHASES; hipLaunchKernelGGL(mega, dim3(grid), dim3(512), LDS_BYTES, stream, a);
#endif
}
```

```cpp
#include <hip/hip_runtime.h>
#include <cstdio>
#include <cstdint>
namespace pg8 {
#define PG8_LAS __attribute__((address_space(3)))
typedef unsigned short bf16_t;
typedef short bf16x8 __attribute__((ext_vector_type(8)));
typedef float f32x4 __attribute__((ext_vector_type(4)));
typedef unsigned u32x4 __attribute__((ext_vector_type(4)));
constexpr int BM = 256, BK = 64, HALF = 128, HTB = HALF * BK * 2  , STAGE_BYTES = 8 * HTB, NXCD = 8, WGM = 8;

__host__ __device__ __forceinline__ int lds_byte(int r, int c) { const int st = (r >> 4) * 2 + (c >> 5), rr = r & 15, cc = c & 31, ob = rr * 64 + cc * 2; return st * 1024 + (ob ^ (((ob >> 9) & 1) << 5)); }
__host__ __device__ __forceinline__ void stage_rc(int b, int& R, int& C) { const int st = b / 1024, sb = b % 1024, swz = sb ^ (((sb >> 9) & 1) << 5); R = (st >> 1) * 16 + swz / 64; C = (st & 1) * 32 + (swz % 64) / 2; }
__host__ __device__ __forceinline__ int perm32(int rho) { const int n = rho >> 4, i = rho & 15; return 8 * (i >> 2) + 4 * n + (i & 3); }

struct Unit { int pm, pn, kb, nk, sp; };
struct Gemm { const bf16_t* A; const bf16_t* Bt; int M, N, K; };

struct StaticOrder {
    int nM, nN, nwg, G, c, nkt;
    __host__ __device__ void init(int M, int N, int K, int G_, int c_) { nM = M / BM; nN = N / BM; nwg = nM * nN; G = G_; c = c_; nkt = K / BK; }
    __host__ __device__ bool next(int i, Unit& u) const {
        const long L = (long)i * G + c; if (L >= nwg) return false;
        int wgid = (int)L; { const int q = nwg / NXCD, r = nwg % NXCD, xcd = wgid % NXCD, off = wgid / NXCD; wgid = (xcd < r ? xcd * (q + 1) : r * (q + 1) + (xcd - r) * q) + off; }
        const int nig = WGM * nN, gid = wgid / nig, fm = gid * WGM, gsz = (nM - fm) < WGM ? (nM - fm) : WGM;
        u.pm = fm + ((wgid % nig) % gsz); u.pn = (wgid % nig) / gsz; u.kb = 0; u.nk = nkt; u.sp = -1; return true;
    }
    __device__ __forceinline__ void a_ready(const Unit&) const {}
    __device__ __forceinline__ void done(const Unit&) const {}
};

struct SplitOrder {
    int c, nkt;
    __host__ __device__ void init(int K, int c_) { c = c_; nkt = K / BK; }
    __host__ __device__ bool next(int i, Unit& u) const {
        if (i == 0) { const int wgid = (c & 7) * 32 + (c >> 3), gid = wgid >> 6; u.pm = gid * 8 + ((wgid & 63) & 7); u.pn = (wgid & 63) >> 3; u.kb = 0; u.nk = nkt; u.sp = -1; return true; }
        if (i == 1) { const int s = c & 7, unit = c >> 3, P = nkt / 2, base = P / 8, rem = P % 8; u.pm = 32 + (unit >> 3); u.pn = unit & 7;
            u.kb = 2 * (s * base + (s < rem ? s : rem)); u.nk = 2 * (base + (s < rem ? 1 : 0)); u.sp = s; return true; }
        return false;
    }
    __device__ __forceinline__ void a_ready(const Unit&) const {}
    __device__ __forceinline__ void done(const Unit&) const {}
};

__device__ __forceinline__ unsigned cvt_pk_bf16(float lo, float hi) { unsigned r; asm volatile("v_cvt_pk_bf16_f32 %0, %1, %2" : "=v"(r) : "v"(lo), "v"(hi)); return r; }
typedef float f32x2 __attribute__((ext_vector_type(2)));
template <class Epi, class Sched, bool ALIGN_EPI = false, bool SP2 = false>
__device__ __forceinline__ void gemm_phase(PG8_LAS unsigned char* lds, const Gemm g, const Sched& S, const Epi& E) {
    int tid_l = threadIdx.x; asm volatile("" : "+v"(tid_l));
    const int tid = tid_l, wid = __builtin_amdgcn_readfirstlane(tid >> 6), lane = tid & 63, wr = wid >> 2, wc = wid & 3, fr = lane & 15, fq = lane >> 4;
    const int K = g.K;
    unsigned voffA[2], voffB[2];
#pragma unroll
    for (int i = 0; i < 2; ++i) { int R, C; stage_rc(tid * 16 + i * 8192, R, C); const int Rb = Epi::PERM ? ((R & ~31) + perm32(R & 31)) : R;
        voffA[i] = (unsigned)(R * K + C) * 2u; voffB[i] = (unsigned)(Rb * K + C) * 2u; }
    const size_t kstep = (size_t)(BK * 2);
    const size_t hstep = (size_t)HALF * K * 2;
    const size_t tstep = 2 * hstep;
    const unsigned ldsw = (unsigned)wid * 1024u;
    const int aoff = lds_byte(wr * 64 + fr, fq * 8), boff = lds_byte(wc * 32 + fr, fq * 8);
#define PG8_SA(b, h) (((b) * 2 + (h)) * HTB)
#define PG8_SB(b, h) ((4 + (b) * 2 + (h)) * HTB)
#define PG8_STAGE(bufoff, gbase, voff) do { _Pragma("unroll") for (int _i = 0; _i < 2; ++_i) \
        __builtin_amdgcn_global_load_lds((const unsigned*)((const char*)(gbase) + (voff)[_i]), (PG8_LAS unsigned*)(lds + (bufoff) + ldsw + _i * 8192), 16, 0, 0); } while (0)
#define PG8_LDA(dst, b, h) do { _Pragma("unroll") for (int m = 0; m < 4; ++m) _Pragma("unroll") for (int k = 0; k < 2; ++k) dst[m][k] = *(const PG8_LAS bf16x8*)(lds + PG8_SA(b, h) + aoff + m * 2048 + k * 1024); } while (0)
#define PG8_LDB(dst, b, h) do { _Pragma("unroll") for (int n = 0; n < 2; ++n) _Pragma("unroll") for (int k = 0; k < 2; ++k) dst[n][k] = *(const PG8_LAS bf16x8*)(lds + PG8_SB(b, h) + boff + n * 2048 + k * 1024); } while (0)
#define PG8_MMA(ai, bj, At, Bt) do { __builtin_amdgcn_s_setprio(1); _Pragma("unroll") for (int m = 0; m < 4; ++m) _Pragma("unroll") for (int n = 0; n < 2; ++n) _Pragma("unroll") for (int k = 0; k < 2; ++k) \
        acc[ai][bj][m][n] = __builtin_amdgcn_mfma_f32_16x16x32_bf16(Bt[n][k], At[m][k], acc[ai][bj][m][n], 0, 0, 0); __builtin_amdgcn_s_setprio(0); } while (0)
#define PG8_WAIT_V(n) asm volatile("s_waitcnt vmcnt(" #n ")" ::: "memory")
#define PG8_WAIT_L(n) asm volatile("s_waitcnt lgkmcnt(" #n ")" ::: "memory")
#define PG8_BAR __builtin_amdgcn_s_barrier()
#define PG8_SCHED __builtin_amdgcn_sched_barrier(0)
    Unit cur, nxt; int ui = 0;
    if (!S.next(0, cur)) return;
    f32x4 acc[2][2][4][2];
#pragma unroll
    for (int a = 0; a < 2; ++a)
#pragma unroll
        for (int b = 0; b < 2; ++b)
#pragma unroll
            for (int m = 0; m < 4; ++m)
#pragma unroll
                for (int n = 0; n < 2; ++n) acc[a][b][m][n] = (f32x4){0.f, 0.f, 0.f, 0.f};
    bf16x8 At[4][2], B0[2][2], B1[2][2];
    const char* cA = (const char*)g.A + (size_t)cur.pm * tstep + (size_t)cur.kb * kstep; const char* cB = (const char*)g.Bt + (size_t)cur.pn * tstep + (size_t)cur.kb * kstep;
    S.a_ready(cur);
    if constexpr (SP2) {
        PG8_STAGE(PG8_SB(0, 0), cB, voffB); PG8_STAGE(PG8_SB(0, 1), cB + hstep, voffB); PG8_STAGE(PG8_SA(0, 0), cA, voffA); PG8_STAGE(PG8_SA(0, 1), cA + hstep, voffA);
        if (wr == 1) PG8_BAR;
        PG8_WAIT_V(2); PG8_BAR;
        PG8_STAGE(PG8_SB(1, 0), cB + kstep, voffB); PG8_STAGE(PG8_SA(1, 0), cA + kstep, voffA); PG8_STAGE(PG8_SB(1, 1), cB + hstep + kstep, voffB);
        PG8_WAIT_V(6); PG8_BAR;
    } else {
        PG8_STAGE(PG8_SB(0, 0), cB, voffB); PG8_STAGE(PG8_SA(0, 0), cA, voffA); PG8_STAGE(PG8_SB(0, 1), cB + hstep, voffB); PG8_STAGE(PG8_SA(0, 1), cA + hstep, voffA);
        if (wr == 1) PG8_BAR;
        PG8_WAIT_V(4); PG8_BAR;
        PG8_STAGE(PG8_SB(1, 0), cB + kstep, voffB); PG8_STAGE(PG8_SA(1, 0), cA + kstep, voffA); PG8_STAGE(PG8_SB(1, 1), cB + hstep + kstep, voffB);
        PG8_WAIT_V(6); PG8_BAR;
    }
    for (;;) {
        const bool has_next = S.next(ui + 1, nxt);
        const char* nA = has_next ? (const char*)g.A + (size_t)nxt.pm * tstep + (size_t)nxt.kb * kstep : cA; const char* nB = has_next ? (const char*)g.Bt + (size_t)nxt.pn * tstep + (size_t)nxt.kb * kstep : cB;
        const int nt = cur.nk;
        for (int t = 0; t < nt; t += 2) {
            const bool last = (t == nt - 2);
            const char* a1 = cA + (size_t)(t + 1) * kstep;
            const char* a2 = last ? nA : cA + (size_t)(t + 2) * kstep; const char* b2 = last ? nB : cB + (size_t)(t + 2) * kstep;
            const char* a3 = a2 + kstep; const char* b3 = b2 + kstep;
            if (last && has_next) S.a_ready(nxt);
            if constexpr (SP2) {
            PG8_LDB(B0, 0, 0); PG8_LDB(B1, 0, 1); PG8_SCHED; PG8_LDA(At, 0, 0); PG8_STAGE(PG8_SA(1, 1), a1 + hstep, voffA);
            PG8_WAIT_V(8); PG8_WAIT_L(0); PG8_BAR; PG8_MMA(0, 0, At, B0); PG8_MMA(0, 1, At, B1); PG8_BAR; PG8_SCHED;
            PG8_LDA(At, 0, 1); PG8_STAGE(PG8_SB(0, 0), b2, voffB); PG8_STAGE(PG8_SB(0, 1), b2 + hstep, voffB); PG8_STAGE(PG8_SA(0, 0), a2, voffA);
            PG8_WAIT_V(8); PG8_WAIT_L(0); PG8_BAR; PG8_MMA(1, 0, At, B0); PG8_MMA(1, 1, At, B1); PG8_BAR; PG8_SCHED;
            PG8_LDB(B0, 1, 0); PG8_LDB(B1, 1, 1); PG8_SCHED; PG8_LDA(At, 1, 0); PG8_STAGE(PG8_SA(0, 1), a2 + hstep, voffA);
            PG8_WAIT_V(8); PG8_WAIT_L(0); PG8_BAR; PG8_MMA(0, 0, At, B0); PG8_MMA(0, 1, At, B1); PG8_BAR; PG8_SCHED;
            PG8_LDA(At, 1, 1); PG8_STAGE(PG8_SB(1, 0), b3, voffB); PG8_STAGE(PG8_SB(1, 1), b3 + hstep, voffB); PG8_STAGE(PG8_SA(1, 0), a3, voffA);
            PG8_WAIT_V(8); PG8_WAIT_L(0); PG8_BAR; PG8_MMA(1, 0, At, B0); PG8_MMA(1, 1, At, B1); PG8_BAR; PG8_SCHED;
            } else {
            PG8_LDB(B0, 0, 0); PG8_SCHED; PG8_LDA(At, 0, 0); PG8_STAGE(PG8_SA(1, 1), a1 + hstep, voffA);
            PG8_WAIT_L(8); PG8_BAR; PG8_WAIT_L(0); PG8_MMA(0, 0, At, B0); PG8_BAR; PG8_SCHED;
            PG8_LDB(B1, 0, 1); PG8_STAGE(PG8_SB(0, 0), b2, voffB);
            PG8_BAR; PG8_WAIT_L(0); PG8_MMA(0, 1, At, B1); PG8_BAR;
            PG8_LDA(At, 0, 1); PG8_STAGE(PG8_SA(0, 0), a2, voffA);
            PG8_BAR; PG8_WAIT_L(0); PG8_MMA(1, 0, At, B0); PG8_BAR; PG8_SCHED;
            PG8_STAGE(PG8_SB(0, 1), b2 + hstep, voffB);
            PG8_WAIT_V(6); PG8_BAR; PG8_MMA(1, 1, At, B1); PG8_BAR;
            PG8_LDB(B0, 1, 0); PG8_SCHED; PG8_LDA(At, 1, 0); PG8_STAGE(PG8_SA(0, 1), a2 + hstep, voffA);
            PG8_WAIT_L(8); PG8_BAR; PG8_WAIT_L(0); PG8_MMA(0, 0, At, B0); PG8_BAR; PG8_SCHED;
            PG8_LDB(B1, 1, 1); PG8_STAGE(PG8_SB(1, 0), b3, voffB);
            PG8_BAR; PG8_WAIT_L(0); PG8_MMA(0, 1, At, B1); PG8_BAR;
            PG8_LDA(At, 1, 1); PG8_STAGE(PG8_SA(1, 0), a3, voffA);
            PG8_BAR; PG8_WAIT_L(0); PG8_MMA(1, 0, At, B0); PG8_BAR; PG8_SCHED;
            PG8_STAGE(PG8_SB(1, 1), b3 + hstep, voffB);
            PG8_WAIT_V(6); PG8_BAR; PG8_MMA(1, 1, At, B1); PG8_BAR;
            }
        }
        if constexpr (ALIGN_EPI) { if (wr == 0) PG8_BAR; }
        if constexpr (!Epi::AFTER_DRAIN) { E(acc, cur, wr, wc, fr, fq); S.done(cur); }
        if (!has_next) break;
#pragma unroll
        for (int a = 0; a < 2; ++a)
#pragma unroll
            for (int b = 0; b < 2; ++b)
#pragma unroll
                for (int m = 0; m < 4; ++m)
#pragma unroll
                    for (int n = 0; n < 2; ++n) acc[a][b][m][n] = (f32x4){0.f, 0.f, 0.f, 0.f};
        cur = nxt; cA = nA; cB = nB; ++ui;
        if constexpr (ALIGN_EPI) { if (wr == 1) PG8_BAR; }
    }
    PG8_WAIT_V(0);
    if constexpr (!ALIGN_EPI) { if (wr == 0) PG8_BAR; }
    PG8_BAR;
    if constexpr (Epi::AFTER_DRAIN) { E.fused(acc, cur, wr, wc, fr, fq, lds, wid, lane); S.done(cur); }
#undef PG8_SA
#undef PG8_SB
#undef PG8_STAGE
#undef PG8_LDA
#undef PG8_LDB
#undef PG8_MMA
#undef PG8_WAIT_V
#undef PG8_WAIT_L
#undef PG8_BAR
#undef PG8_SCHED
}
}
#define XB_TMO      128
#define XB_XCNT(j)  (256  + 64 * (j))
#define XB_XSUB(j)  (1280 + 64 * (j))
#define XB_XGEN(j)  (2304 + 64 * (j))
#define XB_TOP      3328
#define XB_TOPGEN   3392
#define XCD_BAR_WORDS 3456
#define XB_SPIN_CAP (1u << 18)
#define LAS __attribute__((address_space(3)))

__device__ __forceinline__ unsigned xb_ld(unsigned* p)              { return __hip_atomic_load(p, __ATOMIC_RELAXED, __HIP_MEMORY_SCOPE_AGENT); }
__device__ __forceinline__ unsigned xb_add(unsigned* p, unsigned v) { return __hip_atomic_fetch_add(p, v, __ATOMIC_RELAXED, __HIP_MEMORY_SCOPE_AGENT); }
__device__ __forceinline__ unsigned xb_xcc_id() { return (unsigned)__builtin_amdgcn_s_getreg((3 << 11) | 20) & 0xFu; }
#define XB_SPIN(cond, bar) do { unsigned _sp = 0; while (cond) { __builtin_amdgcn_s_sleep(1); \
    if ((++_sp & 255u) == 0u) { if (xb_ld(&(bar)[XB_TMO])) break; if (_sp > XB_SPIN_CAP) { atomicAdd(&(bar)[XB_TMO], 1u); break; } } } } while (0)

struct XcdBarrier {
    unsigned* bar; unsigned x;
    volatile LAS unsigned* st;
};

__device__ __forceinline__ XcdBarrier xcd_barrier_post(unsigned* bar, volatile LAS unsigned* st) {
    XcdBarrier b; b.bar = bar; b.x = xb_xcc_id(); b.st = st;
    if (threadIdx.x == 0) (void)xb_add(&bar[XB_XCNT(b.x)], 1u);
    return b;
}
__device__ __forceinline__ void xcd_barrier_complete(unsigned* bar, unsigned x, unsigned& nloc, unsigned& nx) {
    const unsigned G = gridDim.x * gridDim.y * gridDim.z;
    unsigned sum, cnt, mine, sp = 0u;
    for (;;) {
        sum = 0u; cnt = 0u; mine = 0u;
#pragma unroll
        for (unsigned j = 0; j < 16; ++j) { const unsigned c = xb_ld(&bar[XB_XCNT(j)]); sum += c; cnt += (c > 0u) ? 1u : 0u; mine = (j == x) ? c : mine; }
        if (sum == G) break;
        __builtin_amdgcn_s_sleep(1);
        if ((++sp & 255u) == 0u) { if (xb_ld(&bar[XB_TMO])) break; if (sp > XB_SPIN_CAP) { atomicAdd(&bar[XB_TMO], 1u); break; } }
    }
    nloc = mine > 0u ? mine : 1u; nx = cnt > 0u ? cnt : 1u;
}

__device__ __forceinline__ void xcd_barrier(const XcdBarrier& b) {
    asm volatile("s_waitcnt vmcnt(0)" ::: "memory");
    __syncthreads();
    if (threadIdx.x == 0) {
        unsigned* bar = b.bar;
        __builtin_amdgcn_s_waitcnt(0);
        unsigned nloc = b.st[0], nx = b.st[1];
        if (nloc == 0u) { xcd_barrier_complete(bar, b.x, nloc, nx); b.st[0] = nloc; b.st[1] = nx; }
        const unsigned old = xb_add(&bar[XB_XSUB(b.x)], 1u);
        const unsigned gen = old / nloc;
        if (old + 1u == (gen + 1u) * nloc) {
            __builtin_amdgcn_fence(__ATOMIC_RELEASE, "agent");
            asm volatile("s_waitcnt vmcnt(0)" ::: "memory");
            const unsigned og = xb_add(&bar[XB_TOP], 1u);
            const unsigned tg = og / nx;
            if (og + 1u == (tg + 1u) * nx) xb_add(&bar[XB_TOPGEN], 1u);
            else XB_SPIN(xb_ld(&bar[XB_TOPGEN]) == tg, bar);
            __builtin_amdgcn_fence(__ATOMIC_ACQUIRE, "agent");
            xb_add(&bar[XB_XGEN(b.x)], 1u);
            asm volatile("s_waitcnt vmcnt(0)" ::: "memory");
        } else {
            XB_SPIN(xb_ld(&bar[XB_XGEN(b.x)]) == gen, bar);
            __builtin_amdgcn_fence(__ATOMIC_ACQUIRE, "agent");
            asm volatile("s_waitcnt vmcnt(0)" ::: "memory");
        }
    }
    __syncthreads();
}

constexpr int DM = 2048, NB = 4, SEQ = 2048, DEPTH = 4, DB = 128, DSQ = 8;
constexpr int MP = NB * SEQ, MS = DB * DSQ, MT = MP + MS;
constexpr int S5W = 1024, S5G = 64, S5N = 64, S5C = 16;
constexpr int HW = 1024, HH = 8, HK = 128, HV = 128;
constexpr int FF = 5504, INW = 5120;
constexpr float EPS = 1e-6f;
constexpr int S5CH = 16, S5CL = SEQ / S5CH;

constexpr size_t O_Y = 0, O_REP = (size_t)MT * DM, O_IMP = O_REP + (size_t)DEPTH * NB * S5G * S5N, O_HP = O_IMP + (size_t)DEPTH * NB * S5G * S5N,
                 O_RES = O_HP + (size_t)DEPTH * NB * HH * HK * HV, O_IMS = O_RES + (size_t)DEPTH * DB * S5G * S5N, O_HS = O_IMS + (size_t)DEPTH * DB * S5G * S5N,
                 O_END = O_HS + (size_t)DEPTH * DB * HH * HK * HV;
static_assert(O_END == 92405760, "output size");

constexpr size_t MiB = 1u << 20;
constexpr size_t WS_CTL = 0, CTL_ZERO_BYTES = 1 * MiB;
constexpr size_t WS_AB = 1 * MiB;
constexpr size_t WS_BBR = WS_AB + 256 * 1024;
constexpr size_t WS_BBI = WS_BBR + 1 * MiB;
constexpr size_t WS_LB = WS_BBI + 1 * MiB;
constexpr size_t WS_RS = WS_LB + 64 * 1024;
constexpr size_t WS_S5E = WS_RS + 64 * 1024;
constexpr size_t WS_W = 16 * MiB;
constexpr size_t LW_GU1 = 0, LW_D1 = LW_GU1 + (size_t)2 * FF * DM * 2, LW_GU2 = LW_D1 + (size_t)DM * FF * 2, LW_D2 = LW_GU2 + (size_t)2 * FF * DM * 2,
                 LW_IN = LW_D2 + (size_t)DM * FF * 2, LW_GLU = LW_IN + (size_t)INW * DM * 2, LW_OUT = LW_GLU + (size_t)S5W * S5W * 2, LW_END = LW_OUT + (size_t)DM * DM * 2;
static_assert(LW_END == 166723584 && (LW_D1 % 256) == 0 && (LW_GLU % 256) == 0, "weight map");
constexpr size_t WS_HB = 656 * MiB;
constexpr size_t WS_HID = WS_HB + 36 * MiB;
constexpr size_t WS_A = WS_HID + 97 * MiB;
constexpr size_t WS_Z = WS_A + 72 * MiB;
constexpr size_t WS_CAT = WS_Z + 180 * MiB;
constexpr size_t WS_YSG = WS_CAT + 36 * MiB;
constexpr size_t WS_O = WS_YSG + 18 * MiB;
constexpr size_t WS_PART = WS_O + 36 * MiB;
constexpr size_t WS_END = WS_PART + 64 * MiB;
static_assert(WS_W + 4 * LW_END <= WS_HB && WS_S5E + 2 * MiB <= WS_W, "ws map");

constexpr int RING_BYTES = 131072, LDSCTL_OFF = RING_BYTES, LDS_BYTES = RING_BYTES + 1024;

#define GAS __attribute__((address_space(1)))
#define LAS __attribute__((address_space(3)))
typedef unsigned short bf16;
typedef float f32x4 __attribute__((ext_vector_type(4)));
typedef float f32x2 __attribute__((ext_vector_type(2)));
typedef unsigned v4u __attribute__((ext_vector_type(4)));
typedef unsigned v2u __attribute__((ext_vector_type(2)));
#define LDS_WAIT() asm volatile("s_waitcnt lgkmcnt(0)" ::: "memory")

__device__ __forceinline__ unsigned f2bf(float f) { unsigned u = __builtin_bit_cast(unsigned, f); return (u + 0x7fffu + ((u >> 16) & 1u)) >> 16; }
__device__ __forceinline__ unsigned pk2(float lo, float hi) { unsigned r; asm("v_cvt_pk_bf16_f32 %0, %1, %2" : "=v"(r) : "v"(lo), "v"(hi)); return r; }
__device__ __forceinline__ float bflo(unsigned w) { return __builtin_bit_cast(float, w << 16); }
__device__ __forceinline__ float bfhi(unsigned w) { return __builtin_bit_cast(float, w & 0xffff0000u); }
__device__ __forceinline__ float wave_sum(float v) {
#pragma unroll
    for (int o = 1; o < 64; o <<= 1) v += __shfl_xor(v, o);
    return v;
}
__device__ __forceinline__ float sigm(float x) { return __builtin_amdgcn_rcpf(1.f + __builtin_amdgcn_exp2f(-1.44269504f * x)); }
__device__ __forceinline__ float silu(float x) { return x * __builtin_amdgcn_rcpf(1.f + __builtin_amdgcn_exp2f(-1.44269504f * x)); }
__device__ __forceinline__ float gelu_tanh(float v) { const float a = 0.7978845608f * (v + 0.044715f * v * v * v); return v * __builtin_amdgcn_rcpf(1.f + __builtin_amdgcn_exp2f(-2.88539008f * a)); }

struct Args { const float* in[27]; float* out; unsigned char* ws; int ph_lo, ph_hi; };

struct EpiGU {
    static constexpr bool PERM = true, AFTER_DRAIN = false;
    bf16* O; const float* rs;
    __device__ __forceinline__ void operator()(const pg8::f32x4 (&acc)[2][2][4][2], const pg8::Unit& u, int wr, int wc, int fr, int fq) const {
        const int row0 = u.pm * 256 + wr * 64 + fr, col0 = u.pn * 128 + wc * 32 + 8 * fq;
#pragma unroll
        for (int ai = 0; ai < 2; ++ai)
#pragma unroll
            for (int m = 0; m < 4; ++m) {
                const int row = row0 + ai * 128 + m * 16; const float r = rs[row];
                float o[8];
#pragma unroll
                for (int n = 0; n < 2; ++n)
#pragma unroll
                    for (int j = 0; j < 4; ++j) { const float g = acc[ai][0][m][n][j] * r, uu = acc[ai][1][m][n][j] * r; o[4 * n + j] = silu(g) * uu; }
                v4u w; w.x = pk2(o[0], o[1]); w.y = pk2(o[2], o[3]); w.z = pk2(o[4], o[5]); w.w = pk2(o[6], o[7]);
                *(v4u*)(O + (size_t)row * FF + col0) = w;
            }
    }
};
struct MixOrder {
    bool split; pg8::StaticOrder so; pg8::SplitOrder sp;
    __device__ __forceinline__ bool next(int i, pg8::Unit& u) const { return split ? sp.next(i, u) : so.next(i, u); }
    __device__ __forceinline__ void a_ready(const pg8::Unit&) const {}
    __device__ __forceinline__ void done(const pg8::Unit&) const {}
};
struct EpiF32 {
    static constexpr bool PERM = false, AFTER_DRAIN = false;
    float* C; int ldc; float* P;
    __device__ __forceinline__ void operator()(const pg8::f32x4 (&acc)[2][2][4][2], const pg8::Unit& u, int wr, int wc, int fr, int fq) const {
        const int row0 = u.pm * 256 + wr * 64 + fr, col0 = u.pn * 256 + wc * 32 + 4 * fq;
        float* base = u.sp < 0 ? C : P + ((size_t)u.sp * MS - MP) * ldc;
#pragma unroll
        for (int ai = 0; ai < 2; ++ai)
#pragma unroll
            for (int m = 0; m < 4; ++m) { float* rowp = base + (size_t)(row0 + ai * 128 + m * 16) * ldc + col0;
#pragma unroll
                for (int bj = 0; bj < 2; ++bj)
#pragma unroll
                    for (int n = 0; n < 2; ++n) *(f32x4*)(rowp + bj * 128 + n * 16) = acc[ai][bj][m][n]; }
    }
};
struct EpiWin {
    static constexpr bool PERM = false, AFTER_DRAIN = false;
    float* Z; const float* rs; const float* lb;
    __device__ __forceinline__ void operator()(const pg8::f32x4 (&acc)[2][2][4][2], const pg8::Unit& u, int wr, int wc, int fr, int fq) const {
        const int row0 = u.pm * 256 + wr * 64 + fr, col0 = u.pn * 256 + wc * 32 + 4 * fq; const int kind = u.pn >> 2;
#pragma unroll
        for (int ai = 0; ai < 2; ++ai)
#pragma unroll
            for (int m = 0; m < 4; ++m) { const int row = row0 + ai * 128 + m * 16; const float r = rs[row]; float* rowp = Z + (size_t)row * INW + col0;
#pragma unroll
                for (int bj = 0; bj < 2; ++bj)
#pragma unroll
                    for (int n = 0; n < 2; ++n) { f32x4 v = acc[ai][bj][m][n] * r;
                        if (kind == 1) { v[0] = silu(v[0]); v[1] = silu(v[1]); v[2] = silu(v[2]); v[3] = silu(v[3]); }
                        else if (kind == 2) { const f32x4 l4 = *(const f32x4*)(lb + (col0 + bj * 128 + n * 16 - 2048));
#pragma unroll
                            for (int j = 0; j < 4; ++j) v[j] = l4[j] + (1.f - l4[j]) * sigm(v[j]); }
                        *(f32x4*)(rowp + bj * 128 + n * 16) = v; } }
    }
};
struct EpiGlu {
    static constexpr bool PERM = true, AFTER_DRAIN = false;
    bf16* CAT; const bf16* YSG; const float* bias;
    __device__ __forceinline__ void operator()(const pg8::f32x4 (&acc)[2][2][4][2], const pg8::Unit& u, int wr, int wc, int fr, int fq) const {
        const int row0 = u.pm * 256 + wr * 64 + fr, col0 = u.pn * 256 + wc * 32 + 8 * fq;
        f32x4 bv[2][2];
#pragma unroll
        for (int bj = 0; bj < 2; ++bj)
#pragma unroll
            for (int n = 0; n < 2; ++n) bv[bj][n] = *(const f32x4*)(bias + col0 + bj * 128 + 4 * n);
#pragma unroll
        for (int ai = 0; ai < 2; ++ai)
#pragma unroll
            for (int m = 0; m < 4; ++m) { const int row = row0 + ai * 128 + m * 16;
#pragma unroll
                for (int bj = 0; bj < 2; ++bj) { const int col = col0 + bj * 128;
                    const v4u y = *(const v4u*)(YSG + (size_t)row * S5W + col);
                    const f32x4 t0 = acc[ai][bj][m][0] + bv[bj][0], t1 = acc[ai][bj][m][1] + bv[bj][1];
                    v4u w; w.x = pk2(bflo(y.x) * sigm(t0[0]), bfhi(y.x) * sigm(t0[1])); w.y = pk2(bflo(y.y) * sigm(t0[2]), bfhi(y.y) * sigm(t0[3]));
                    w.z = pk2(bflo(y.z) * sigm(t1[0]), bfhi(y.z) * sigm(t1[1])); w.w = pk2(bflo(y.w) * sigm(t1[2]), bfhi(y.w) * sigm(t1[3]));
                    *(v4u*)(CAT + (size_t)row * DM + col) = w; } }
    }
};

__device__ __forceinline__ void s5_tables_item(const Args& a, int lg, LAS unsigned char* lds, int tid);
constexpr int I_GU = 32 * 344, I_D = 86 * 64, I_IN = 32 * 160, I_GLU = 16 * 32, I_OUT = 32 * 64;
constexpr int OI_GU1 = 0, OI_D1 = OI_GU1 + I_GU, OI_IN = OI_D1 + I_D, OI_GLU = OI_IN + I_IN, OI_OUT = OI_GLU + I_GLU, OI_GU2 = OI_OUT + I_OUT, OI_D2 = OI_GU2 + I_GU, I_L = OI_D2 + I_D;
static_assert(I_L == 40704, "items per layer");
struct TrDesc { const float* src; const float* gain; bf16* dst; int ldw, K; };
__device__ __forceinline__ TrDesc tr_decode(const Args& a, int it) {
    const int l = it / I_L; int r = it - l * I_L; TrDesc d;
    unsigned char* wl = a.ws + WS_W + (size_t)l * LW_END;
    if (r >= OI_GU2 && r < OI_D2 || r < OI_D1) { const int f = r >= OI_GU2; r -= f ? OI_GU2 : 0; const int kb = r / 344, nb = r % 344, pn = nb >> 3, rr = nb & 7;
        d.src = (rr < 4 ? a.in[f ? 10 : 7] : a.in[f ? 11 : 8]) + (size_t)l * DM * FF + (size_t)(64 * kb) * FF + 128 * pn + 32 * (rr & 3); d.ldw = FF;
        d.gain = a.in[5] + (size_t)(l * 3 + (f ? 2 : 0)) * DM + 64 * kb; d.dst = (bf16*)(wl + (f ? LW_GU2 : LW_GU1)) + (size_t)(32 * nb) * DM + 64 * kb; d.K = DM; return d; }
    if (r >= OI_D2 || r < OI_IN) { const int f = r >= OI_D2; r -= f ? OI_D2 : OI_D1; const int kb = r / 64, nb = r % 64;
        d.src = a.in[f ? 12 : 9] + (size_t)l * FF * DM + (size_t)(64 * kb) * DM + 32 * nb; d.ldw = DM; d.gain = nullptr; d.dst = (bf16*)(wl + (f ? LW_D2 : LW_D1)) + (size_t)(32 * nb) * FF + 64 * kb; d.K = FF; return d; }
    if (r < OI_GLU) { r -= OI_IN; const int kb = r / 160, nb = r % 160;
        d.src = a.in[13] + (size_t)l * DM * INW + (size_t)(64 * kb) * INW + 32 * nb; d.ldw = INW; d.gain = a.in[5] + (size_t)(l * 3 + 1) * DM + 64 * kb; d.dst = (bf16*)(wl + LW_IN) + (size_t)(32 * nb) * DM + 64 * kb; d.K = DM; return d; }
    if (r < OI_OUT) { r -= OI_GLU; const int kb = r / 32, nb = r % 32;
        d.src = a.in[23] + (size_t)l * S5W * S5W + (size_t)(64 * kb) * S5W + 32 * nb; d.ldw = S5W; d.gain = nullptr; d.dst = (bf16*)(wl + LW_GLU) + (size_t)(32 * nb) * S5W + 64 * kb; d.K = S5W; return d; }
    { r -= OI_OUT; const int kb = r / 64, nb = r % 64;
        d.src = a.in[14] + (size_t)l * DM * DM + (size_t)(64 * kb) * DM + 32 * nb; d.ldw = DM; d.gain = nullptr; d.dst = (bf16*)(wl + LW_OUT) + (size_t)(32 * nb) * DM + 64 * kb; d.K = DM; return d; }
}
__device__ __forceinline__ void tr_load(const TrDesc& d, float (&v)[32], int lane) {
    const float* p = d.src + (size_t)(lane >> 5) * d.ldw + (lane & 31);
#pragma unroll
    for (int i = 0; i < 32; ++i) v[i] = __builtin_nontemporal_load(p + (size_t)(2 * i) * d.ldw);
}
__device__ __forceinline__ void tr_store(const TrDesc& d, const float (&v)[32], LAS float* scr, int lane) {
    if (d.gain) {
#pragma unroll
        for (int i = 0; i < 32; ++i) scr[(2 * i + (lane >> 5)) * 33 + (lane & 31)] = v[i] * d.gain[2 * i + (lane >> 5)];
    } else {
#pragma unroll
        for (int i = 0; i < 32; ++i) scr[(2 * i + (lane >> 5)) * 33 + (lane & 31)] = v[i];
    }
    LDS_WAIT(); asm volatile("" ::: "memory");
    const int c = lane & 7;
#pragma unroll
    for (int j = 0; j < 4; ++j) { const int n = (lane >> 3) + 8 * j; const LAS float* s = scr + (8 * c) * 33 + n;
        v4u o; o.x = pk2(s[0 * 33], s[1 * 33]); o.y = pk2(s[2 * 33], s[3 * 33]); o.z = pk2(s[4 * 33], s[5 * 33]); o.w = pk2(s[6 * 33], s[7 * 33]);
        *(v4u*)(d.dst + (size_t)n * d.K + 8 * c) = o; }
    LDS_WAIT(); asm volatile("" ::: "memory");
}
__device__ __forceinline__ void convert_queue(const Args& a, unsigned* ctr, int begin, int end, LAS unsigned char* lds, int tid) {
    const int wave = __builtin_amdgcn_readfirstlane(tid >> 6), lane = tid & 63;
    LAS float* scr = (LAS float*)(lds + wave * 16384);
    for (;;) {
        unsigned c = 0; if (lane == 0) c = __hip_atomic_fetch_add(ctr, 8u, __ATOMIC_RELAXED, __HIP_MEMORY_SCOPE_AGENT);
        const int ib = begin + (int)__builtin_amdgcn_readfirstlane(c);
        if (ib >= end) break;
        for (int i0 = ib; i0 < ib + 8 && i0 < end; i0 += 2) {
            const TrDesc d0 = tr_decode(a, i0); float v0[32]; tr_load(d0, v0, lane);
            if (i0 + 1 < end) { const TrDesc d1 = tr_decode(a, i0 + 1); float v1[32]; tr_load(d1, v1, lane); tr_store(d0, v0, scr, lane); tr_store(d1, v1, scr, lane); }
            else tr_store(d0, v0, scr, lane);
        }
    }
}
constexpr int CW_Q = 32768;
__device__ __forceinline__ void p0_prologue(const Args& a, LAS unsigned char* lds, int G, int bid, int tid) {
    const int wave = __builtin_amdgcn_readfirstlane(tid >> 6), lane = tid & 63;
    const int gw = bid * 8 + wave, NGW = G * 8;
    convert_queue(a, (unsigned*)(a.ws + WS_CTL) + CW_Q, 0, OI_D1, lds, tid);
    __syncthreads();
    for (int lg = bid; lg < DEPTH * S5G; lg += G) s5_tables_item(a, lg, lds, tid);
    for (int idx = bid * 512 + tid; idx < HW; idx += G * 512) {
        const float x0 = a.in[25][idx], x1 = a.in[25][HW + idx], x2 = a.in[25][2 * HW + idx], x3 = a.in[25][3 * HW + idx];
        const float mx = fmaxf(fmaxf(x0, x1), fmaxf(x2, x3));
        const float e0 = expf(x0 - mx), e1 = expf(x1 - mx), e2 = expf(x2 - mx), e3 = expf(x3 - mx), inv = 1.f / (e0 + e1 + e2 + e3);
        float* lb = (float*)(a.ws + WS_LB);
        lb[idx] = 0.f; lb[HW + idx] = e1 * inv; lb[2 * HW + idx] = (e1 + e2) * inv; lb[3 * HW + idx] = (e1 + e2 + e3) * inv;
    }
    for (int row = gw; row < MT; row += NGW) {
        const float* xr = row < MP ? a.in[0] + (size_t)row * DM : a.in[1] + (size_t)(row - MP) * DM;
        float* hr = a.out + O_Y + (size_t)row * DM; bf16* hb = (bf16*)(a.ws + WS_HB) + (size_t)row * DM;
        float ss = 0.f;
#pragma unroll
        for (int j = 0; j < 8; ++j) { const f32x4 v = *(const f32x4*)(xr + 4 * lane + 256 * j); ss += (v[0] * v[0] + v[1] * v[1]) + (v[2] * v[2] + v[3] * v[3]);
            *(f32x4*)(hr + 4 * lane + 256 * j) = v; v2u w; w.x = pk2(v[0], v[1]); w.y = pk2(v[2], v[3]); *(v2u*)(hb + 4 * lane + 256 * j) = w; }
        ss = wave_sum(ss);
        if (lane == 0) ((float*)(a.ws + WS_RS))[row] = 1.f / sqrtf(ss * (1.f / DM) + EPS);
    }
}

__device__ __forceinline__ void norm_res_phase(const Args& a, const float* gain, float coef, bool ksplit, int G, int bid, int tid) {
    const int wave = __builtin_amdgcn_readfirstlane(tid >> 6), lane = tid & 63;
    const int gw = bid * 8 + wave, NGW = G * 8;
    f32x4 gv[8];
#pragma unroll
    for (int j = 0; j < 8; ++j) gv[j] = *(const f32x4*)(gain + 4 * lane + 256 * j) * coef;
    for (int row = gw; row < MT; row += NGW) {
        const float* ar = (const float*)(a.ws + WS_A) + (size_t)row * DM; float* hr = a.out + O_Y + (size_t)row * DM; bf16* hb = (bf16*)(a.ws + WS_HB) + (size_t)row * DM;
        f32x4 av[8], hv[8]; float ss = 0.f;
        if (ksplit && row >= MP) {
            const float* pr = (const float*)(a.ws + WS_PART) + (size_t)(row - MP) * DM;
#pragma unroll
            for (int j = 0; j < 8; ++j) { f32x4 s = *(const f32x4*)(pr + 4 * lane + 256 * j);
#pragma unroll
                for (int q = 1; q < 8; ++q) s += *(const f32x4*)(pr + (size_t)q * MS * DM + 4 * lane + 256 * j);
                av[j] = s; }
        } else {
#pragma unroll
            for (int j = 0; j < 8; ++j) av[j] = *(const f32x4*)(ar + 4 * lane + 256 * j);
        }
#pragma unroll
        for (int j = 0; j < 8; ++j) { hv[j] = *(const f32x4*)(hr + 4 * lane + 256 * j);
            ss += (av[j][0] * av[j][0] + av[j][1] * av[j][1]) + (av[j][2] * av[j][2] + av[j][3] * av[j][3]); }
        ss = wave_sum(ss);
        const float ra = 1.f / sqrtf(ss * (1.f / DM) + EPS);
        float s2 = 0.f;
#pragma unroll
        for (int j = 0; j < 8; ++j) { const f32x4 v = hv[j] + av[j] * gv[j] * ra; s2 += (v[0] * v[0] + v[1] * v[1]) + (v[2] * v[2] + v[3] * v[3]);
            *(f32x4*)(hr + 4 * lane + 256 * j) = v; v2u w; w.x = pk2(v[0], v[1]); w.y = pk2(v[2], v[3]); *(v2u*)(hb + 4 * lane + 256 * j) = w; }
        s2 = wave_sum(s2);
        if (lane == 0) ((float*)(a.ws + WS_RS))[row] = 1.f / sqrtf(s2 * (1.f / DM) + EPS);
    }
}

__device__ __forceinline__ void hgrn_sample_item(const Args& a, int l, int item, LAS unsigned char* lds, int tid) {
    const int h = item & 7, b = item >> 3, kq = tid >> 5, v4 = tid & 31;
    LAS float* red = (LAS float*)lds;
    const float* s0 = a.in[4] + ((size_t)((l * DB + b) * HH + h) * HK + kq * 8) * HV + 4 * v4;
    float* s1 = a.out + O_HS + ((size_t)((l * DB + b) * HH + h) * HK + kq * 8) * HV + 4 * v4;
    f32x4 S[8];
#pragma unroll
    for (int i = 0; i < 8; ++i) S[i] = *(const f32x4*)(s0 + (size_t)i * HV);
    const float* zb = (const float*)(a.ws + WS_Z) + (size_t)(MP + b * DSQ) * INW + h * HK;
#pragma unroll
    for (int t = 0; t < DSQ; ++t) {
        const float* zr = zb + (size_t)t * INW;
        const f32x4 q0 = *(const f32x4*)(zr + 1024 + kq * 8), q1 = *(const f32x4*)(zr + 1024 + kq * 8 + 4);
        const f32x4 f0 = *(const f32x4*)(zr + 2048 + kq * 8), f1 = *(const f32x4*)(zr + 2048 + kq * 8 + 4);
        const f32x4 vv = *(const f32x4*)(zr + 3072 + 4 * v4);
        f32x4 acc = (f32x4){0.f, 0.f, 0.f, 0.f};
#pragma unroll
        for (int i = 0; i < 8; ++i) { const float f = i < 4 ? f0[i & 3] : f1[i & 3], q = i < 4 ? q0[i & 3] : q1[i & 3]; S[i] = S[i] * f + vv * (1.f - f); acc += S[i] * q; }
        *(LAS f32x4*)(red + (t * 16 + kq) * 128 + 4 * v4) = acc;
    }
#pragma unroll
    for (int i = 0; i < 8; ++i) *(f32x4*)(s1 + (size_t)i * HV) = S[i];
    __syncthreads();
#pragma unroll
    for (int e = 0; e < 2; ++e) { const int idx = tid + 512 * e, t = idx >> 7, v = idx & 127; float s = 0.f;
#pragma unroll
        for (int k = 0; k < 16; ++k) s += red[(t * 16 + k) * 128 + v];
        ((float*)(a.ws + WS_O))[(size_t)(MP + b * DSQ + t) * HW + h * HV + v] = s; }
    __syncthreads();
}
__device__ __forceinline__ void hgrn_post_item(const Args& a, int l, int item, int lane) {
    const int h = item & 7, row = item >> 3;
    const f32x2 o = *(const f32x2*)((const float*)(a.ws + WS_O) + (size_t)row * HW + h * HV + 2 * lane);
    const float ss = wave_sum(o[0] * o[0] + o[1] * o[1]);
    const float r = 1.f / sqrtf(ss * (1.f / HV) + EPS);
    const f32x2 gg = *(const f32x2*)((const float*)(a.ws + WS_Z) + (size_t)row * INW + 4096 + h * HV + 2 * lane);
    const f32x2 gn = *(const f32x2*)(a.in[26] + (size_t)l * HW + h * HV + 2 * lane);
    *(unsigned*)((bf16*)(a.ws + WS_CAT) + (size_t)row * DM + 1024 + h * HV + 2 * lane) = pk2(o[0] * r * gn[0] * silu(gg[0]), o[1] * r * gn[1] * silu(gg[1]));
}

typedef short bf16x8_t __attribute__((ext_vector_type(8)));
constexpr int GC = 64, GNCH = SEQ / GC, GITEMS = NB * HH * GNCH;
constexpr int KS = 272, TS = 144;
constexpr int L_SUM = 0, L_VT = 2048, L_KD = L_VT + 128 * TS;
constexpr int L_Q = L_VT + 128 * TS, L_QR = L_Q + 64 * KS, L_KT = L_QR + 64 * KS, L_ATT = L_KT + 10 * 16 * KS, L_SSQ = L_ATT + 64 * TS, L_RR = L_SSQ + 64 * 8 * 4, L_GEND = L_RR + 256;
static_assert(L_GEND <= RING_BYTES, "GLA LDS map");
constexpr size_t WS_SLOC = WS_END, WS_SIN = WS_SLOC + 64 * MiB, WS_DEC = WS_SIN + 32 * MiB, WS_END2 = WS_DEC + 1 * MiB;

__device__ __forceinline__ v4u pack8(const float (&x)[16], int o) { v4u w; w.x = pk2(x[o], x[o + 1]); w.y = pk2(x[o + 2], x[o + 3]); w.z = pk2(x[o + 4], x[o + 5]); w.w = pk2(x[o + 6], x[o + 7]); return w; }

__device__ __forceinline__ void gla_a_item(const Args& a, int item, LAS unsigned char* lds, int tid) {
    const int j = item & 31, h = (item >> 5) & 7, b = item >> 8;
    const int k = tid & 127, ti = __builtin_amdgcn_readfirstlane(tid >> 7), lane = tid & 63, w = __builtin_amdgcn_readfirstlane(tid >> 6);
    const float* zr = (const float*)(a.ws + WS_Z) + (size_t)(b * SEQ + j * GC + ti * 16) * INW + h * HK + k;
    float fv[16], vv[16];
#pragma unroll
    for (int s = 0; s < 16; ++s) { fv[s] = zr[(size_t)s * INW + 2048]; vv[s] = zr[(size_t)s * INW + 3072]; }
    float c[16]; float run = 0.f;
#pragma unroll
    for (int s = 0; s < 16; ++s) { run += __logf(fv[s]); c[s] = run; }
    LAS float* sums = (LAS float*)(lds + L_SUM);
    sums[ti * 128 + k] = run;
    *(LAS v4u*)(lds + L_VT + k * TS + ti * 32) = pack8(vv, 0); *(LAS v4u*)(lds + L_VT + k * TS + ti * 32 + 16) = pack8(vv, 8);
    __syncthreads();
    const float s0 = sums[k], s1 = sums[128 + k], s2 = sums[256 + k], s3 = sums[384 + k];
    const float P4 = (s0 + s1) + (s2 + s3);
    const float rest = ti == 0 ? (s1 + s2 + s3) : ti == 1 ? (s2 + s3) : ti == 2 ? s3 : 0.f;
    float kd[16];
#pragma unroll
    for (int s = 0; s < 16; ++s) kd[s] = (1.f - fv[s]) * __expf(rest + (run - c[s]));
    *(LAS v4u*)(lds + L_KD + k * TS + ti * 32) = pack8(kd, 0); *(LAS v4u*)(lds + L_KD + k * TS + ti * 32 + 16) = pack8(kd, 8);
    if (ti == 0) ((float*)(a.ws + WS_DEC))[(size_t)item * 128 + k] = __expf(P4);
    __syncthreads();
    const int r = lane & 15, g = lane >> 4;
    bf16x8_t af[2];
#pragma unroll
    for (int st = 0; st < 2; ++st) af[st] = *(const LAS bf16x8_t*)(lds + L_KD + (16 * w + r) * TS + (32 * st + 8 * g) * 2);
    float* out = (float*)(a.ws + WS_SLOC) + (size_t)item * 16384;
#pragma unroll
    for (int vt = 0; vt < 8; ++vt) {
        f32x4 acc = (f32x4){0.f, 0.f, 0.f, 0.f};
#pragma unroll
        for (int st = 0; st < 2; ++st) { const bf16x8_t bfr = *(const LAS bf16x8_t*)(lds + L_VT + (16 * vt + r) * TS + (32 * st + 8 * g) * 2);
            acc = __builtin_amdgcn_mfma_f32_16x16x32_bf16(af[st], bfr, acc, 0, 0, 0); }
        *(f32x4*)(out + (size_t)(16 * vt + r) * 128 + 16 * w + 4 * g) = acc;
    }
    __syncthreads();
}

__device__ __forceinline__ void gla_b_phase(const Args& a, int l, int G, int bid, int tid) {
    for (int gid = bid * 512 + tid; gid < NB * HH * 4096; gid += G * 512) {
        const int bh = gid >> 12, rem = gid & 4095, v = rem >> 5, k4 = (rem & 31) * 4;
        f32x4 S = (f32x4){0.f, 0.f, 0.f, 0.f};
        const float* sl = (const float*)(a.ws + WS_SLOC) + (size_t)(bh * GNCH) * 16384 + v * 128 + k4;
        const float* dc = (const float*)(a.ws + WS_DEC) + (size_t)(bh * GNCH) * 128 + k4;
        bf16* si = (bf16*)(a.ws + WS_SIN) + (size_t)(bh * GNCH) * 16384 + v * 128 + k4;
#pragma unroll 8
        for (int j = 0; j < GNCH; ++j) {
            v2u wv; wv.x = pk2(S[0], S[1]); wv.y = pk2(S[2], S[3]); *(v2u*)(si + (size_t)j * 16384) = wv;
            const f32x4 x = *(const f32x4*)(sl + (size_t)j * 16384), d = *(const f32x4*)(dc + (size_t)j * 128);
            S = d * S + x;
        }
        float* sp = a.out + O_HP + ((size_t)(l * NB * HH + bh) * HK + k4) * HV + v;
#pragma unroll
        for (int i = 0; i < 4; ++i) sp[(size_t)i * HV] = S[i];
    }
}

__device__ __forceinline__ void gla_c_item(const Args& a, int l, int item, LAS unsigned char* lds, int tid) {
    const int j = item & 31, h = (item >> 5) & 7, b = item >> 8;
    const int k = tid & 127, ti = __builtin_amdgcn_readfirstlane(tid >> 7), lane = tid & 63, w = __builtin_amdgcn_readfirstlane(tid >> 6);
    const int r = lane & 15, g = lane >> 4;
    const int row0 = b * SEQ + j * GC;
    const float* zr = (const float*)(a.ws + WS_Z) + (size_t)(row0 + ti * 16) * INW + h * HK + k;
    float fv[16], vv[16], qv[16];
#pragma unroll
    for (int s = 0; s < 16; ++s) { fv[s] = zr[(size_t)s * INW + 2048]; vv[s] = zr[(size_t)s * INW + 3072]; qv[s] = zr[(size_t)s * INW + 1024]; }
    bf16x8_t sfr[4];
    { const bf16* si = (const bf16*)(a.ws + WS_SIN) + (size_t)item * 16384 + (size_t)(16 * w + r) * 128 + 8 * g;
#pragma unroll
      for (int st = 0; st < 4; ++st) sfr[st] = *(const bf16x8_t*)(si + 32 * st); }
    float gz[16];
    { const float* zg = (const float*)(a.ws + WS_Z) + (size_t)row0 * INW + 4096 + h * HV + 16 * w + r;
#pragma unroll
      for (int tt = 0; tt < 4; ++tt)
#pragma unroll
        for (int i = 0; i < 4; ++i) gz[tt * 4 + i] = zg[(size_t)(16 * tt + 4 * g + i) * INW]; }
    const float gn = a.in[26][(size_t)l * HW + h * HV + 16 * w + r];
    float c[16]; float run = 0.f;
#pragma unroll
    for (int s = 0; s < 16; ++s) { run += __logf(fv[s]); c[s] = run; }
    LAS float* sums = (LAS float*)(lds + L_SUM);
    sums[ti * 128 + k] = run;
    *(LAS v4u*)(lds + L_VT + k * TS + ti * 32) = pack8(vv, 0); *(LAS v4u*)(lds + L_VT + k * TS + ti * 32 + 16) = pack8(vv, 8);
    { LAS unsigned* az = (LAS unsigned*)(lds + L_ATT); for (int i = tid; i < 64 * TS / 4; i += 512) az[i] = 0u; }
    __syncthreads();
    const float s0 = sums[k], s1 = sums[128 + k], s2 = sums[256 + k];
    const float myP = ti == 0 ? 0.f : ti == 1 ? s0 : ti == 2 ? (s0 + s1) : (s0 + s1 + s2);
#pragma unroll
    for (int s = 0; s < 16; ++s) {
        const int t = 16 * ti + s;
        *(LAS bf16*)(lds + L_Q + t * KS + k * 2) = (bf16)f2bf(qv[s] * __expf(myP + c[s]));
        *(LAS bf16*)(lds + L_QR + t * KS + k * 2) = (bf16)f2bf(qv[s] * __expf(c[s]));
    }
#pragma unroll
    for (int tp = 0; tp < 4; ++tp) {
        if (tp >= ti) {
            const float dP = (tp == ti) ? 0.f : (tp == ti + 1) ? (ti == 0 ? s0 : ti == 1 ? s1 : s2) : (tp == ti + 2) ? (ti == 0 ? (s0 + s1) : (s1 + s2)) : (s0 + s1 + s2);
            LAS unsigned char* kt = lds + L_KT + (tp * (tp + 1) / 2 + ti) * (16 * KS);
#pragma unroll
            for (int s = 0; s < 16; ++s) *(LAS bf16*)(kt + s * KS + k * 2) = (bf16)f2bf((1.f - fv[s]) * __expf(fminf(dP - c[s], 60.f)));
        }
    }
    __syncthreads();
#pragma unroll
    for (int rep = 0; rep < 2; ++rep) {
        const int q = w + 8 * rep;
        if (q < 10) {
            const int tq = q < 1 ? 0 : q < 3 ? 1 : q < 6 ? 2 : 3, sj = q - tq * (tq + 1) / 2;
            f32x4 acc = (f32x4){0.f, 0.f, 0.f, 0.f};
#pragma unroll
            for (int st = 0; st < 4; ++st) {
                const bf16x8_t af = *(const LAS bf16x8_t*)(lds + L_QR + (16 * tq + r) * KS + (32 * st + 8 * g) * 2);
                const bf16x8_t bfr = *(const LAS bf16x8_t*)(lds + L_KT + q * (16 * KS) + r * KS + (32 * st + 8 * g) * 2);
                acc = __builtin_amdgcn_mfma_f32_16x16x32_bf16(af, bfr, acc, 0, 0, 0);
            }
#pragma unroll
            for (int i = 0; i < 4; ++i) { const int t = 16 * tq + 4 * g + i, s = 16 * sj + r; *(LAS bf16*)(lds + L_ATT + t * TS + s * 2) = (bf16)f2bf(s <= t ? acc[i] : 0.f); }
        }
    }
    __syncthreads();
    f32x4 o[4];
#pragma unroll
    for (int tt = 0; tt < 4; ++tt) {
        f32x4 acc = (f32x4){0.f, 0.f, 0.f, 0.f};
#pragma unroll
        for (int st = 0; st < 4; ++st) { const bf16x8_t af = *(const LAS bf16x8_t*)(lds + L_Q + (16 * tt + r) * KS + (32 * st + 8 * g) * 2);
            acc = __builtin_amdgcn_mfma_f32_16x16x32_bf16(af, sfr[st], acc, 0, 0, 0); }
#pragma unroll
        for (int st = 0; st < 2; ++st) if (st == 0 || tt >= 2) {
            const bf16x8_t af = *(const LAS bf16x8_t*)(lds + L_ATT + (16 * tt + r) * TS + (32 * st + 8 * g) * 2);
            const bf16x8_t bfr = *(const LAS bf16x8_t*)(lds + L_VT + (16 * w + r) * TS + (32 * st + 8 * g) * 2);
            acc = __builtin_amdgcn_mfma_f32_16x16x32_bf16(af, bfr, acc, 0, 0, 0); }
        o[tt] = acc;
    }
    LAS float* ssq = (LAS float*)(lds + L_SSQ); LAS float* rr = (LAS float*)(lds + L_RR);
#pragma unroll
    for (int tt = 0; tt < 4; ++tt)
#pragma unroll
        for (int i = 0; i < 4; ++i) { float p = o[tt][i] * o[tt][i]; p += __shfl_xor(p, 1); p += __shfl_xor(p, 2); p += __shfl_xor(p, 4); p += __shfl_xor(p, 8);
            if (r == 0) ssq[(16 * tt + 4 * g + i) * 8 + w] = p; }
    __syncthreads();
    if (tid < 64) { float s = 0.f;
#pragma unroll
        for (int x = 0; x < 8; ++x) s += ssq[tid * 8 + x];
        rr[tid] = 1.f / sqrtf(s * (1.f / HV) + EPS); }
    __syncthreads();
    bf16* cp = (bf16*)(a.ws + WS_CAT) + (size_t)row0 * DM + 1024 + h * HV + 16 * w + r;
#pragma unroll
    for (int tt = 0; tt < 4; ++tt)
#pragma unroll
        for (int i = 0; i < 4; ++i) { const int t = 16 * tt + 4 * g + i; cp[(size_t)t * DM] = (bf16)f2bf(o[tt][i] * rr[t] * gn * silu(gz[tt * 4 + i])); }
    __syncthreads();
}
constexpr int S5ITEMS = S5G * 40, S5IPG = 40;
constexpr size_t WS_S5K = WS_END2, WS_S5P = WS_S5K + 2 * MiB, WS_S5Q = WS_S5P + 16 * MiB, WS_S5A = WS_S5Q + 16 * MiB, WS_S5T = WS_S5A + 1 * MiB, WS_END3 = WS_S5T + 1 * MiB;
constexpr int L5_K = 0, L5_U = 8192, L5_XL = 16384, L5_XIN = L5_XL + 128 * 17 * 4, L5_END = L5_XIN + 16 * 272;
constexpr int LP_AP = 0, LP_BB = LP_AP + 17 * 64 * 8, LP_C = LP_BB + 64 * 16 * 8, LP_END = LP_C + 16 * 64 * 8;

__device__ __forceinline__ f32x2 cmul(f32x2 x, f32x2 y) { return (f32x2){x[0] * y[0] - x[1] * y[1], x[0] * y[1] + x[1] * y[0]}; }

__device__ __forceinline__ void s5_tables_item(const Args& a, int lg, LAS unsigned char* lds, int tid) {
    LAS f32x2* ap = (LAS f32x2*)(lds + LP_AP); LAS f32x2* bbl = (LAS f32x2*)(lds + LP_BB); LAS f32x2* cl = (LAS f32x2*)(lds + LP_C);
    const float dt = expf(a.in[17][lg]);
#pragma unroll 1
    for (int idx = tid; idx < 17 * 64; idx += 512) { const int tau = idx >> 6, n = idx & 63; const float lr = a.in[15][lg * 64 + n], li = a.in[16][lg * 64 + n];
        const float mag = expf(lr * dt * (float)tau), ang = li * dt * (float)tau; ap[idx] = (f32x2){mag * cosf(ang), mag * sinf(ang)}; }
#pragma unroll 1
    for (int idx = tid; idx < 64 * 16; idx += 512) { const int n = idx >> 4; const float lr = a.in[15][lg * 64 + n], li = a.in[16][lg * 64 + n];
        const float mag = expf(lr * dt), ang = li * dt; const float are = mag * cosf(ang), aim = mag * sinf(ang);
        const float p = are - 1.f, q = aim, den = lr * lr + li * li; const float zre = (p * lr + q * li) / den, zim = (q * lr - p * li) / den;
        const float br = a.in[18][(size_t)lg * 1024 + idx], bi = a.in[19][(size_t)lg * 1024 + idx];
        bbl[idx] = (f32x2){zre * br - zim * bi, zre * bi + zim * br};
        cl[idx] = (f32x2){a.in[20][(size_t)lg * 1024 + idx], a.in[21][(size_t)lg * 1024 + idx]}; }
    if (tid < 64) { const float lr = a.in[15][lg * 64 + tid], li = a.in[16][lg * 64 + tid];
        const float m16 = expf(lr * dt * 16.f), g16 = li * dt * 16.f, m8 = expf(-lr * dt * 8.f), g8 = -li * dt * 8.f;
        f32x2* A = (f32x2*)(a.ws + WS_S5A); A[lg * 64 + tid] = (f32x2){m16 * cosf(g16), m16 * sinf(g16)}; A[16384 + lg * 64 + tid] = (f32x2){m8 * cosf(g8), m8 * sinf(g8)}; }
    __syncthreads();
    bf16* Kt = (bf16*)(a.ws + WS_S5K) + (size_t)lg * 4096; bf16* Pt = (bf16*)(a.ws + WS_S5P) + (size_t)lg * 32768; bf16* Qt = (bf16*)(a.ws + WS_S5Q) + (size_t)lg * 32768;
#pragma unroll 1
    for (int idx = tid; idx < 4096; idx += 512) { const int tau = idx >> 8, c = (idx >> 4) & 15, cp = idx & 15; float s = 0.f;
#pragma unroll 4
        for (int n = 0; n < 64; ++n) { const f32x2 w = cmul(ap[tau * 64 + n], bbl[n * 16 + cp]); const f32x2 cc = cl[c * 64 + n]; s += cc[0] * w[0] - cc[1] * w[1]; }
        Kt[idx] = (bf16)f2bf(s); }
#pragma unroll 2
    for (int idx = tid; idx < 32768; idx += 512) { const int row = idx >> 7, np = idx & 127, k = row >> 4, c = row & 15, n = np & 63;
        const f32x2 A = ap[(k + 1) * 64 + n], cc = cl[c * 64 + n];
        Pt[idx] = (bf16)f2bf(np < 64 ? (cc[0] * A[0] - cc[1] * A[1]) : -(cc[0] * A[1] + cc[1] * A[0])); }
#pragma unroll 2
    for (int idx = tid; idx < 32768; idx += 512) { const int np = idx >> 8, col = idx & 255, s = col >> 4, cp = col & 15, n = np & 63;
        const f32x2 w = cmul(ap[(15 - s) * 64 + n], bbl[n * 16 + cp]);
        Qt[idx] = (bf16)f2bf(np < 64 ? w[0] : w[1]); }
    __syncthreads();
}

__device__ __forceinline__ void s5_block(const Args& a, int l, int g, int b, LAS unsigned char* lds, int tid) {
    const int lane0 = tid & 63, w = __builtin_amdgcn_readfirstlane(tid >> 6); const int lane = lane0, r = lane & 15, g8 = lane >> 4;
    const int lg = l * S5G + g;
    const float* Z = (const float*)(a.ws + WS_Z);
    { const v4u* src = (const v4u*)((const bf16*)(a.ws + WS_S5K) + (size_t)lg * 4096); ((LAS v4u*)(lds + L5_K))[tid] = src[tid]; }
    bf16x8_t qf[8], pf[2][4];
    { const bf16* Qt = (const bf16*)(a.ws + WS_S5Q) + (size_t)lg * 32768 + (size_t)(16 * w + r) * 256 + 8 * g8;
#pragma unroll
      for (int st = 0; st < 8; ++st) qf[st] = *(const bf16x8_t*)(Qt + 32 * st);
#pragma unroll
      for (int x = 0; x < 2; ++x) { const int k = x ? 15 - w : w; const bf16* Pt = (const bf16*)(a.ws + WS_S5P) + (size_t)lg * 32768 + (size_t)(16 * k + r) * 128 + 8 * g8;
#pragma unroll
        for (int st = 0; st < 4; ++st) pf[x][st] = *(const bf16x8_t*)(Pt + 32 * st); } }
    const f32x4 dv = *(const f32x4*)(a.in[22] + (size_t)l * S5W + 16 * g + 4 * g8);
    const f32x2 a16 = ((const f32x2*)(a.ws + WS_S5A))[lg * 64 + lane], am8 = ((const f32x2*)(a.ws + WS_S5A))[16384 + lg * 64 + lane];
    f32x2 X = (f32x2){0.f, 0.f};
    const int su = 2 * w + (g8 >> 1);
    f32x4 cu0, cu1;
    { const size_t row = (size_t)(b * SEQ + r * 16 + su); cu0 = *(const f32x4*)(Z + row * INW + 16 * g + 8 * (g8 & 1)); cu1 = *(const f32x4*)(Z + row * INW + 16 * g + 8 * (g8 & 1) + 4); }
#pragma unroll 1
    for (int step = 0; step < 10; ++step) {
        int lane_l = lane0; asm volatile("" : "+v"(lane_l));
        const int lane = lane_l, r = lane & 15, g8 = lane >> 4;
        const bool sample = step >= 8; const int stile = 2 * b + (step - 8);
        { v4u fr; fr.x = pk2(cu0[0], cu0[1]); fr.y = pk2(cu0[2], cu0[3]); fr.z = pk2(cu1[0], cu1[1]); fr.w = pk2(cu1[2], cu1[3]);
          if (sample && su < 8) fr = (v4u){0u, 0u, 0u, 0u};
          ((LAS v4u*)(lds + L5_U))[w * 64 + lane] = fr; }
        if (step < 9) { const int ns = step + 1; const bool nsm = ns >= 8;
            const size_t row = nsm ? (size_t)(MP + ((2 * b + ns - 8) * 16 + r) * DSQ + (su >= 8 ? su - 8 : 0)) : (size_t)(b * SEQ + ns * 256 + r * 16 + su);
            cu0 = *(const f32x4*)(Z + row * INW + 16 * g + 8 * (g8 & 1)); cu1 = *(const f32x4*)(Z + row * INW + 16 * g + 8 * (g8 & 1) + 4); }
        f32x4 uu[2];
#pragma unroll
        for (int x = 0; x < 2; ++x) { const int k = x ? 15 - w : w;
            const size_t row = sample ? (size_t)(MP + (stile * 16 + r) * DSQ + (k >= 8 ? k - 8 : 0)) : (size_t)(b * SEQ + step * 256 + r * 16 + k);
            uu[x] = *(const f32x4*)(Z + row * INW + 16 * g + 4 * g8); }
        __syncthreads();
        bf16x8_t uf[8];
#pragma unroll
        for (int st = 0; st < 8; ++st) uf[st] = ((const LAS bf16x8_t*)(lds + L5_U))[st * 64 + lane];
        { f32x4 acc = (f32x4){0.f, 0.f, 0.f, 0.f};
#pragma unroll
          for (int st = 0; st < 8; ++st) acc = __builtin_amdgcn_mfma_f32_16x16x32_bf16(qf[st], uf[st], acc, 0, 0, 0);
          LAS float* XL = (LAS float*)(lds + L5_XL);
#pragma unroll
          for (int i = 0; i < 4; ++i) XL[(16 * w + 4 * g8 + i) * 17 + r] = acc[i]; }
        __syncthreads();
        if (w == 0) {
            const LAS float* XL = (const LAS float*)(lds + L5_XL);
            if (!sample) {
#pragma unroll
                for (int c = 0; c < 16; ++c) {
                    *(LAS bf16*)(lds + L5_XIN + c * 272 + lane * 2) = (bf16)f2bf(X[0]); *(LAS bf16*)(lds + L5_XIN + c * 272 + (64 + lane) * 2) = (bf16)f2bf(X[1]);
                    X = cmul(a16, X) + (f32x2){XL[lane * 17 + c], XL[(64 + lane) * 17 + c]};
                }
                if (step == 7) { const size_t so = (size_t)((l * NB + b) * S5G + g) * S5N + lane; a.out[O_REP + so] = X[0]; a.out[O_IMP + so] = X[1]; }
            } else {
#pragma unroll
                for (int c = 0; c < 16; ++c) {
                    const size_t si = (size_t)((l * DB + stile * 16 + c) * S5G + g) * S5N + lane;
                    const f32x2 xv = cmul(am8, (f32x2){a.in[2][si], a.in[3][si]});
                    *(LAS bf16*)(lds + L5_XIN + c * 272 + lane * 2) = (bf16)f2bf(xv[0]); *(LAS bf16*)(lds + L5_XIN + c * 272 + (64 + lane) * 2) = (bf16)f2bf(xv[1]);
                    const f32x2 xo = cmul(a16, xv) + (f32x2){XL[lane * 17 + c], XL[(64 + lane) * 17 + c]};
                    a.out[O_RES + si] = xo[0]; a.out[O_IMS + si] = xo[1];
                }
            }
        }
        __syncthreads();
        bf16x8_t xf[4];
#pragma unroll
        for (int st = 0; st < 4; ++st) xf[st] = *(const LAS bf16x8_t*)(lds + L5_XIN + r * 272 + (32 * st + 8 * g8) * 2);
#pragma unroll
        for (int x = 0; x < 2; ++x) {
            const int k = x ? 15 - w : w;
            if (!sample || k >= 8) {
                f32x4 acc = (f32x4){0.f, 0.f, 0.f, 0.f};
                const int nst = (k >> 1) + 1;
#pragma unroll
                for (int st = 0; st < 8; ++st) if (st < nst) {
                    const int tau = k - 2 * st - (g8 >> 1);
                    bf16x8_t kf = (bf16x8_t){0, 0, 0, 0, 0, 0, 0, 0};
                    if (tau >= 0) kf = *(const LAS bf16x8_t*)(lds + L5_K + tau * 512 + r * 32 + (g8 & 1) * 16);
                    acc = __builtin_amdgcn_mfma_f32_16x16x32_bf16(kf, uf[st], acc, 0, 0, 0);
                }
#pragma unroll
                for (int st = 0; st < 4; ++st) acc = __builtin_amdgcn_mfma_f32_16x16x32_bf16(pf[x][st], xf[st], acc, 0, 0, 0);
                const size_t row = sample ? (size_t)(MP + (stile * 16 + r) * DSQ + (k - 8)) : (size_t)(b * SEQ + step * 256 + r * 16 + k);
                v2u o; o.x = pk2(gelu_tanh(acc[0] + dv[0] * uu[x][0]), gelu_tanh(acc[1] + dv[1] * uu[x][1])); o.y = pk2(gelu_tanh(acc[2] + dv[2] * uu[x][2]), gelu_tanh(acc[3] + dv[3] * uu[x][3]));
                *(v2u*)((bf16*)(a.ws + WS_YSG) + row * S5W + 16 * g + 4 * g8) = o;
            }
        }
    }
    __syncthreads();
}

constexpr int PH_PER_LAYER = 13, N_PHASES = 1 + DEPTH * PH_PER_LAYER;
#ifndef PROBE_DUP
#define PROBE_DUP 0
#endif
#ifndef KSPLIT_FROM
#define KSPLIT_FROM 2
#endif
#ifndef MK_PER_PHASE
#define MK_PER_PHASE 0
#endif

__global__ void __launch_bounds__(512, 2) mega(Args args) {
    extern __shared__ __attribute__((aligned(16))) unsigned char lds_raw[];
    LAS unsigned char* lds = (LAS unsigned char*)lds_raw;
    const int tid = threadIdx.x, lane = tid & 63, wave = __builtin_amdgcn_readfirstlane(tid >> 6);
    const int G = gridDim.x, bid = blockIdx.x;
    volatile LAS unsigned* MISC = (volatile LAS unsigned*)(lds + LDSCTL_OFF);
    if (tid < 64) MISC[tid] = 0u;
    __syncthreads();
    const int lo = args.ph_lo, hi = args.ph_hi;
    XcdBarrier bar; bar.bar = (unsigned*)(args.ws + WS_CTL) + 4096; bar.x = 0; bar.st = nullptr;
    if (hi - lo > 1) bar = xcd_barrier_post((unsigned*)(args.ws + WS_CTL) + 4096, MISC + 8);
#define IN(k) (lo <= (k) && (k) < hi)
#define CONVQ(q, b, e) do { if (l < 2) { int tq_ = tid; asm volatile("" : "+v"(tq_)); convert_queue(args, (unsigned*)(args.ws + WS_CTL) + CW_Q + 64 * (q), (b), (e), lds, tq_); } } while (0)
#define TIDL() int tidl = tid; asm volatile("" : "+v"(tidl)); const int lanel = tidl & 63, wavel = __builtin_amdgcn_readfirstlane(tidl >> 6); (void)lanel; (void)wavel
#define SEAM(k) do { if (IN((k) + 1)) xcd_barrier(bar); } while (0)

    if (IN(0)) { for (int rep = 0; rep < ((PROBE_DUP & 16) ? 2 : 1); ++rep) { TIDL(); p0_prologue(args, lds, G, bid, tidl); } SEAM(0); }

    for (int l = 0; l < DEPTH; ++l) {
        const int pb = 1 + l * PH_PER_LAYER;
        unsigned char* wl = args.ws + WS_W + (size_t)l * LW_END;
        const bf16* HB = (const bf16*)(args.ws + WS_HB); bf16* HID = (bf16*)(args.ws + WS_HID); float* A = (float*)(args.ws + WS_A); float* Z = (float*)(args.ws + WS_Z);
        const float* RS = (const float*)(args.ws + WS_RS);
        const bool ksplit = (l >= KSPLIT_FROM) && (G == 256);
#define FFN_PHASES(f) do { const int p0 = pb + ((f) ? 10 : 0); \
            if (IN(p0)) { pg8::Gemm g{HB, (const bf16*)(wl + ((f) ? LW_GU2 : LW_GU1)), MT, 2 * FF, DM}; pg8::StaticOrder S; S.init(MT, 2 * FF, DM, G, bid); \
                EpiGU E{HID, RS}; pg8::gemm_phase<EpiGU, pg8::StaticOrder, true, true>(lds, g, S, E); \
                if (f) CONVQ(1 + 5 * l + 3, (2 * l + 1) * I_L + OI_D1, (2 * l + 1) * I_L + OI_GU2); else CONVQ(1 + 5 * l + 0, 2 * l * I_L + OI_D1, 2 * l * I_L + OI_IN); SEAM(p0); } \
            if (IN(p0 + 1)) { pg8::Gemm g{HID, (const bf16*)(wl + ((f) ? LW_D2 : LW_D1)), MT, DM, FF}; MixOrder S; S.split = ksplit; S.so.init(MT, DM, FF, G, bid); S.sp.init(FF, bid); \
                EpiF32 E{A, DM, (float*)(args.ws + WS_PART)}; pg8::gemm_phase<EpiF32, MixOrder, true, true>(lds, g, S, E); \
                if (f) CONVQ(1 + 5 * l + 4, (2 * l + 1) * I_L + OI_GU2, (2 * l + 2) * I_L + (l == 0 ? OI_D1 : 0)); else CONVQ(1 + 5 * l + 1, 2 * l * I_L + OI_IN, (2 * l + 1) * I_L); SEAM(p0 + 1); } \
            if (IN(p0 + 2)) { TIDL(); norm_res_phase(args, args.in[6] + (size_t)(l * 3 + ((f) ? 2 : 0)) * DM, 0.5f, ksplit, G, bid, tidl); SEAM(p0 + 2); } } while (0)
        FFN_PHASES(0);
        if (IN(pb + 3)) { pg8::Gemm g{HB, (const bf16*)(wl + LW_IN), MT, INW, DM}; pg8::StaticOrder S; S.init(MT, INW, DM, G, bid);
            EpiWin E{Z, RS, (const float*)(args.ws + WS_LB) + (size_t)l * HW}; pg8::gemm_phase<EpiWin, pg8::StaticOrder, true, true>(lds, g, S, E); SEAM(pb + 3); }
        if (IN(pb + 4)) {
            for (int rep = 0; rep < ((PROBE_DUP & 1) ? 2 : 1); ++rep) {
            TIDL();
            for (int it = bid; it < GITEMS; it += G) gla_a_item(args, it, lds, tidl);
            for (int it = bid; it < DB * HH; it += G) hgrn_sample_item(args, l, it, lds, tidl);
            }
            SEAM(pb + 4); }
        if (IN(pb + 5)) { TIDL(); gla_b_phase(args, l, G, bid, tidl); SEAM(pb + 5); }
        if (IN(pb + 6)) {
            for (int rep = 0; rep < ((PROBE_DUP & 2) ? 2 : 1); ++rep) {
            TIDL(); const int npost = MS * HH;
            for (int it = bid; it < GITEMS; it += G) gla_c_item(args, l, it, lds, tidl);
            for (int it = bid; it < S5G * NB; it += G) s5_block(args, l, it >> 2, it & 3, lds, tidl);
            for (int it = bid * 8 + wavel; it < npost; it += G * 8) hgrn_post_item(args, l, it + MP * HH, lanel);
            }
            SEAM(pb + 6); }
        if (IN(pb + 7)) { pg8::Gemm g{(const bf16*)(args.ws + WS_YSG), (const bf16*)(wl + LW_GLU), MT, S5W, S5W}; pg8::StaticOrder S; S.init(MT, S5W, S5W, G, bid);
            EpiGlu E{(bf16*)(args.ws + WS_CAT), (const bf16*)(args.ws + WS_YSG), args.in[24] + (size_t)l * S5W}; pg8::gemm_phase<EpiGlu, pg8::StaticOrder, true, true>(lds, g, S, E); SEAM(pb + 7); }
        if (IN(pb + 8)) { pg8::Gemm g{(const bf16*)(args.ws + WS_CAT), (const bf16*)(wl + LW_OUT), MT, DM, DM}; MixOrder S; S.split = ksplit; S.so.init(MT, DM, DM, G, bid); S.sp.init(DM, bid);
            EpiF32 E{A, DM, (float*)(args.ws + WS_PART)}; pg8::gemm_phase<EpiF32, MixOrder, true, true>(lds, g, S, E); CONVQ(1 + 5 * l + 2, (2 * l + 1) * I_L, (2 * l + 1) * I_L + OI_D1); SEAM(pb + 8); }
        if (IN(pb + 9)) { TIDL(); norm_res_phase(args, args.in[6] + (size_t)(l * 3 + 1) * DM, 1.0f, ksplit, G, bid, tidl); SEAM(pb + 9); }
        FFN_PHASES(1);
    }
#undef IN
#undef SEAM
}

extern "C" void kernel_launch(void* const* d_in, const int* in_sizes, int n_in, void* d_out, int out_size, void* d_ws, size_t ws_size, hipStream_t stream) {
    static int grid = 0;
    if (grid == 0) {
        if (n_in != 27 || out_size != (int)O_END || ws_size < WS_END3) { fprintf(stderr, "kernel_launch: unexpected shapes: n_in %d out %d ws %zu (need %zu)\n", n_in, out_size, ws_size, (size_t)WS_END3); grid = -1; return; }
        int dev = 0, cus = 0, per_cu = 0;
        if (hipGetDevice(&dev) != hipSuccess || hipDeviceGetAttribute(&cus, hipDeviceAttributeMultiprocessorCount, dev) != hipSuccess) { grid = -1; return; }
        if (hipFuncSetAttribute((const void*)mega, hipFuncAttributeMaxDynamicSharedMemorySize, LDS_BYTES) != hipSuccess) { fprintf(stderr, "kernel_launch: hipFuncSetAttribute failed\n"); grid = -1; return; }
        if (hipOccupancyMaxActiveBlocksPerMultiprocessor(&per_cu, (const void*)mega, 512, LDS_BYTES) != hipSuccess || per_cu < 1) fprintf(stderr, "kernel_launch: occupancy query reports %d\n", per_cu);
        (void)hipGetLastError();
        grid = cus;
    }
    if (grid < 0) return;
    (void)hipMemsetAsync((char*)d_ws + WS_CTL, 0, CTL_ZERO_BYTES, stream);
    Args a{};
    for (int i = 0; i < 27; ++i) a.in[i] = (const float*)d_in[i];
    a.out = (float*)d_out; a.ws = (unsigned char*)d_ws;
#if MK_PER_PHASE
    for (int p = 0; p < N_PHASES; ++p) { a.ph_lo = p; a.ph_hi = p + 1; hipLaunchKernelGGL(mega, dim3(grid), dim3(512), LDS_BYTES, stream, a); }
#else
    a.ph_lo = 0; a.ph_hi = N_PHASES; hipLaunchKernelGGL(mega, dim3(grid), dim3(512), LDS_BYTES, stream, a);
#endif
}
```
